# Optimizing an MI355X kernel written in HIP

```python
import math
import jax
import jax.numpy as jnp
from jax import lax
import numpy as np

D_MODEL = 4096
BATCH = 4
SEQ = 2048
DEPTH = 1

A_HEAD_DIM = 128
A_HEADS = D_MODEL // (2 * A_HEAD_DIM)
IDX_HEADS = 32
IDX_HEAD_DIM = 128
IDX_ROPE_DIM = 64
TOPK_MAX = 256
V_HEAD_DIM = 128
B_HEADS = D_MODEL // (2 * V_HEAD_DIM)
Q_LORA_RANK = 1024
KV_LORA_RANK = 512
QK_NOPE_DIM = 128
QK_ROPE_DIM = 64
D_FF = 11008
CONV_WIDTH = 3
REL_BUCKETS = 32
REL_MAX_DIST = 128
ROPE_THETA = 10000.0
Q_BLOCK = 128
LN_EPS = 1e-5
RMS_EPS = 1e-6
NEG_INF = -1e30
DEEPNORM_ALPHA = (2 * DEPTH) ** 0.25
DEEPNORM_BETA = (8 * DEPTH) ** -0.25
MIX_WIDTH = A_HEADS * A_HEAD_DIM + B_HEADS * V_HEAD_DIM
IN_SPLITS = (A_HEADS * A_HEAD_DIM, A_HEAD_DIM, A_HEAD_DIM,
             IDX_HEADS * IDX_HEAD_DIM, IDX_HEAD_DIM, IDX_HEADS,
             Q_LORA_RANK, KV_LORA_RANK, QK_ROPE_DIM)
IN_WIDTH = sum(IN_SPLITS)
SPLIT_POINTS = [int(v) for v in np.cumsum(IN_SPLITS)[:-1]]

kernel_name = 'hybrid_dsa_mla_convffn_layer'


def layer_norm(x, g, b):
    xf = x.astype(jnp.float32)
    mu = jnp.mean(xf, axis=-1, keepdims=True)
    var = jnp.mean(jnp.square(xf - mu), axis=-1, keepdims=True)
    y = (xf - mu) * lax.rsqrt(var + LN_EPS)
    return (y * g.astype(jnp.float32) + b.astype(jnp.float32)).astype(x.dtype)


def rms_norm(x, g):
    xf = x.astype(jnp.float32)
    y = xf * lax.rsqrt(jnp.mean(jnp.square(xf), axis=-1, keepdims=True) + RMS_EPS)
    return (y * g.astype(jnp.float32)).astype(x.dtype)


def rope(x, pos):
    half = x.shape[-1] // 2
    freqs = ROPE_THETA ** (-jnp.arange(half, dtype=jnp.float32) / half)
    ang = pos.astype(jnp.float32)[:, :, None] * freqs
    cos = jnp.cos(ang)[:, :, None, :].astype(x.dtype)
    sin = jnp.sin(ang)[:, :, None, :].astype(x.dtype)
    x1, x2 = x[..., :half], x[..., half:]
    return jnp.concatenate([x1 * cos - x2 * sin, x1 * sin + x2 * cos], axis=-1)


def rel_bucket(rel):
    n = jnp.maximum(rel, 0)
    max_exact = REL_BUCKETS // 2
    nf = jnp.maximum(n, 1).astype(jnp.float32)
    large = max_exact + (jnp.log(nf / max_exact) / math.log(REL_MAX_DIST / max_exact)
                         * (REL_BUCKETS - max_exact)).astype(jnp.int32)
    large = jnp.minimum(large, REL_BUCKETS - 1)
    return jnp.where(n < max_exact, n, large)


def dsa_attention(q, k, v, iq, ik, iw, pos, rel_bias):
    B_, S = q.shape[0], q.shape[1]
    topk = min(TOPK_MAX, S // 4)
    nope = IDX_HEAD_DIM - IDX_ROPE_DIM
    iq = jnp.concatenate([iq[..., :nope], rope(iq[..., nope:], pos)], axis=-1)
    ik_h = ik[:, :, None, :]
    ik = jnp.concatenate([ik_h[..., :nope], rope(ik_h[..., nope:], pos)], axis=-1)[:, :, 0, :]
    iw = iw * (IDX_HEADS ** -0.5)
    idx_scale = IDX_HEAD_DIM ** -0.5
    att_scale = A_HEAD_DIM ** -0.5
    key_idx = jnp.arange(S)
    gather = jax.vmap(lambda arr, ii: arr[ii])

    def block(i):
        t0 = i * Q_BLOCK
        qb = lax.dynamic_slice_in_dim(q, t0, Q_BLOCK, axis=1)
        iqb = lax.dynamic_slice_in_dim(iq, t0, Q_BLOCK, axis=1)
        iwb = lax.dynamic_slice_in_dim(iw, t0, Q_BLOCK, axis=1)
        posb = lax.dynamic_slice_in_dim(pos, t0, Q_BLOCK, axis=1)
        tq = t0 + jnp.arange(Q_BLOCK)
        causal = key_idx[None, :] <= tq[:, None]
        dots = jnp.einsum('bthd,bsd->bths', iqb, ik, preferred_element_type=jnp.float32) * idx_scale
        score = jnp.einsum('bths,bth->bts', jax.nn.relu(dots), iwb.astype(jnp.float32))
        score = jnp.where(causal[None], score, NEG_INF)
        _, sel = lax.top_k(score, topk)
        valid = sel <= tq[None, :, None]
        k_sel = gather(k, sel)
        v_sel = gather(v, sel)
        pos_sel = gather(pos, sel)
        bias = rel_bias[rel_bucket(posb[:, :, None] - pos_sel)]
        logits = jnp.einsum('bthd,btkd->bhtk', qb, k_sel, preferred_element_type=jnp.float32) * att_scale
        logits = logits + jnp.transpose(bias, (0, 3, 1, 2)).astype(jnp.float32)
        logits = jnp.where(valid[:, None], logits, NEG_INF)
        p = jax.nn.softmax(logits, axis=-1).astype(v.dtype)
        return jnp.einsum('bhtk,btkd->bthd', p, v_sel)

    out = lax.map(block, jnp.arange(S // Q_BLOCK))
    return jnp.moveaxis(out, 0, 1).reshape(B_, S, A_HEADS * A_HEAD_DIM)


def mla_attention(q_lat, kv_lat, k_rope, pos, q_norm_g, w_uq, kv_norm_g, w_ukv):
    B_, S = q_lat.shape[0], q_lat.shape[1]
    q = (rms_norm(q_lat, q_norm_g) @ w_uq).reshape(B_, S, B_HEADS, QK_NOPE_DIM + QK_ROPE_DIM)
    q = jnp.concatenate([q[..., :QK_NOPE_DIM], rope(q[..., QK_NOPE_DIM:], pos)], axis=-1)
    kv = (rms_norm(kv_lat, kv_norm_g) @ w_ukv).reshape(B_, S, B_HEADS, QK_NOPE_DIM + V_HEAD_DIM)
    k_r = jnp.broadcast_to(rope(k_rope[:, :, None, :], pos), (B_, S, B_HEADS, QK_ROPE_DIM))
    k = jnp.concatenate([kv[..., :QK_NOPE_DIM], k_r], axis=-1)
    v = kv[..., QK_NOPE_DIM:]
    scale = (QK_NOPE_DIM + QK_ROPE_DIM) ** -0.5
    key_idx = jnp.arange(S)

    def block(i):
        t0 = i * Q_BLOCK
        qb = lax.dynamic_slice_in_dim(q, t0, Q_BLOCK, axis=1)
        tq = t0 + jnp.arange(Q_BLOCK)
        logits = jnp.einsum('bthd,bshd->bhts', qb, k, preferred_element_type=jnp.float32) * scale
        logits = jnp.where((key_idx[None, :] <= tq[:, None])[None, None], logits, NEG_INF)
        p = jax.nn.softmax(logits, axis=-1).astype(v.dtype)
        return jnp.einsum('bhts,bshd->bthd', p, v)

    out = lax.map(block, jnp.arange(S // Q_BLOCK))
    return jnp.moveaxis(out, 0, 1).reshape(B_, S, B_HEADS * V_HEAD_DIM)


def causal_dwconv(h, w, b):
    S = h.shape[1]
    hp = jnp.pad(h, ((0, 0), (CONV_WIDTH - 1, 0), (0, 0)))
    out = b
    for j in range(CONV_WIDTH):
        out = out + w[j] * hp[:, j:j + S]
    return out


def conv_glu_ffn(u, w_gate, w_up, conv_w, conv_b, w_down):
    g = causal_dwconv(u @ w_gate, conv_w, conv_b)
    return (jax.nn.silu(g) * (u @ w_up)) @ w_down


def setup_inputs(seed: int = 0) -> dict:
    key = jax.random.key(seed)
    ks = jax.random.split(key, 24)
    f32 = jnp.float32
    L = DEPTH

    def nrm(k, shape, scale):
        return jax.random.normal(k, shape, f32) * scale

    x = nrm(ks[0], (BATCH, SEQ, D_MODEL), 1.0)
    c = nrm(ks[1], (BATCH, D_MODEL), 1.0)
    positions = (jax.random.randint(ks[2], (BATCH, 1), 0, 1024, dtype=jnp.int32)
                 + jnp.arange(SEQ, dtype=jnp.int32)[None, :])
    w_ada = nrm(ks[3], (L, D_MODEL, 6 * D_MODEL), 0.1 * D_MODEL ** -0.5)
    b_ada = nrm(ks[4], (L, 6 * D_MODEL), 0.01)
    col_scale = np.ones((IN_WIDTH,), np.float32)
    v_off = IN_SPLITS[0] + IN_SPLITS[1]
    col_scale[v_off:v_off + A_HEAD_DIM] = DEEPNORM_BETA
    w_in = nrm(ks[5], (L, D_MODEL, IN_WIDTH), D_MODEL ** -0.5) * jnp.asarray(col_scale)
    rel_bias = nrm(ks[6], (REL_BUCKETS, A_HEADS), 0.5)
    q_norm_g = 1.0 + nrm(ks[7], (L, Q_LORA_RANK), 0.02)
    w_uq = nrm(ks[8], (L, Q_LORA_RANK, B_HEADS * (QK_NOPE_DIM + QK_ROPE_DIM)), Q_LORA_RANK ** -0.5)
    kv_norm_g = 1.0 + nrm(ks[9], (L, KV_LORA_RANK), 0.02)
    w_uk = nrm(ks[10], (L, KV_LORA_RANK, B_HEADS, QK_NOPE_DIM), KV_LORA_RANK ** -0.5)
    w_uv = nrm(ks[11], (L, KV_LORA_RANK, B_HEADS, V_HEAD_DIM), DEEPNORM_BETA * KV_LORA_RANK ** -0.5)
    w_ukv = jnp.concatenate([w_uk, w_uv], axis=-1).reshape(L, KV_LORA_RANK, B_HEADS * (QK_NOPE_DIM + V_HEAD_DIM))
    w_o = nrm(ks[12], (L, MIX_WIDTH, D_MODEL), DEEPNORM_BETA * MIX_WIDTH ** -0.5)
    ln1_g = 1.0 + nrm(ks[13], (L, D_MODEL), 0.02)
    ln1_b = nrm(ks[14], (L, D_MODEL), 0.02)
    w_gate = nrm(ks[15], (L, D_MODEL, D_FF), D_MODEL ** -0.5)
    w_up = nrm(ks[16], (L, D_MODEL, D_FF), DEEPNORM_BETA * D_MODEL ** -0.5)
    conv_w = nrm(ks[17], (L, CONV_WIDTH, D_FF), CONV_WIDTH ** -0.5)
    conv_b = nrm(ks[18], (L, D_FF), 0.02)
    w_down = nrm(ks[19], (L, D_FF, D_MODEL), DEEPNORM_BETA * D_FF ** -0.5)
    ln2_g = 1.0 + nrm(ks[20], (L, D_MODEL), 0.02)
    ln2_b = nrm(ks[21], (L, D_MODEL), 0.02)
    return {'x': x, 'c': c, 'positions': positions, 'w_ada': w_ada, 'b_ada': b_ada,
            'w_in': w_in, 'rel_bias': rel_bias, 'q_norm_g': q_norm_g, 'w_uq': w_uq,
            'kv_norm_g': kv_norm_g, 'w_ukv': w_ukv, 'w_o': w_o, 'ln1_g': ln1_g, 'ln1_b': ln1_b,
            'w_gate': w_gate, 'w_up': w_up, 'conv_w': conv_w, 'conv_b': conv_b,
            'w_down': w_down, 'ln2_g': ln2_g, 'ln2_b': ln2_b}


def reference(x, c, positions, w_ada, b_ada, w_in, rel_bias, q_norm_g, w_uq, kv_norm_g, w_ukv,
              w_o, ln1_g, ln1_b, w_gate, w_up, conv_w, conv_b, w_down, ln2_g, ln2_b):
    B_, S = x.shape[0], x.shape[1]
    c_act = jax.nn.silu(c)
    for l in range(DEPTH):
        mod = (c_act @ w_ada[l] + b_ada[l])[:, None, :]
        sh_a, sc_a, g_a, sh_f, sc_f, g_f = jnp.split(mod, 6, axis=-1)
        u = x * (1 + sc_a) + sh_a
        a_q, a_k, a_v, i_q, i_k, i_w, b_ql, b_kvl, b_kr = jnp.split(u @ w_in[l], SPLIT_POINTS, axis=-1)
        y_a = dsa_attention(a_q.reshape(B_, S, A_HEADS, A_HEAD_DIM), a_k, a_v,
                            i_q.reshape(B_, S, IDX_HEADS, IDX_HEAD_DIM), i_k, i_w,
                            positions, rel_bias)
        y_b = mla_attention(b_ql, b_kvl, b_kr, positions, q_norm_g[l], w_uq[l], kv_norm_g[l], w_ukv[l])
        mix = jnp.concatenate([y_a, y_b], axis=-1) @ w_o[l]
        x = layer_norm(DEEPNORM_ALPHA * x + (1 + g_a) * mix, ln1_g[l], ln1_b[l])
        u = x * (1 + sc_f) + sh_f
        y = conv_glu_ffn(u, w_gate[l], w_up[l], conv_w[l], conv_b[l], w_down[l])
        x = layer_norm(DEEPNORM_ALPHA * x + (1 + g_f) * y, ln2_g[l], ln2_b[l])
    return x
```

```cpp
#include <hip/hip_runtime.h>
#include <cstdio>
#include <cstdint>

namespace pg8 {
#define PG8_LAS __attribute__((address_space(3)))
typedef unsigned short bf16_t;
typedef short bf16x8 __attribute__((ext_vector_type(8)));
typedef float f32x4 __attribute__((ext_vector_type(4)));
typedef unsigned u32x4 __attribute__((ext_vector_type(4)));
constexpr int BM = 256, BK = 64, HALF = 128, HTB = HALF * BK * 2  , STAGE_BYTES = 8 * HTB, NXCD = 8, WGM = 8;

__host__ __device__ __forceinline__ int lds_byte(int r, int c) { const int st = (r >> 4) * 2 + (c >> 5), rr = r & 15, cc = c & 31, ob = rr * 64 + cc * 2; return st * 1024 + (ob ^ (((ob >> 9) & 1) << 5)); }
__host__ __device__ __forceinline__ void stage_rc(int b, int& R, int& C) { const int st = b / 1024, sb = b % 1024, swz = sb ^ (((sb >> 9) & 1) << 5); R = (st >> 1) * 16 + swz / 64; C = (st & 1) * 32 + (swz % 64) / 2; }
__host__ __device__ __forceinline__ int perm32(int rho) { const int n = rho >> 4, i = rho & 15; return 8 * (i >> 2) + 4 * n + (i & 3); }

struct Unit { int pm, pn; };
struct Gemm { const bf16_t* A; const bf16_t* Bt; int lda, K; };
typedef int i32x4 __attribute__((ext_vector_type(4)));
typedef int i32x8 __attribute__((ext_vector_type(8)));
__device__ __forceinline__ i32x8 cat8(bf16x8 lo, bf16x8 hi) { return __builtin_shufflevector(__builtin_bit_cast(i32x4, lo), __builtin_bit_cast(i32x4, hi), 0, 1, 2, 3, 4, 5, 6, 7); }

struct StaticOrder {
    int nM, nN, nwg, G, c;
    __host__ __device__ void init(int M, int N, int G_, int c_) { nM = M / BM; nN = N / BM; nwg = nM * nN; G = G_; c = c_; }
    __host__ __device__ bool next(int i, Unit& u) const {
        const long L = (long)i * G + c; if (L >= nwg) return false;
        int wgid = (int)L; { const int q = nwg / NXCD, r = nwg % NXCD, xcd = wgid % NXCD, off = wgid / NXCD; wgid = (xcd < r ? xcd * (q + 1) : r * (q + 1) + (xcd - r) * q) + off; }
        const int nig = WGM * nN, gid = wgid / nig, fm = gid * WGM, gsz = (nM - fm) < WGM ? (nM - fm) : WGM;
        u.pm = fm + ((wgid % nig) % gsz); u.pn = (wgid % nig) / gsz; return true;
    }
    __device__ __forceinline__ void a_ready(const Unit&) const {}
    __device__ __forceinline__ void done(const Unit&) const {}
};

__device__ __forceinline__ unsigned cvt_pk_bf16(float lo, float hi) { unsigned r; asm volatile("v_cvt_pk_bf16_f32 %0, %1, %2" : "=v"(r) : "v"(lo), "v"(hi)); return r; }
__device__ __forceinline__ u32x4 pack8(const f32x4 v0, const f32x4 v1) { u32x4 w; w.x = cvt_pk_bf16(v0[0], v0[1]); w.y = cvt_pk_bf16(v0[2], v0[3]); w.z = cvt_pk_bf16(v1[0], v1[1]); w.w = cvt_pk_bf16(v1[2], v1[3]); return w; }
__device__ __forceinline__ void rope8(f32x4& v0, f32x4& v1, const float* rp) {
    const f32x4 c0 = *(const f32x4*)rp, c1 = *(const f32x4*)(rp + 4);
    float a, b;
    a = v0[0] * c0[0] - v0[1] * c0[1]; b = v0[0] * c0[1] + v0[1] * c0[0]; v0[0] = a; v0[1] = b;
    a = v0[2] * c0[2] - v0[3] * c0[3]; b = v0[2] * c0[3] + v0[3] * c0[2]; v0[2] = a; v0[3] = b;
    a = v1[0] * c1[0] - v1[1] * c1[1]; b = v1[0] * c1[1] + v1[1] * c1[0]; v1[0] = a; v1[1] = b;
    a = v1[2] * c1[2] - v1[3] * c1[3]; b = v1[2] * c1[3] + v1[3] * c1[2]; v1[2] = a; v1[3] = b;
}

struct EpiPlain {
    static constexpr bool PERM = true, AFTER_DRAIN = false;
    bf16_t* O; int ldc;
    __device__ __forceinline__ void operator()(const f32x4 (&acc)[2][2][4][2], const Unit& u, int wr, int wc, int fr, int fq) const {
        const int row0 = u.pm * BM + wr * 64 + fr, col0 = u.pn * BM + wc * 32 + 8 * fq;
#pragma unroll
        for (int ai = 0; ai < 2; ++ai)
#pragma unroll
            for (int m = 0; m < 4; ++m) { bf16_t* rowp = O + (size_t)(row0 + ai * HALF + m * 16) * ldc + col0;
#pragma unroll
                for (int bj = 0; bj < 2; ++bj) *(u32x4*)(rowp + bj * HALF) = pack8(acc[ai][bj][m][0], acc[ai][bj][m][1]); }
    }
};

struct EpiProj {
    static constexpr bool PERM = true, AFTER_DRAIN = false;
    bf16_t *AQ, *AKV, *IQ, *IKX, *QL, *KVL; float *IW, *RSQQ, *RSQK; const float* ROPE; bf16_t* KR2;
    __device__ __forceinline__ void operator()(const f32x4 (&acc)[2][2][4][2], const Unit& u, int wr, int wc, int fr, int fq) const {
        const int pn = u.pn; bf16_t* dst; int pitch, coff, kind = 0; unsigned ropemask = 0u;
        if (pn < 8) { dst = AQ; pitch = 2048; coff = pn * 256; }
        else if (pn == 8) { dst = AKV; pitch = 256; coff = 0; }
        else if (pn < 25) { dst = IQ; pitch = 4096; coff = (pn - 9) * 256; ropemask = 0xAu; }
        else if (pn == 25) { dst = IKX; pitch = 256; coff = 0; ropemask = 0x6u; kind = 3; }
        else if (pn < 30) { dst = QL; pitch = 1024; coff = (pn - 26) * 256; kind = 1; }
        else { dst = KVL; pitch = 512; coff = (pn - 30) * 256; kind = 2; }
        const int row0 = u.pm * BM + wr * 64 + fr, lc0 = wc * 32 + 8 * fq, i0 = 16 * (wc & 1) + 4 * fq;
#pragma unroll
        for (int ai = 0; ai < 2; ++ai)
#pragma unroll
            for (int m = 0; m < 4; ++m) {
                const int row = row0 + ai * HALF + m * 16; float ss = 0.f;
#pragma unroll
                for (int bj = 0; bj < 2; ++bj) {
                    f32x4 v0 = acc[ai][bj][m][0], v1 = acc[ai][bj][m][1];
                    if (pn < 8) { v0 = v0 * (0.08838834764831845f * 1.4426950408889634f); v1 = v1 * (0.08838834764831845f * 1.4426950408889634f); }
                    if ((ropemask >> (2 * bj + (wc >> 1))) & 1u) rope8(v0, v1, ROPE + ((size_t)row * 32 + i0) * 2);
                    if (kind == 1 || kind == 2) ss += (v0[0] * v0[0] + v0[1] * v0[1]) + (v0[2] * v0[2] + v0[3] * v0[3]) + (v1[0] * v1[0] + v1[1] * v1[1]) + (v1[2] * v1[2] + v1[3] * v1[3]);
                    if (kind == 3 && bj == 1 && wc == 2) { float* iw = IW + (size_t)row * 32 + 8 * fq; *(f32x4*)iw = v0; *(f32x4*)(iw + 4) = v1; }
                    if (kind == 3 && bj == 1 && wc < 2) *(u32x4*)(KR2 + (size_t)row * 2048 + lc0) = pack8(v0, v1);
                    if (kind == 1 || kind == 2) {
                        int w0 = 0, w1 = 0; w0 = __builtin_amdgcn_cvt_pk_fp8_f32(v0[0], v0[1], w0, false); w0 = __builtin_amdgcn_cvt_pk_fp8_f32(v0[2], v0[3], w0, true);
                        w1 = __builtin_amdgcn_cvt_pk_fp8_f32(v1[0], v1[1], w1, false); w1 = __builtin_amdgcn_cvt_pk_fp8_f32(v1[2], v1[3], w1, true);
                        typedef unsigned u32x2 __attribute__((ext_vector_type(2)));
                        *(u32x2*)((unsigned char*)dst + (size_t)row * pitch + coff + lc0 + bj * HALF) = (u32x2){(unsigned)w0, (unsigned)w1}; }
                    else *(u32x4*)(dst + (size_t)row * pitch + coff + lc0 + bj * HALF) = pack8(v0, v1);
                }
                if (kind == 1 || kind == 2) {
                    ss += __shfl_xor(ss, 16); ss += __shfl_xor(ss, 32);
                    if (fq == 0) { if (kind == 1) RSQQ[(size_t)row * 16 + (pn - 26) * 4 + wc] = ss; else RSQK[(size_t)row * 8 + (pn - 30) * 4 + wc] = ss; }
                }
            }
    }
};

template <bool ISQ> struct EpiUp {
    static constexpr bool PERM = true, AFTER_DRAIN = false;
    bf16_t* O; int ldc; const float* RSQ; const float* ROPE;
    __device__ __forceinline__ void operator()(const f32x4 (&acc)[2][2][4][2], const Unit& u, int wr, int wc, int fr, int fq) const {
        const int row0 = u.pm * BM + wr * 64 + fr, col0 = u.pn * BM + wc * 32 + 8 * fq, i0 = 16 * (wc & 1) + 4 * fq;
#pragma unroll
        for (int ai = 0; ai < 2; ++ai)
#pragma unroll
            for (int m = 0; m < 4; ++m) {
                const int row = row0 + ai * HALF + m * 16; float rs;
                if (ISQ) { const f32x4* p = (const f32x4*)(RSQ + (size_t)row * 16); const f32x4 a = p[0], b = p[1], c = p[2], d = p[3];
                    const float s = ((a[0] + a[1]) + (a[2] + a[3])) + ((b[0] + b[1]) + (b[2] + b[3])) + ((c[0] + c[1]) + (c[2] + c[3])) + ((d[0] + d[1]) + (d[2] + d[3]));
                    rs = (0.07216878364870322f * 1.4426950408889634f / 32.0f) / sqrtf(s * (1.0f / 1024.0f) + 1e-6f); }
                else { const f32x4* p = (const f32x4*)(RSQ + (size_t)row * 8); const f32x4 a = p[0], b = p[1];
                    const float s = ((a[0] + a[1]) + (a[2] + a[3])) + ((b[0] + b[1]) + (b[2] + b[3]));
                    rs = (1.0f / 16.0f) / sqrtf(s * (1.0f / 512.0f) + 1e-6f); }
#pragma unroll
                for (int bj = 0; bj < 2; ++bj) {
                    f32x4 v0 = acc[ai][bj][m][0] * rs, v1 = acc[ai][bj][m][1] * rs;
                    if (ISQ) { if ((4 * u.pn + 2 * bj + (wc >> 1)) % 3 == 2) rope8(v0, v1, ROPE + ((size_t)row * 32 + i0) * 2); }
                    *(u32x4*)(O + (size_t)row * ldc + col0 + bj * HALF) = pack8(v0, v1);
                }
            }
    }
};

struct EpiVT {
    static constexpr bool PERM = true, AFTER_DRAIN = false;
    bf16_t* O; const float* RSQ;
    __device__ __forceinline__ void operator()(const f32x4 (&acc)[2][2][4][2], const Unit& u, int wr, int wc, int fr, int fq) const {
        const int row0 = u.pm * BM + wr * 64 + fr, col0 = u.pn * BM + wc * 32 + 8 * fq;
        f32x4 rs[2][2];
#pragma unroll
        for (int bj = 0; bj < 2; ++bj)
#pragma unroll
            for (int e = 0; e < 8; ++e) { const f32x4* p = (const f32x4*)(RSQ + (size_t)(col0 + bj * HALF + e) * 8); const f32x4 a = p[0], b = p[1];
                const float s = ((a[0] + a[1]) + (a[2] + a[3])) + ((b[0] + b[1]) + (b[2] + b[3]));
                rs[bj][e >> 2][e & 3] = (1.0f / 16.0f) / sqrtf(s * (1.0f / 512.0f) + 1e-6f); }
#pragma unroll
        for (int ai = 0; ai < 2; ++ai)
#pragma unroll
            for (int m = 0; m < 4; ++m) { bf16_t* rowp = O + (size_t)(row0 + ai * HALF + m * 16) * 8192 + col0;
#pragma unroll
                for (int bj = 0; bj < 2; ++bj) *(u32x4*)(rowp + bj * HALF) = pack8(acc[ai][bj][m][0] * rs[bj][0], acc[ai][bj][m][1] * rs[bj][1]); }
    }
};

struct EpiZ {
    static constexpr bool PERM = false, AFTER_DRAIN = false;
    const float* R; float* Z; const float* gate; float alpha, ascale;
    __device__ __forceinline__ void operator()(const f32x4 (&acc)[2][2][4][2], const Unit& u, int wr, int wc, int fr, int fq) const {
        const int row0 = u.pm * BM + wr * 64 + fr, col0 = u.pn * BM + wc * 32 + 4 * fq;
        const float* gp = gate + (size_t)((u.pm * BM) >> 11) * 24576 + col0;
        f32x4 gv[2][2];
#pragma unroll
        for (int bj = 0; bj < 2; ++bj)
#pragma unroll
            for (int n = 0; n < 2; ++n) gv[bj][n] = (*(const f32x4*)(gp + bj * HALF + 16 * n) + 1.0f) * ascale;
#pragma unroll
        for (int ai = 0; ai < 2; ++ai)
#pragma unroll
            for (int m = 0; m < 4; ++m) { const size_t ro = (size_t)(row0 + ai * HALF + m * 16) * 4096 + col0;
#pragma unroll
                for (int bj = 0; bj < 2; ++bj)
#pragma unroll
                    for (int n = 0; n < 2; ++n) { const f32x4 r = *(const f32x4*)(R + ro + bj * HALF + 16 * n);
                        *(f32x4*)(Z + ro + bj * HALF + 16 * n) = r * alpha + gv[bj][n] * acc[ai][bj][m][n]; } }
    }
};

template <class Epi, class Sched, bool ALIGN_EPI = false, bool SP2 = false, bool FP8 = false>
__device__ __forceinline__ void gemm_phase(PG8_LAS unsigned char* lds, const Gemm g, const Sched& S, const Epi& E) {
    const int tid = threadIdx.x, wid = __builtin_amdgcn_readfirstlane(tid >> 6), lane = tid & 63, wr = wid >> 2, wc = wid & 3, fr = lane & 15, fq = lane >> 4;
    const int K = g.K, nt = K / BK, lda = g.lda;
    unsigned voffA[2], voffB[2];
#pragma unroll
    for (int i = 0; i < 2; ++i) { int R, C; stage_rc(tid * 16 + i * 8192, R, C); const int Rb = Epi::PERM ? ((R & ~31) + perm32(R & 31)) : R;
        voffA[i] = (unsigned)(R * lda + C) * 2u; voffB[i] = (unsigned)(Rb * K + C) * 2u; }
    const size_t kstep = (size_t)(BK * 2);
    const size_t hstep = (size_t)HALF * K * 2, hstepA = (size_t)HALF * lda * 2;
    const size_t tstep = 2 * hstep, tstepA = 2 * hstepA;
    const unsigned ldsw = (unsigned)wid * 1024u;
    const int aoff = lds_byte(wr * 64 + fr, fq * 8), boff = lds_byte(wc * 32 + fr, fq * 8);
#define PG8_SA(b, h) (((b) * 2 + (h)) * HTB)
#define PG8_SB(b, h) ((4 + (b) * 2 + (h)) * HTB)
#define PG8_STAGE(bufoff, gbase, voff) do { _Pragma("unroll") for (int _i = 0; _i < 2; ++_i) \
        __builtin_amdgcn_global_load_lds((const unsigned*)((const char*)(gbase) + (voff)[_i]), (PG8_LAS unsigned*)(lds + (bufoff) + ldsw + _i * 8192), 16, 0, 0); } while (0)
#define PG8_LDA(dst, b, h) do { if constexpr (FP8) { _Pragma("unroll") for (int m = 0; m < 4; ++m) dst##8[m] = __builtin_shufflevector(*(const PG8_LAS i32x4*)(lds + PG8_SA(b, h) + aoff + m * 2048), *(const PG8_LAS i32x4*)(lds + PG8_SA(b, h) + aoff + m * 2048 + 1024), 0, 1, 2, 3, 4, 5, 6, 7); } \
        else { _Pragma("unroll") for (int m = 0; m < 4; ++m) _Pragma("unroll") for (int k = 0; k < 2; ++k) dst[m][k] = *(const PG8_LAS bf16x8*)(lds + PG8_SA(b, h) + aoff + m * 2048 + k * 1024); } } while (0)
#define PG8_LDB(dst, b, h) do { if constexpr (FP8) { _Pragma("unroll") for (int n = 0; n < 2; ++n) dst##8[n] = __builtin_shufflevector(*(const PG8_LAS i32x4*)(lds + PG8_SB(b, h) + boff + n * 2048), *(const PG8_LAS i32x4*)(lds + PG8_SB(b, h) + boff + n * 2048 + 1024), 0, 1, 2, 3, 4, 5, 6, 7); } \
        else { _Pragma("unroll") for (int n = 0; n < 2; ++n) _Pragma("unroll") for (int k = 0; k < 2; ++k) dst[n][k] = *(const PG8_LAS bf16x8*)(lds + PG8_SB(b, h) + boff + n * 2048 + k * 1024); } } while (0)
#define PG8_MMA(ai, bj, At, Bt) do { __builtin_amdgcn_s_setprio(1); \
        if constexpr (FP8) { _Pragma("unroll") for (int m = 0; m < 4; ++m) _Pragma("unroll") for (int n = 0; n < 2; ++n) \
            asm volatile("v_mfma_f32_16x16x128_f8f6f4 %0, %1, %2, %0" : "+v"(acc[ai][bj][m][n]) : "v"(Bt##8[n]), "v"(At##8[m])); } \
        else { _Pragma("unroll") for (int m = 0; m < 4; ++m) _Pragma("unroll") for (int n = 0; n < 2; ++n) _Pragma("unroll") for (int k = 0; k < 2; ++k) \
            acc[ai][bj][m][n] = __builtin_amdgcn_mfma_f32_16x16x32_bf16(Bt[n][k], At[m][k], acc[ai][bj][m][n], 0, 0, 0); } \
        __builtin_amdgcn_s_setprio(0); } while (0)
#define PG8_WAIT_V(n) asm volatile("s_waitcnt vmcnt(" #n ")" ::: "memory")
#define PG8_WAIT_L(n) asm volatile("s_waitcnt lgkmcnt(" #n ")" ::: "memory")
#define PG8_BAR __builtin_amdgcn_s_barrier()
#define PG8_SCHED __builtin_amdgcn_sched_barrier(0)
    Unit cur, nxt; int ui = 0;
    if (!S.next(0, cur)) return;
    f32x4 acc[2][2][4][2];
#pragma unroll
    for (int a = 0; a < 2; ++a)
#pragma unroll
        for (int b = 0; b < 2; ++b)
#pragma unroll
            for (int m = 0; m < 4; ++m)
#pragma unroll
                for (int n = 0; n < 2; ++n) acc[a][b][m][n] = (f32x4){0.f, 0.f, 0.f, 0.f};
    bf16x8 At[4][2], B0[2][2], B1[2][2]; i32x8 At8[4], B08[2], B18[2];
    const char* cA = (const char*)g.A + (size_t)cur.pm * tstepA; const char* cB = (const char*)g.Bt + (size_t)cur.pn * tstep;
    S.a_ready(cur);
    if constexpr (SP2) {
        PG8_STAGE(PG8_SB(0, 0), cB, voffB); PG8_STAGE(PG8_SB(0, 1), cB + hstep, voffB); PG8_STAGE(PG8_SA(0, 0), cA, voffA); PG8_STAGE(PG8_SA(0, 1), cA + hstepA, voffA);
        if (wr == 1) PG8_BAR;
        PG8_WAIT_V(2); PG8_BAR;
        PG8_STAGE(PG8_SB(1, 0), cB + kstep, voffB); PG8_STAGE(PG8_SA(1, 0), cA + kstep, voffA); PG8_STAGE(PG8_SB(1, 1), cB + hstep + kstep, voffB);
        PG8_WAIT_V(6); PG8_BAR;
    } else {
        PG8_STAGE(PG8_SB(0, 0), cB, voffB); PG8_STAGE(PG8_SA(0, 0), cA, voffA); PG8_STAGE(PG8_SB(0, 1), cB + hstep, voffB); PG8_STAGE(PG8_SA(0, 1), cA + hstepA, voffA);
        if (wr == 1) PG8_BAR;
        PG8_WAIT_V(4); PG8_BAR;
        PG8_STAGE(PG8_SB(1, 0), cB + kstep, voffB); PG8_STAGE(PG8_SA(1, 0), cA + kstep, voffA); PG8_STAGE(PG8_SB(1, 1), cB + hstep + kstep, voffB);
        PG8_WAIT_V(6); PG8_BAR;
    }
    for (;;) {
        const bool has_next = S.next(ui + 1, nxt);
        const char* nA = has_next ? (const char*)g.A + (size_t)nxt.pm * tstepA : cA; const char* nB = has_next ? (const char*)g.Bt + (size_t)nxt.pn * tstep : cB;
        for (int t = 0; t < nt; t += 2) {
            const bool last = (t == nt - 2);
            const char* a1 = cA + (size_t)(t + 1) * kstep;
            const char* a2 = last ? nA : cA + (size_t)(t + 2) * kstep; const char* b2 = last ? nB : cB + (size_t)(t + 2) * kstep;
            const char* a3 = a2 + kstep; const char* b3 = b2 + kstep;
            if (last && has_next) S.a_ready(nxt);
            if constexpr (SP2) {
            PG8_LDB(B0, 0, 0); PG8_LDB(B1, 0, 1); PG8_SCHED; PG8_LDA(At, 0, 0); PG8_STAGE(PG8_SA(1, 1), a1 + hstepA, voffA);
            PG8_WAIT_V(8); PG8_WAIT_L(0); PG8_BAR; PG8_MMA(0, 0, At, B0); PG8_MMA(0, 1, At, B1); PG8_BAR; PG8_SCHED;
            PG8_LDA(At, 0, 1); PG8_STAGE(PG8_SB(0, 0), b2, voffB); PG8_STAGE(PG8_SB(0, 1), b2 + hstep, voffB); PG8_STAGE(PG8_SA(0, 0), a2, voffA);
            PG8_WAIT_V(8); PG8_WAIT_L(0); PG8_BAR; PG8_MMA(1, 0, At, B0); PG8_MMA(1, 1, At, B1); PG8_BAR; PG8_SCHED;
            PG8_LDB(B0, 1, 0); PG8_LDB(B1, 1, 1); PG8_SCHED; PG8_LDA(At, 1, 0); PG8_STAGE(PG8_SA(0, 1), a2 + hstepA, voffA);
            PG8_WAIT_V(8); PG8_WAIT_L(0); PG8_BAR; PG8_MMA(0, 0, At, B0); PG8_MMA(0, 1, At, B1); PG8_BAR; PG8_SCHED;
            PG8_LDA(At, 1, 1); PG8_STAGE(PG8_SB(1, 0), b3, voffB); PG8_STAGE(PG8_SB(1, 1), b3 + hstep, voffB); PG8_STAGE(PG8_SA(1, 0), a3, voffA);
            PG8_WAIT_V(8); PG8_WAIT_L(0); PG8_BAR; PG8_MMA(1, 0, At, B0); PG8_MMA(1, 1, At, B1); PG8_BAR; PG8_SCHED;
            } else {
            PG8_LDB(B0, 0, 0); PG8_SCHED; PG8_LDA(At, 0, 0); PG8_STAGE(PG8_SA(1, 1), a1 + hstepA, voffA);
            PG8_WAIT_L(8); PG8_BAR; PG8_WAIT_L(0); PG8_MMA(0, 0, At, B0); PG8_BAR; PG8_SCHED;
            PG8_LDB(B1, 0, 1); PG8_STAGE(PG8_SB(0, 0), b2, voffB);
            PG8_BAR; PG8_WAIT_L(0); PG8_MMA(0, 1, At, B1); PG8_BAR;
            PG8_LDA(At, 0, 1); PG8_STAGE(PG8_SA(0, 0), a2, voffA);
            PG8_BAR; PG8_WAIT_L(0); PG8_MMA(1, 0, At, B0); PG8_BAR; PG8_SCHED;
            PG8_STAGE(PG8_SB(0, 1), b2 + hstep, voffB);
            PG8_WAIT_V(6); PG8_BAR; PG8_MMA(1, 1, At, B1); PG8_BAR;
            PG8_LDB(B0, 1, 0); PG8_SCHED; PG8_LDA(At, 1, 0); PG8_STAGE(PG8_SA(0, 1), a2 + hstepA, voffA);
            PG8_WAIT_L(8); PG8_BAR; PG8_WAIT_L(0); PG8_MMA(0, 0, At, B0); PG8_BAR; PG8_SCHED;
            PG8_LDB(B1, 1, 1); PG8_STAGE(PG8_SB(1, 0), b3, voffB);
            PG8_BAR; PG8_WAIT_L(0); PG8_MMA(0, 1, At, B1); PG8_BAR;
            PG8_LDA(At, 1, 1); PG8_STAGE(PG8_SA(1, 0), a3, voffA);
            PG8_BAR; PG8_WAIT_L(0); PG8_MMA(1, 0, At, B0); PG8_BAR; PG8_SCHED;
            PG8_STAGE(PG8_SB(1, 1), b3 + hstep, voffB);
            PG8_WAIT_V(6); PG8_BAR; PG8_MMA(1, 1, At, B1); PG8_BAR;
            }
        }
        if constexpr (ALIGN_EPI) { if (wr == 0) PG8_BAR; }
        if constexpr (!Epi::AFTER_DRAIN) { E(acc, cur, wr, wc, fr, fq); S.done(cur); }
        if (!has_next) break;
#pragma unroll
        for (int a = 0; a < 2; ++a)
#pragma unroll
            for (int b = 0; b < 2; ++b)
#pragma unroll
                for (int m = 0; m < 4; ++m)
#pragma unroll
                    for (int n = 0; n < 2; ++n) acc[a][b][m][n] = (f32x4){0.f, 0.f, 0.f, 0.f};
        cur = nxt; cA = nA; cB = nB; ++ui;
        if constexpr (ALIGN_EPI) { if (wr == 1) PG8_BAR; }
    }
    PG8_WAIT_V(0);
    if constexpr (!ALIGN_EPI) { if (wr == 0) PG8_BAR; }
    PG8_BAR;
    if constexpr (Epi::AFTER_DRAIN) { E.fused(acc, cur, wr, wc, fr, fq, lds, wid, lane); S.done(cur); }
#undef PG8_SA
#undef PG8_SB
#undef PG8_STAGE
#undef PG8_LDA
#undef PG8_LDB
#undef PG8_MMA
#undef PG8_WAIT_V
#undef PG8_WAIT_L
#undef PG8_BAR
#undef PG8_SCHED
}
}
constexpr int NWAVES = 8;
constexpr int BATCH = 4, SEQ = 2048, D = 4096, M = BATCH * SEQ, FF = 11008, NIN = 8192  , NGU = 2 * FF;
constexpr int N_PHASES = 11;
#ifndef DSA_NAIVE
#define DSA_NAIVE 0
#endif
#ifndef MK_ONE_LAUNCH
#define MK_ONE_LAUNCH 1
#endif
constexpr float LN_EPS = 1e-5f, ALPHA = 1.189207115002721f;

constexpr size_t MiB = 1u << 20;
constexpr size_t WS_CTL = 0, CTL_ZERO_BYTES = 1 * MiB;
constexpr size_t WS_MOD = 1 * MiB, WS_ROPE = 2 * MiB, WS_RSQQ = 4 * MiB, WS_RSQK = 4 * MiB + 512 * 1024, WS_IW = 5 * MiB, WS_VTA = 6 * MiB;
constexpr size_t WS_WIN = 8 * MiB, WS_WUQ = 72 * MiB, WS_WUKV = 78 * MiB, WS_WO = 82 * MiB, WS_WGU = 114 * MiB, WS_WD = 286 * MiB;
constexpr size_t WS_U = 372 * MiB, WS_AQ = 436 * MiB, WS_AKV = 468 * MiB, WS_IQ = 472 * MiB, WS_IKX = 536 * MiB, WS_QL = 540 * MiB, WS_KVL = 556 * MiB;
constexpr size_t WS_QB = 564 * MiB, WS_KV = 612 * MiB, WS_KN = 612 * MiB, WS_VT = 644 * MiB, WS_SC = 676 * MiB, WS_MIX = 740 * MiB, WS_Z1 = 804 * MiB, WS_X1 = 932 * MiB;
constexpr size_t WS_GU = 436 * MiB  , WS_H = 1060 * MiB, WS_KR2 = 1232 * MiB  , WS_END = 1264 * MiB;
static_assert(WS_GU + (size_t)M * NGU * 2 <= WS_X1, "GU overlay");
constexpr int CW_TMO = 0, CW_CODE = 1, CW_BAR = 4096;

constexpr int RING_OFF = 0, RING_BYTES = 131072;
constexpr int LDSCTL_OFF = 157696, MISC_OFF = LDSCTL_OFF + 320;
constexpr int LDS_BYTES = 160768;

#define GAS __attribute__((address_space(1)))
#define LAS __attribute__((address_space(3)))
typedef unsigned short bf16;
typedef unsigned v4u __attribute__((ext_vector_type(4)));
typedef unsigned v2u __attribute__((ext_vector_type(2)));
typedef float f32x4 __attribute__((ext_vector_type(4)));
typedef float f32x2 __attribute__((ext_vector_type(2)));
typedef GAS unsigned gu32;
#define RLX_AGENT __ATOMIC_RELAXED, __HIP_MEMORY_SCOPE_AGENT
#define LDS_WAIT() asm volatile("s_waitcnt lgkmcnt(0)" ::: "memory")
#define VM_WAIT() asm volatile("s_waitcnt vmcnt(0)" ::: "memory")
__device__ __forceinline__ unsigned f2bf(float f) { unsigned u = __builtin_bit_cast(unsigned, f); return (u + 0x7fffu + ((u >> 16) & 1u)) >> 16; }
__device__ __forceinline__ unsigned pk2(float lo, float hi) { return f2bf(lo) | (f2bf(hi) << 16); }
__device__ __forceinline__ float bflo(unsigned w) { return __builtin_bit_cast(float, w << 16); }
__device__ __forceinline__ float bfhi(unsigned w) { return __builtin_bit_cast(float, w & 0xffff0000u); }

#define XB_TMO      128
#define XB_XCNT(j)  (256  + 64 * (j))
#define XB_XSUB(j)  (1280 + 64 * (j))
#define XB_XGEN(j)  (2304 + 64 * (j))
#define XB_TOP      3328
#define XB_TOPGEN   3392
#define XCD_BAR_WORDS 3456
#define XB_SPIN_CAP (1u << 18)
__device__ __forceinline__ unsigned xb_ld(unsigned* p)              { return __hip_atomic_load(p, __ATOMIC_RELAXED, __HIP_MEMORY_SCOPE_AGENT); }
__device__ __forceinline__ unsigned xb_add(unsigned* p, unsigned v) { return __hip_atomic_fetch_add(p, v, __ATOMIC_RELAXED, __HIP_MEMORY_SCOPE_AGENT); }
__device__ __forceinline__ unsigned xb_xcc_id() { return (unsigned)__builtin_amdgcn_s_getreg((3 << 11) | 20) & 0xFu; }
#define XB_SPIN(cond, bar) do { unsigned _sp = 0; while (cond) { __builtin_amdgcn_s_sleep(1); \
    if ((++_sp & 255u) == 0u) { if (xb_ld(&(bar)[XB_TMO])) break; if (_sp > XB_SPIN_CAP) { atomicAdd(&(bar)[XB_TMO], 1u); break; } } } } while (0)
struct XcdBarrier { unsigned* bar; unsigned x; volatile LAS unsigned* st; };
__device__ __forceinline__ XcdBarrier xcd_barrier_post(unsigned* bar, volatile LAS unsigned* st) {
    XcdBarrier b; b.bar = bar; b.x = xb_xcc_id(); b.st = st;
    if (threadIdx.x == 0) (void)xb_add(&bar[XB_XCNT(b.x)], 1u);
    return b;
}
__device__ __forceinline__ void xcd_barrier_complete(unsigned* bar, unsigned x, unsigned& nloc, unsigned& nx) {
    const unsigned G = gridDim.x * gridDim.y * gridDim.z;
    unsigned sum, cnt, mine, sp = 0u;
    for (;;) {
        sum = 0u; cnt = 0u; mine = 0u;
#pragma unroll
        for (unsigned j = 0; j < 16; ++j) { const unsigned c = xb_ld(&bar[XB_XCNT(j)]); sum += c; cnt += (c > 0u) ? 1u : 0u; mine = (j == x) ? c : mine; }
        if (sum == G) break;
        __builtin_amdgcn_s_sleep(1);
        if ((++sp & 255u) == 0u) { if (xb_ld(&bar[XB_TMO])) break; if (sp > XB_SPIN_CAP) { atomicAdd(&bar[XB_TMO], 1u); break; } }
    }
    nloc = mine > 0u ? mine : 1u; nx = cnt > 0u ? cnt : 1u;
}
__device__ __forceinline__ void xcd_barrier(const XcdBarrier& b) {
    asm volatile("s_waitcnt vmcnt(0)" ::: "memory");
    __syncthreads();
    if (threadIdx.x == 0) {
        unsigned* bar = b.bar;
        __builtin_amdgcn_s_waitcnt(0);
        unsigned nloc = b.st[0], nx = b.st[1];
        if (nloc == 0u) { xcd_barrier_complete(bar, b.x, nloc, nx); b.st[0] = nloc; b.st[1] = nx; }
        const unsigned old = xb_add(&bar[XB_XSUB(b.x)], 1u);
        const unsigned gen = old / nloc;
        if (old + 1u == (gen + 1u) * nloc) {
            __builtin_amdgcn_fence(__ATOMIC_RELEASE, "agent");
            asm volatile("s_waitcnt vmcnt(0)" ::: "memory");
            const unsigned og = xb_add(&bar[XB_TOP], 1u);
            const unsigned tg = og / nx;
            if (og + 1u == (tg + 1u) * nx) xb_add(&bar[XB_TOPGEN], 1u);
            else XB_SPIN(xb_ld(&bar[XB_TOPGEN]) == tg, bar);
            __builtin_amdgcn_fence(__ATOMIC_ACQUIRE, "agent");
            xb_add(&bar[XB_XGEN(b.x)], 1u);
            asm volatile("s_waitcnt vmcnt(0)" ::: "memory");
        } else {
            XB_SPIN(xb_ld(&bar[XB_XGEN(b.x)]) == gen, bar);
            __builtin_amdgcn_fence(__ATOMIC_ACQUIRE, "agent");
            asm volatile("s_waitcnt vmcnt(0)" ::: "memory");
        }
    }
    __syncthreads();
}

struct Frame {
    LAS unsigned char* lds;
    volatile LAS unsigned* MISC;
    gu32* ctl;
    int tid, lane, wave;
    int vcu, G;
    unsigned char* ws;
    const float* in[21];
    float* out;
};
__device__ __forceinline__ float wave_sum(float v) {
#pragma unroll
    for (int o = 1; o < 64; o <<= 1) v += __shfl_xor(v, o);
    return v;
}
__device__ __forceinline__ float wave_max(float v) {
#pragma unroll
    for (int o = 1; o < 64; o <<= 1) v = fmaxf(v, __shfl_xor(v, o));
    return v;
}
__device__ __forceinline__ int wave_isum(int v) {
#pragma unroll
    for (int o = 1; o < 64; o <<= 1) v += __shfl_xor(v, o);
    return v;
}
enum { I_X = 0, I_C, I_POS, I_WADA, I_BADA, I_WIN, I_RELB, I_QG, I_WUQ, I_KVG, I_WUKV, I_WO, I_LN1G, I_LN1B, I_WG, I_WU, I_CW, I_CB, I_WD, I_LN2G, I_LN2B };

__device__ const unsigned char BUCKET_TAB[128] = {0, 1, 2, 3, 4, 5, 6, 7, 8, 9, 10, 11, 12, 13, 14, 15, 16, 16, 16, 17, 17, 18, 18, 18, 19, 19, 19, 20, 20, 20, 20, 21, 21, 21, 21, 22, 22, 22, 22, 22, 23, 23, 23, 23, 23, 23, 24, 24, 24, 24, 24, 24, 25, 25, 25, 25, 25, 25, 25, 26, 26, 26, 26, 26, 26, 26, 26, 27, 27, 27, 27, 27, 27, 27, 27, 27, 27, 28, 28, 28, 28, 28, 28, 28, 28, 28, 28, 29, 29, 29, 29, 29, 29, 29, 29, 29, 29, 29, 29, 30, 30, 30, 30, 30, 30, 30, 30, 30, 30, 30, 30, 30, 30, 31, 31, 31, 31, 31, 31, 31, 31, 31, 31, 31, 31, 31, 31, 31};
__device__ const double ROPE_FREV[32] = {
    0.15915494309189535, 0.11934937021124886, 0.08949940160889101, 0.06711508300522726,
    0.050329212104487035, 0.03774158471741977, 0.0283021958306234, 0.02122365276477766,
    0.015915494309189534, 0.011934937021124886, 0.008949940160889102, 0.006711508300522725,
    0.005032921210448704, 0.003774158471741977, 0.00283021958306234, 0.0021223652764777662,
    0.0015915494309189536, 0.0011934937021124885, 0.0008949940160889102, 0.0006711508300522726,
    0.0005032921210448703, 0.00037741584717419774, 0.00028302195830623395, 0.0002122365276477766,
    0.00015915494309189535, 0.00011934937021124886, 8.949940160889102e-05, 6.711508300522725e-05,
    5.0329212104487035e-05, 3.774158471741978e-05, 2.8302195830623396e-05, 2.122365276477766e-05
};

__device__ __forceinline__ int colmap(int kind, int c) {
    if (kind == 0) return c;
    if (kind == 1) {
        if (c < 2304) return c;
        if (c < 6528) { const int base = (c < 6400) ? 2304 : 6400; const int r = c - base, h = r >> 7, d = r & 127;
            if (d < 64) return c; const int j = d - 64; return base + h * 128 + 64 + 2 * (j & 31) + (j >> 5); }
        if (c < 6560) return 6592 + (c - 6528);
        if (c < 7584) return 6656 + (c - 6560);
        if (c < 8096) return 7680 + (c - 7584);
        const int j = c - 8096; return 6528 + 2 * (j & 31) + (j >> 5);
    }
    if (kind == 2) { const int h = c / 192, d = c - h * 192; if (d < 128) return c; const int j = d - 128; return h * 192 + 128 + 2 * (j & 31) + (j >> 5); }
    if (kind == 3) return (c >> 7) * 256 + (c & 127);
    if (kind == 5) return (c >> 8) * 128 + (c & 127) + ((c & 128) ? 2048 : 0);
    return (c >> 7) * 256 + 128 + (c & 127);
}
constexpr int TT_IN = 32 * 64, TT_UQ = 8 * 24, TT_UKV = 4 * 32, TT_O = 32 * 32, TT_G = 32 * 86, TT_D = 86 * 32;
constexpr int TT_TOTAL = TT_IN + TT_UQ + TT_UKV + TT_O + 2 * TT_G + TT_D;
struct TJob { const float* W; const float* scale; bf16* WT; int K, N, kind, k0, n0; float f8s; };
__device__ __forceinline__ TJob tjob(const Frame& F, int t) {
    TJob j; j.scale = nullptr; j.f8s = 0.f; int nnt;
    if (t < TT_IN) { j.W = F.in[I_WIN]; j.WT = (bf16*)(F.ws + WS_WIN); j.K = 4096; j.N = 8160; j.kind = 1; nnt = 64; }
    else if ((t -= TT_IN) < TT_UQ) { j.W = F.in[I_WUQ]; j.scale = F.in[I_QG]; j.WT = (bf16*)(F.ws + WS_WUQ); j.K = 1024; j.N = 3072; j.kind = 2; j.f8s = 32.0f; nnt = 24; }
    else if ((t -= TT_UQ) < TT_UKV) { j.W = F.in[I_WUKV]; j.scale = F.in[I_KVG]; j.WT = (bf16*)(F.ws + WS_WUKV); j.K = 512; j.N = 4096; j.kind = 5; j.f8s = 16.0f; nnt = 32; }
    else if ((t -= TT_UKV) < TT_O) { j.W = F.in[I_WO]; j.WT = (bf16*)(F.ws + WS_WO); j.K = 4096; j.N = 4096; j.kind = 0; j.f8s = 128.0f; nnt = 32; }
    else if ((t -= TT_O) < TT_G) { j.W = F.in[I_WG]; j.WT = (bf16*)(F.ws + WS_WGU); j.K = 4096; j.N = FF; j.kind = 3; nnt = 86; }
    else if ((t -= TT_G) < TT_G) { j.W = F.in[I_WU]; j.WT = (bf16*)(F.ws + WS_WGU); j.K = 4096; j.N = FF; j.kind = 4; nnt = 86; }
    else { t -= TT_G; j.W = F.in[I_WD]; j.WT = (bf16*)(F.ws + WS_WD); j.K = FF; j.N = 4096; j.kind = 0; nnt = 32; }
    j.k0 = (t / nnt) * 128; j.n0 = (t % nnt) * 128; return j;
}
__device__ __forceinline__ void tr_load(const Frame& F, int t, f32x4 (&ld)[8]) {
    const TJob j = tjob(F, t); const int rsub = F.lane >> 5, c4 = F.lane & 31, n = j.n0 + 4 * c4;
#pragma unroll
    for (int i = 0; i < 8; ++i) { const int k = j.k0 + 16 * F.wave + 2 * i + rsub;
        f32x4 v = (f32x4){0.f, 0.f, 0.f, 0.f};
        if (n < j.N) v = __builtin_nontemporal_load((const f32x4*)(j.W + (size_t)k * j.N + n));
        if (j.scale) v = v * j.scale[k];
        ld[i] = v; }
}
__device__ __forceinline__ void p0_prologue(Frame& F) {
    const int g = blockIdx.x, G = F.G;
    { float* ROPE = (float*)(F.ws + WS_ROPE); const int* pos = (const int*)F.in[I_POS];
      for (int idx = g * 512 + F.tid; idx < M * 32; idx += G * 512) { const int m = idx >> 5, i = idx & 31;
          const double r = (double)pos[m] * ROPE_FREV[i]; const float fr = (float)(r - __builtin_floor(r)) * 2.0f;
          ROPE[2 * idx] = cospif(fr); ROPE[2 * idx + 1] = sinpif(fr); } }
    { v4u* z = (v4u*)((bf16*)(F.ws + WS_WIN) + (size_t)6624 * 4096);
      for (int idx = g * 512 + F.tid; idx < 32 * 4096 / 8; idx += G * 512) z[idx] = (v4u){0u, 0u, 0u, 0u}; }
    {
        LAS float* CACT = (LAS float*)F.lds; LAS float* RED = (LAS float*)(F.lds + 65536);
        for (int idx = F.tid; idx < 4 * 4096; idx += 512) { const float c = F.in[I_C][idx]; CACT[idx] = c / (1.0f + __expf(-c)); }
        __syncthreads();
        for (int it = g; it < 256; it += G) {
            const int ln = F.lane < 48 ? F.lane : 47; const float* wp = F.in[I_WADA] + (size_t)(512 * F.wave) * 24576 + it * 96 + 2 * ln;
            f32x2 acc[4];
#pragma unroll
            for (int b = 0; b < 4; ++b) acc[b] = (f32x2){0.f, 0.f};
            for (int k = 0; k < 512; k += 16) {
                f32x2 wv[16];
#pragma unroll
                for (int i = 0; i < 16; ++i) wv[i] = __builtin_nontemporal_load((const f32x2*)(wp + (size_t)(k + i) * 24576));
#pragma unroll
                for (int i = 0; i < 16; ++i)
#pragma unroll
                    for (int b = 0; b < 4; ++b) acc[b] += wv[i] * CACT[b * 4096 + 512 * F.wave + k + i];
            }
            if (F.lane < 48) {
#pragma unroll
                for (int b = 0; b < 4; ++b) *(LAS f32x2*)(RED + (F.wave * 4 + b) * 96 + 2 * F.lane) = acc[b]; }
            __syncthreads();
            if (F.tid < 384) { const int b = F.tid / 96, c = F.tid % 96; float s = F.in[I_BADA][it * 96 + c];
#pragma unroll
              for (int w = 0; w < 8; ++w) s += RED[(w * 4 + b) * 96 + c];
              ((float*)(F.ws + WS_MOD))[b * 24576 + it * 96 + c] = s; }
            __syncthreads();
        }
    }
    {
        const int tb = (int)((long)TT_TOTAL * g / G), te = (int)((long)TT_TOTAL * (g + 1) / G);
        LAS float* T = (LAS float*)F.lds;
        f32x4 ldA[8], ldB[8];
        if (tb < te) tr_load(F, tb, ldA);
        if (tb + 1 < te) tr_load(F, tb + 1, ldB);
#define TR_STEP(LD, t_) do { \
            { const int rsub = F.lane >> 5, c4 = F.lane & 31; \
              _Pragma("unroll") for (int i = 0; i < 8; ++i) { const int k = 16 * F.wave + 2 * i + rsub; *(LAS f32x4*)(T + 132 * k + ((4 * c4) ^ (4 * ((k >> 3) & 15)))) = LD[i]; } } \
            __syncthreads(); \
            const TJob j = tjob(F, (t_)); \
            if ((t_) + 2 < te) tr_load(F, (t_) + 2, LD); \
            { const int c = F.lane & 15; \
              _Pragma("unroll") for (int q = 0; q < 4; ++q) { const int n = (F.lane >> 4) + 4 * F.wave + 32 * q; const LAS float* s = T + 132 * (8 * c) + (n ^ (4 * c)); \
                  if (j.f8s != 0.f) { const float fs = j.f8s; int w0 = 0, w1 = 0; \
                      w0 = __builtin_amdgcn_cvt_pk_fp8_f32(s[0] * fs, s[132] * fs, w0, false); w0 = __builtin_amdgcn_cvt_pk_fp8_f32(s[2 * 132] * fs, s[3 * 132] * fs, w0, true); \
                      w1 = __builtin_amdgcn_cvt_pk_fp8_f32(s[4 * 132] * fs, s[5 * 132] * fs, w1, false); w1 = __builtin_amdgcn_cvt_pk_fp8_f32(s[6 * 132] * fs, s[7 * 132] * fs, w1, true); \
                      if (j.n0 + n < j.N) *(v2u*)((unsigned char*)j.WT + (size_t)colmap(j.kind, j.n0 + n) * j.K + j.k0 + 8 * c) = (v2u){(unsigned)w0, (unsigned)w1}; } \
                  else { v4u o; o.x = pk2(s[0], s[132]); o.y = pk2(s[2 * 132], s[3 * 132]); o.z = pk2(s[4 * 132], s[5 * 132]); o.w = pk2(s[6 * 132], s[7 * 132]); \
                  if (j.n0 + n < j.N) *(v4u*)(j.WT + (size_t)colmap(j.kind, j.n0 + n) * j.K + j.k0 + 8 * c) = o; } } } \
            __syncthreads(); } while (0)
        for (int t = tb; t < te; t += 2) { TR_STEP(ldA, t); if (t + 1 < te) TR_STEP(ldB, t + 1); }
#undef TR_STEP
    }
}

__device__ __forceinline__ void p1_modulate(Frame& F) {
    const int gw = F.vcu * NWAVES + F.wave, NGW = F.G * NWAVES; const float* mod = (const float*)(F.ws + WS_MOD); bf16* U = (bf16*)(F.ws + WS_U);
    for (int m = gw; m < M; m += NGW) { const float* mb = mod + (size_t)(m >> 11) * 24576; const f32x4* xr = (const f32x4*)(F.in[I_X] + (size_t)m * D) + F.lane;
#pragma unroll 4
        for (int j = 0; j < 16; ++j) { const f32x4 v = xr[64 * j], sh = *((const f32x4*)mb + F.lane + 64 * j), sc = *((const f32x4*)(mb + 4096) + F.lane + 64 * j);
            const f32x4 o = v * (sc + 1.0f) + sh; v2u w; w.x = pk2(o[0], o[1]); w.y = pk2(o[2], o[3]);
            *((v2u*)(U + (size_t)m * D) + F.lane + 64 * j) = w; } }
}
__device__ __forceinline__ void ln_stats(const f32x4 (&v)[16], float& mean, float& rstd) {
    float s = 0.f;
#pragma unroll
    for (int j = 0; j < 16; ++j) s += (v[j][0] + v[j][1]) + (v[j][2] + v[j][3]);
    mean = wave_sum(s) * (1.0f / D); float q = 0.f;
#pragma unroll
    for (int j = 0; j < 16; ++j) { const f32x4 d = v[j] - mean; q += (d[0] * d[0] + d[1] * d[1]) + (d[2] * d[2] + d[3] * d[3]); }
    rstd = 1.0f / sqrtf(wave_sum(q) * (1.0f / D) + LN_EPS);
}
__device__ __forceinline__ void p6_ln1(Frame& F) {
    const int gw = F.vcu * NWAVES + F.wave, NGW = F.G * NWAVES; const float* mod = (const float*)(F.ws + WS_MOD); bf16* U = (bf16*)(F.ws + WS_U);
    const float* Z1 = (const float*)(F.ws + WS_Z1); float* X1 = (float*)(F.ws + WS_X1);
    for (int m = gw; m < M; m += NGW) { const float* mb = mod + (size_t)(m >> 11) * 24576; const f32x4* zr = (const f32x4*)(Z1 + (size_t)m * D) + F.lane;
        f32x4 v[16];
#pragma unroll
        for (int j = 0; j < 16; ++j) v[j] = zr[64 * j];
        float mean, rstd; ln_stats(v, mean, rstd);
#pragma unroll
        for (int j = 0; j < 16; ++j) { const f32x4 gg = *((const f32x4*)F.in[I_LN1G] + F.lane + 64 * j), bb = *((const f32x4*)F.in[I_LN1B] + F.lane + 64 * j);
            const f32x4 x1 = (v[j] - mean) * rstd * gg + bb;
            *((f32x4*)(X1 + (size_t)m * D) + F.lane + 64 * j) = x1;
            const f32x4 sh = *((const f32x4*)(mb + 3 * 4096) + F.lane + 64 * j), sc = *((const f32x4*)(mb + 4 * 4096) + F.lane + 64 * j);
            const f32x4 o = x1 * (sc + 1.0f) + sh; v2u w; w.x = pk2(o[0], o[1]); w.y = pk2(o[2], o[3]);
            *((v2u*)(U + (size_t)m * D) + F.lane + 64 * j) = w; } }
}
__device__ __forceinline__ void p10_ln2(Frame& F) {
    const int gw = F.vcu * NWAVES + F.wave, NGW = F.G * NWAVES;
    for (int m = gw; m < M; m += NGW) { f32x4* zr = (f32x4*)(F.out + (size_t)m * D) + F.lane;
        f32x4 v[16];
#pragma unroll
        for (int j = 0; j < 16; ++j) v[j] = zr[64 * j];
        float mean, rstd; ln_stats(v, mean, rstd);
#pragma unroll
        for (int j = 0; j < 16; ++j) { const f32x4 gg = *((const f32x4*)F.in[I_LN2G] + F.lane + 64 * j), bb = *((const f32x4*)F.in[I_LN2B] + F.lane + 64 * j);
            zr[64 * j] = (v[j] - mean) * rstd * gg + bb; } }
}
__device__ __forceinline__ void p8_hpass(Frame& F) {
    const bf16* GU = (const bf16*)(F.ws + WS_GU); bf16* H = (bf16*)(F.ws + WS_H);
    const float* cw = F.in[I_CW]; const float* cb = F.in[I_CB];
    const size_t total = (size_t)M * (FF / 8);
    for (size_t idx = (size_t)blockIdx.x * 512 + F.tid; idx < total; idx += (size_t)F.G * 512) {
        const int m = (int)(idx / (FF / 8)), c = (int)(idx % (FF / 8)) * 8, t = m & (SEQ - 1);
        const size_t gcol = (size_t)(c >> 7) * 256 + (c & 127);
        const v4u g2 = *(const v4u*)(GU + (size_t)m * NGU + gcol), up = *(const v4u*)(GU + (size_t)m * NGU + gcol + 128);
        v4u g1 = (v4u){0u, 0u, 0u, 0u}, g0 = (v4u){0u, 0u, 0u, 0u};
        if (t >= 1) g1 = *(const v4u*)(GU + (size_t)(m - 1) * NGU + gcol);
        if (t >= 2) g0 = *(const v4u*)(GU + (size_t)(m - 2) * NGU + gcol);
        float o[8];
#pragma unroll
        for (int e = 0; e < 8; ++e) { const unsigned w2 = g2[e >> 1], w1 = g1[e >> 1], w0 = g0[e >> 1], wu = up[e >> 1];
            const float a2 = (e & 1) ? bfhi(w2) : bflo(w2), a1 = (e & 1) ? bfhi(w1) : bflo(w1), a0 = (e & 1) ? bfhi(w0) : bflo(w0), uu = (e & 1) ? bfhi(wu) : bflo(wu);
            const float gg = cb[c + e] + cw[c + e] * a0 + cw[FF + c + e] * a1 + cw[2 * FF + c + e] * a2;
            o[e] = gg / (1.0f + __expf(-gg)) * uu; }
        v4u w; w.x = pk2(o[0], o[1]); w.y = pk2(o[2], o[3]); w.z = pk2(o[4], o[5]); w.w = pk2(o[6], o[7]);
        *(v4u*)(H + (size_t)m * FF + c) = w;
    }
}


namespace att {
typedef float f32x16 __attribute__((ext_vector_type(16)));
typedef short bf16x8 __attribute__((ext_vector_type(8)));
constexpr int VP = 144;
constexpr int KREG = 32768, VREG = 24576, V_OFF = 2 * KREG;
constexpr int X_OFF = V_OFF + 3 * VREG;
__device__ __forceinline__ int swap23(int r) { return (r & ~12) | ((r & 4) << 1) | ((r & 8) >> 1); }
__device__ __forceinline__ unsigned sortable(float f) { const unsigned u = __builtin_bit_cast(unsigned, f); return (u & 0x80000000u) ? ~u : (u | 0x80000000u); }

template <int OFF> __device__ __forceinline__ void lds_rd128(bf16x8& d, unsigned addr) { asm volatile("ds_read_b128 %0, %1 offset:%2" : "=v"(d) : "v"(addr), "n"(OFF)); }
template <int N> __device__ __forceinline__ void lgkm_wait(bf16x8& d) { asm volatile("s_waitcnt lgkmcnt(%1)" : "+v"(d) : "n"(N)); }
struct Stg {
    const unsigned char* base;
    unsigned koff[4], voff[3];
    unsigned ldsk, ldsv;
    int nk, nv;
    template <int E> __device__ __forceinline__ void k() { if (E < nk) __builtin_amdgcn_global_load_lds((const unsigned*)(base + koff[E]), (LAS unsigned*)(unsigned long long)(ldsk + E * 1024), 16, 0, 0); }
    template <int E> __device__ __forceinline__ void v() { if (E < nv) __builtin_amdgcn_global_load_lds((const unsigned*)(base + voff[E]), (LAS unsigned*)(unsigned long long)(ldsv + E * 1024), 16, 0, 0); }
};
template <int N, int KSTEPS, int KP, int PF, bool DMA> struct SStep {
    static __device__ __forceinline__ void run(bf16x8 (&fr)[PF], f32x16 (&sa)[2], const bf16x8 (&qf)[KSTEPS], unsigned base, Stg& st) {
        constexpr int NMM = 2 * KSTEPS, kb = N / KSTEPS, s = N % KSTEPS, GAP = NMM / 4;
        lgkm_wait<((NMM - N < PF) ? NMM - N : PF) - 1>(fr[N % PF]);
        sa[kb] = __builtin_amdgcn_mfma_f32_32x32x16_bf16(fr[N % PF], qf[s], sa[kb], 0, 0, 0);
        if constexpr (N + PF < NMM) lds_rd128<32 * ((N + PF) / KSTEPS) * KP + 32 * ((N + PF) % KSTEPS)>(fr[N % PF], base);
        if constexpr (DMA && N % 2 == 1 && N < 8) st.template k<N / 2>();
        if constexpr (DMA && N % 2 == 1 && N >= 8 && N < 14) st.template v<(N - 8) / 2>();
        if constexpr (N + 1 < NMM) SStep<N + 1, KSTEPS, KP, PF, DMA>::run(fr, sa, qf, base, st);
    }
};
template <int N, int PF> struct PVStep {
    static __device__ __forceinline__ void run(bf16x8 (&fr)[PF], f32x16 (&o)[4], const bf16x8 (&pf)[4], unsigned base) {
        constexpr int d = N / 4, ks = N % 4;
        lgkm_wait<((16 - N < PF) ? 16 - N : PF) - 1>(fr[N % PF]);
        o[d] = __builtin_amdgcn_mfma_f32_32x32x16_bf16(fr[N % PF], pf[ks], o[d], 0, 0, 0);
        if constexpr (N + PF < 16) lds_rd128<32 * ((N + PF) / 4) * VP + 32 * ((N + PF) % 4)>(fr[N % PF], base);
        if constexpr (N + 1 < 16) PVStep<N + 1, PF>::run(fr, o, pf, base);
    }
};
template <int N, int KSTEPS, int KP, int PF> struct SPre { static __device__ __forceinline__ void run(bf16x8 (&fr)[PF], unsigned base) {
    lds_rd128<32 * (N / KSTEPS) * KP + 32 * (N % KSTEPS)>(fr[N], base); if constexpr (N + 1 < PF) SPre<N + 1, KSTEPS, KP, PF>::run(fr, base); } };
template <int N, int PF> struct PVPre { static __device__ __forceinline__ void run(bf16x8 (&fr)[PF], unsigned base) {
    lds_rd128<32 * (N / 4) * VP + 32 * (N % 4)>(fr[N], base); if constexpr (N + 1 < PF) PVPre<N + 1, PF>::run(fr, base); } };
__device__ __forceinline__ void dsa_topk(Frame& F, int b, int q0, int slot) {
    const int tid = F.tid, lane = F.lane, w = F.wave; LAS unsigned char* lds = F.lds; const size_t brow = (size_t)b * SEQ;
    LAS unsigned* bmp = (LAS unsigned*)(lds + X_OFF) + slot * 1024;
    LAS float* rb2 = (LAS float*)(lds + X_OFF + 8192 + 1024);
    {
        const float* SC = (const float*)(F.ws + WS_SC);
        for (int idx = tid; idx < 2048; idx += 512) rb2[idx] = F.in[I_RELB][(int)BUCKET_TAB[idx >> 4] * 16 + (idx & 15)] * 1.4426950408889634f;
        for (int tt = 0; tt < 2; ++tt) {
            const int t = q0 + 2 * w + tt, n = t + 1; const float* row = SC + (brow + t) * SEQ;
            unsigned u[32];
#pragma unroll
            for (int j = 0; j < 32; ++j) { const int s = 64 * j + lane; u[j] = 0u; if (64 * j < n) { if (s < n) u[j] = sortable(row[s]); } }
            unsigned T = 1u;
            bool exact = true;
            if (n > 256) {
                T = 0u; exact = false;
                for (int bit = 31; bit >= 0; --bit) {
                    const unsigned cand = T | (1u << bit); int c = 0;
#pragma unroll
                    for (int j = 0; j < 32; ++j) c += __popcll(__ballot(u[j] >= cand));
                    if (c >= 256) T = cand;
                    if (c == 256) { exact = true; break; }
                }
            }
            if (exact) {
#pragma unroll
                for (int j = 0; j < 32; ++j) { const unsigned long long mk = __ballot(u[j] >= T); if (lane < 2) bmp[(2 * w + tt) * 64 + 2 * j + lane] = (unsigned)(mk >> (32 * lane)); }
            } else {
                int need = 256;
#pragma unroll
                for (int j = 0; j < 32; ++j) need -= __popcll(__ballot(u[j] > T));
#pragma unroll
                for (int j = 0; j < 32; ++j) { unsigned long long mk = __ballot(u[j] > T), eq = __ballot(u[j] == T);
                    while (eq != 0ull && need > 0) { const unsigned long long low = eq & (~eq + 1ull); mk |= low; eq ^= low; --need; }
                    if (lane < 2) bmp[(2 * w + tt) * 64 + 2 * j + lane] = (unsigned)(mk >> (32 * lane)); }
            }
        }
    }
}
template <int MODE> __device__ __forceinline__ void attn_unit(Frame& F, int b, int h, int q0, int slot) {
    constexpr int KD = MODE == 0 ? 192 : 128, KCH = KD / 8, KP = (KCH + 1) * 16, KSTEPS = KD / 16, KTILE = 64 * KP;
    constexpr int KROWCH = KCH + 1;
    static_assert(64 * KP <= KREG && 128 * VP <= VREG, "tile buffers");
    const int tid = F.tid, lane = F.lane, w = F.wave, l32 = lane & 31, hh = lane >> 5;
    LAS unsigned char* lds = F.lds;
    unsigned long long wsl_ = (unsigned long long)F.ws; asm volatile("" : "+s"(wsl_));
    unsigned char* const WSP = (unsigned char*)wsl_;
    unsigned long long posl_ = (unsigned long long)F.in[I_POS]; asm volatile("" : "+s"(posl_)); const int* const POSP = (const int*)posl_;
    const bf16* QG; const bf16* KG; const bf16* K2G = nullptr; const bf16* VTG; bf16* MIX = (bf16*)(WSP + WS_MIX);
    if (MODE == 0) { QG = (const bf16*)(WSP + WS_QB); KG = (const bf16*)(WSP + WS_KN); K2G = (const bf16*)(WSP + WS_IKX); VTG = (const bf16*)(WSP + WS_VT) + (size_t)(h * 128) * M; }
    else { QG = (const bf16*)(WSP + WS_AQ); KG = (const bf16*)(WSP + WS_AKV); VTG = (const bf16*)(WSP + WS_VTA); }
    const size_t brow = (size_t)b * SEQ;
    int tq, qhead;
    if (MODE == 0) { tq = q0 + 32 * w + l32; qhead = h; } else { tq = q0 + 2 * w + (l32 >> 4); qhead = l32 & 15; }
    const int nt = MODE == 0 ? (q0 + 256) / 64 : (q0 + 16 + 63) / 64;
    LAS unsigned* bmp = (LAS unsigned*)(lds + X_OFF) + slot * 1024;
    LAS int* posk = (LAS int*)(lds + X_OFF + 8192);
    LAS int* farf = (LAS int*)(lds + X_OFF + 8192 + 512);
    LAS float* rb2 = (LAS float*)(lds + X_OFF + 8192 + 1024);
    bf16x8 qf[KSTEPS];
    int posq = 0, minposq = 0; float bias_far = 0.f;
    if (MODE == 1) { const int* pos = POSP; posq = pos[brow + tq]; const int p0 = pos[brow + q0 + 2 * w], p1 = pos[brow + q0 + 2 * w + 1]; minposq = p0 < p1 ? p0 : p1; }
    Stg st; st.base = WSP;
    { constexpr int NKI = (64 * KROWCH + 63) / 64, NVI = 18;
      int ln_ = lane; asm volatile("" : "+v"(ln_));
      st.nk = NKI - 4 * w; st.nk = st.nk < 0 ? 0 : (st.nk > 4 ? 4 : st.nk); st.nv = NVI - 3 * w; st.nv = st.nv < 0 ? 0 : (st.nv > 3 ? 3 : st.nv);
#pragma unroll
      for (int e = 0; e < 4; ++e) { const int q = (4 * w + e) * 64 + ln_, rho = q / KROWCH, c = q % KROWCH; const bool ok = rho < 64 && c < KCH; const unsigned kr = (unsigned)swap23(rho & 63);
          if (MODE == 0) { const bool two = c >= 16;
              st.koff[e] = !ok ? (unsigned)WS_KN : (two ? (unsigned)WS_KR2 + ((unsigned)(brow + kr) * 2048u + 8u * (c - 16)) * 2u : (unsigned)WS_KN + ((unsigned)(brow + kr) * 2048u + (unsigned)h * 128u + 8u * c) * 2u); }
          else st.koff[e] = !ok ? (unsigned)WS_AKV : (unsigned)WS_AKV + ((unsigned)(brow + kr) * 256u + 8u * c) * 2u; }
#pragma unroll
      for (int e = 0; e < 3; ++e) { const int q = (3 * w + e) * 64 + ln_, d = q / 9, c = q % 9; const bool ok = d < 128 && c < 8;
          const unsigned vb = MODE == 0 ? (unsigned)WS_VT + (unsigned)(h * 128) * (unsigned)(M * 2) : (unsigned)WS_VTA;
          st.voff[e] = !ok ? vb : vb + (unsigned)d * (unsigned)(M * 2) + ((unsigned)brow + 8u * c) * 2u; } }
#define ATT_ADVANCE() do { _Pragma("unroll") for (int e = 0; e < 4; ++e) st.koff[e] += (MODE == 0 ? 64u * 4096u : 64u * 512u); _Pragma("unroll") for (int e = 0; e < 3; ++e) st.voff[e] += 128u; } while (0)
#define ATT_TARGET(i_, vs_) do { st.ldsk = (unsigned)(unsigned long long)(lds + ((i_) & 1) * KREG) + 4 * w * 1024; st.ldsv = (unsigned)(unsigned long long)(lds + V_OFF + (vs_) * VREG) + 3 * w * 1024; } while (0)
#define ATT_POS(i_) do { if (MODE == 1 && tid < 64) { const int* pos_ = POSP + brow + 64 * (i_); const int pk = pos_[tid]; posk[((i_) & 1) * 64 + tid] = pk; int mx = pk; \
            _Pragma("unroll") for (int o_ = 1; o_ < 64; o_ <<= 1) { const int y = __shfl_xor(mx, o_); mx = mx > y ? mx : y; } \
            if (tid == 0) farf[(i_) & 1] = mx; } } while (0)
    f32x16 o[4];
#pragma unroll
    for (int d = 0; d < 4; ++d)
#pragma unroll
        for (int r = 0; r < 16; ++r) o[d][r] = 0.f;
    float ninit = 0.f, lrun = 0.f;
    constexpr float THR = 8.0f;
    __syncthreads();
    if (MODE == 1) bias_far = rb2[127 * 16 + qhead];
    { const bf16* qp = MODE == 0 ? QG + (brow + tq) * 3072 + qhead * 192 + 8 * hh : QG + (brow + tq) * 2048 + qhead * 128 + 8 * hh;
#pragma unroll
      for (int s = 0; s < KSTEPS; ++s) qf[s] = *(const bf16x8*)(qp + 16 * s); }
    ATT_TARGET(0, 0); st.k<0>(); st.k<1>(); st.k<2>(); st.k<3>(); st.v<0>(); st.v<1>(); st.v<2>(); ATT_POS(0); ATT_ADVANCE();
    asm volatile("s_waitcnt vmcnt(0)" ::: "memory"); __syncthreads();
    const int tmin = MODE == 0 ? q0 + 32 * w : q0;
    constexpr int PF = 3;
    constexpr bool STAG = MODE == 0;
    f32x16 sa[2]; bf16x8 fr[PF];
#define ATT_S(ii_, DMA_) do { const LAS unsigned char* kbuf_ = lds + ((ii_) & 1) * KREG; const unsigned kbase_ = (unsigned)(unsigned long long)(kbuf_ + l32 * KP + hh * 16); \
        SPre<0, KSTEPS, KP, PF>::run(fr, kbase_); \
        float ni_ = ninit; asm volatile("" : "+v"(ni_));     \
        if (MODE == 0) { _Pragma("unroll") for (int kb = 0; kb < 2; ++kb) _Pragma("unroll") for (int r = 0; r < 16; ++r) sa[kb][r] = ni_; } \
        else { const bool far_ = __builtin_amdgcn_readfirstlane(minposq - farf[(ii_) & 1]) >= 128; \
            _Pragma("unroll") for (int kb = 0; kb < 2; ++kb) _Pragma("unroll") for (int g = 0; g < 2; ++g) { float bia[8]; \
                _Pragma("unroll") for (int e = 0; e < 8; ++e) bia[e] = bias_far; \
                if (!far_) { const LAS int* pp = posk + ((ii_) & 1) * 64 + 32 * kb + 16 * g + 8 * hh; \
                    _Pragma("unroll") for (int e = 0; e < 8; ++e) { int rel = posq - pp[e]; rel = rel < 0 ? 0 : (rel > 127 ? 127 : rel); bia[e] = rb2[rel * 16 + qhead]; } } \
                _Pragma("unroll") for (int e = 0; e < 8; ++e) sa[kb][8 * g + e] = bia[e] + ni_; \
                __builtin_amdgcn_sched_barrier(0); } } \
        SStep<0, KSTEPS, KP, PF, DMA_>::run(fr, sa, qf, kbase_, st); } while (0)
#define ATT_SOFT(ii_) do { const int key0_ = 64 * (ii_); \
        if (MODE == 0) { if (key0_ + 63 > tmin) { \
            _Pragma("unroll") for (int kb = 0; kb < 2; ++kb) _Pragma("unroll") for (int r = 0; r < 16; ++r) { const int key = key0_ + 32 * kb + 16 * (r >> 3) + 8 * hh + (r & 7); const float xv = sa[kb][r]; sa[kb][r] = key > tq ? -__builtin_inff() : xv; } } } \
        else { const v2u wds = *(const LAS v2u*)(bmp + (2 * w + (l32 >> 4)) * 64 + 2 * (ii_)); \
            _Pragma("unroll") for (int kb = 0; kb < 2; ++kb) { const int wdh = (int)((kb == 0 ? wds.x : wds.y) >> (8 * hh)); \
                _Pragma("unroll") for (int r = 0; r < 16; ++r) { const int mk = __builtin_amdgcn_sbfe(wdh, 16 * (r >> 3) + (r & 7), 1); const float xv = sa[kb][r];     \
                    sa[kb][r] = __builtin_bit_cast(float, (__builtin_bit_cast(int, xv) & mk) | ((int)0xff800000 & ~mk)); } } } \
        float mloc = sa[0][0]; \
        _Pragma("unroll") for (int kb = 0; kb < 2; ++kb) _Pragma("unroll") for (int r = 0; r < 16; ++r) mloc = fmaxf(mloc, sa[kb][r]); \
        mloc = fmaxf(mloc, __shfl_xor(mloc, 32)); \
        if ((ii_) == 0 || __any(mloc > THR)) {               \
            const float delta = (ii_) == 0 ? (mloc > -1.0e30f ? mloc : 0.f) : fmaxf(mloc, 0.f), alpha = __builtin_amdgcn_exp2f(-delta); \
            ninit -= delta; lrun *= alpha; \
            _Pragma("unroll") for (int kb = 0; kb < 2; ++kb) _Pragma("unroll") for (int r = 0; r < 16; ++r) sa[kb][r] -= delta; \
            _Pragma("unroll") for (int d = 0; d < 4; ++d) _Pragma("unroll") for (int r = 0; r < 16; ++r) o[d][r] *= alpha; } \
        float psum = 0.f; \
        _Pragma("unroll") for (int kb = 0; kb < 2; ++kb) _Pragma("unroll") for (int r = 0; r < 16; ++r) { const float p = __builtin_amdgcn_exp2f(sa[kb][r]); sa[kb][r] = p; psum += p; } \
        lrun += psum; \
          \
        _Pragma("unroll") for (int ks = 0; ks < 4; ++ks) { v4u pk; \
            _Pragma("unroll") for (int e = 0; e < 4; ++e) pk[e] = pg8::cvt_pk_bf16(sa[ks >> 1][8 * (ks & 1) + 2 * e], sa[ks >> 1][8 * (ks & 1) + 2 * e + 1]); \
            pf[ks] = __builtin_bit_cast(bf16x8, pk); } } while (0)
#define ATT_PV(vs_) do { const unsigned vbase_ = (unsigned)(unsigned long long)(lds + V_OFF + (vs_) * VREG + l32 * VP + hh * 16); PVPre<0, PF>::run(fr, vbase_); PVStep<0, PF>::run(fr, o, pf, vbase_); } while (0)
    bf16x8 pf[4];
    int vs = 0;
    for (int i = 0; i < nt; ++i) {
        const int vn = vs == 2 ? 0 : vs + 1, vp = vs == 0 ? 2 : vs - 1;
        ATT_TARGET(i + 1, vn); if (i + 1 < nt) ATT_POS(i + 1);
        if (!STAG || w < 4) { ATT_S(i, true); ATT_SOFT(i); ATT_PV(vs); }
        else { st.k<0>(); st.k<1>(); st.k<2>(); st.k<3>(); st.v<0>(); st.v<1>(); st.v<2>();
            if (i > 0) { ATT_SOFT(i - 1); ATT_PV(vp); }
            ATT_S(i, false); }
        ATT_ADVANCE();
        asm volatile("s_waitcnt vmcnt(0)" ::: "memory"); __syncthreads();
        vs = vn;
    }
    if (STAG && w >= 4) { const int vl = vs == 0 ? 2 : vs - 1; ATT_SOFT(nt - 1); ATT_PV(vl); }
#undef ATT_S
#undef ATT_SOFT
#undef ATT_PV
    { const float lt = lrun + __shfl_xor(lrun, 32), inv = 16.0f / lt;
      int tq2 = tq; asm volatile("" : "+v"(tq2));
      const unsigned oo = (unsigned)(b * SEQ + tq2) * 4096u + (MODE == 0 ? 2048u + (unsigned)h * 128u : (unsigned)qhead * 128u);
      unsigned char* op = (unsigned char*)MIX + oo;
#pragma unroll
      for (int d = 0; d < 4; ++d)
#pragma unroll
          for (int g = 0; g < 4; ++g) { int wv = 0; wv = __builtin_amdgcn_cvt_pk_fp8_f32(o[d][4 * g] * inv, o[d][4 * g + 1] * inv, wv, false); wv = __builtin_amdgcn_cvt_pk_fp8_f32(o[d][4 * g + 2] * inv, o[d][4 * g + 3] * inv, wv, true);
              *(unsigned*)(op + 32 * d + 8 * g + 4 * hh) = (unsigned)wv; } }
}
#undef ATT_ADVANCE
#undef ATT_TARGET
#undef ATT_POS
}

__device__ __forceinline__ void indexer_unit(Frame& F, int b, int t0) {
    constexpr int KP = 272, KTILE = 64 * KP;
    const int tid = F.tid, lane = F.lane, w = F.wave, l32 = lane & 31, hh = lane >> 5;
    LAS unsigned char* lds = F.lds;
    const bf16* IQ = (const bf16*)(F.ws + WS_IQ); const bf16* IKX = (const bf16*)(F.ws + WS_IKX); const float* IW = (const float*)(F.ws + WS_IW); float* SC = (float*)(F.ws + WS_SC);
    const size_t brow = (size_t)b * SEQ, m0 = brow + t0 + 2 * w;
    att::bf16x8 af[2][8]; float wt[2][16];
#pragma unroll
    for (int tt = 0; tt < 2; ++tt) {
#pragma unroll
        for (int s = 0; s < 8; ++s) af[tt][s] = *(const att::bf16x8*)(IQ + (m0 + tt) * 4096 + l32 * 128 + 16 * s + 8 * hh);
#pragma unroll
        for (int g = 0; g < 4; ++g) { const f32x4 v = *(const f32x4*)(IW + (m0 + tt) * 32 + 8 * g + 4 * hh); wt[tt][4 * g] = v[0]; wt[tt][4 * g + 1] = v[1]; wt[tt][4 * g + 2] = v[2]; wt[tt][4 * g + 3] = v[3]; }
    }
    const int nt = (t0 + 16 + 63) / 64;
    v4u st[2];
#define IDX_LOAD(i_) do { _Pragma("unroll") for (int e = 0; e < 2; ++e) { const int q = tid + 512 * e, rho = q >> 4, c = q & 15; st[e] = *(const v4u*)(IKX + (brow + 64 * (i_) + rho) * 256 + 8 * c); } } while (0)
#define IDX_STORE(i_) do { _Pragma("unroll") for (int e = 0; e < 2; ++e) { const int q = tid + 512 * e, rho = q >> 4, c = q & 15; *(LAS v4u*)(lds + ((i_) & 1) * KTILE + rho * KP + c * 16) = st[e]; } } while (0)
    __syncthreads();
    IDX_LOAD(0); IDX_STORE(0);
    __syncthreads();
    for (int i = 0; i < nt; ++i) {
        if (i + 1 < nt) IDX_LOAD(i + 1);
        const LAS unsigned char* kbuf = lds + (i & 1) * KTILE;
#pragma unroll
        for (int kb = 0; kb < 2; ++kb) {
            att::bf16x8 bfr[8];
#pragma unroll
            for (int s = 0; s < 8; ++s) bfr[s] = *(const LAS att::bf16x8*)(kbuf + (32 * kb + l32) * KP + (2 * s + hh) * 16);
            float sc[2];
#pragma unroll
            for (int tt = 0; tt < 2; ++tt) {
                att::f32x16 acc;
#pragma unroll
                for (int r = 0; r < 16; ++r) acc[r] = 0.f;
#pragma unroll
                for (int s = 0; s < 8; ++s) acc = __builtin_amdgcn_mfma_f32_32x32x16_bf16(af[tt][s], bfr[s], acc, 0, 0, 0);
                float x = 0.f;
#pragma unroll
                for (int r = 0; r < 16; ++r) x += wt[tt][r] * fmaxf(acc[r], 0.f);
                sc[tt] = x + __shfl_xor(x, 32);
            }
            SC[(m0 + hh) * SEQ + 64 * i + 32 * kb + l32] = hh ? sc[1] : sc[0];
        }
        if (i + 1 < nt) IDX_STORE(i + 1);
        __syncthreads();
    }
#undef IDX_LOAD
#undef IDX_STORE
}
__device__ __forceinline__ void av_transpose(Frame& F, int tile) {
    const bf16* AKV = (const bf16*)(F.ws + WS_AKV); bf16* VTA = (bf16*)(F.ws + WS_VTA);
    LAS unsigned short* T = (LAS unsigned short*)F.lds;
    __syncthreads();
#pragma unroll
    for (int e = 0; e < 2; ++e) { const int tok = F.tid & 63, c = (F.tid >> 6) + 8 * e; const v4u v = *(const v4u*)(AKV + (size_t)(64 * tile + tok) * 256 + 128 + 8 * c);
#pragma unroll
        for (int k = 0; k < 4; ++k) { T[(8 * c + 2 * k) * 72 + tok] = (unsigned short)(v[k] & 0xffffu); T[(8 * c + 2 * k + 1) * 72 + tok] = (unsigned short)(v[k] >> 16); } }
    __syncthreads();
    { const int d = F.tid >> 2, part = F.tid & 3; const LAS v4u* s = (const LAS v4u*)(T + d * 72 + 16 * part);
      v4u* dst = (v4u*)(VTA + (size_t)d * M + 64 * tile + 16 * part); dst[0] = s[0]; dst[1] = s[1]; }
    __syncthreads();
}

struct Args { const float* in[21]; float* out; unsigned char* ws; int ph_lo, ph_hi; };
__global__ void __launch_bounds__(NWAVES * 64, 2) skel_fwd(Args args) {
    extern __shared__ __attribute__((aligned(16))) unsigned char lds[];
    Frame F;
    F.lds = (LAS unsigned char*)lds;
    F.MISC = (volatile LAS unsigned*)(F.lds + MISC_OFF);
    F.tid = threadIdx.x; F.lane = F.tid & 63; F.wave = __builtin_amdgcn_readfirstlane(F.tid >> 6);
    F.G = gridDim.x; { const int bx = blockIdx.x; F.vcu = (F.G % 8 == 0) ? (bx % 8) * (F.G / 8) + bx / 8 : bx; }
    F.ws = args.ws; F.ctl = (gu32*)(args.ws + WS_CTL); F.out = args.out;
#pragma unroll
    for (int i = 0; i < 21; ++i) F.in[i] = args.in[i];
    for (int u = F.tid; u < (LDS_BYTES - LDSCTL_OFF) / 4; u += NWAVES * 64) ((LAS unsigned*)(F.lds + LDSCTL_OFF))[u] = 0u;
    __syncthreads();
    XcdBarrier bar; bar.bar = (unsigned*)(F.ctl + CW_BAR); bar.x = 0; bar.st = nullptr;
    const int lo = args.ph_lo, hi = args.ph_hi;
    if (hi - lo > 1) bar = xcd_barrier_post((unsigned*)(F.ctl + CW_BAR), F.MISC + 8);
#define IN(k) (lo <= (k) && (k) < hi)
#define SEAM(k) do { if (IN(k) && IN((k) + 1)) xcd_barrier(bar); } while (0)
    unsigned char* ws = args.ws;

    if (IN(0)) { p0_prologue(F); SEAM(0); }
    if (IN(1)) { p1_modulate(F); SEAM(1); }
    if (IN(2)) {
        pg8::Gemm g{(const bf16*)(ws + WS_U), (const bf16*)(ws + WS_WIN), D, D}; pg8::StaticOrder S; S.init(M, NIN, F.G, (int)blockIdx.x);
        pg8::EpiProj E{(bf16*)(ws + WS_AQ), (bf16*)(ws + WS_AKV), (bf16*)(ws + WS_IQ), (bf16*)(ws + WS_IKX), (bf16*)(ws + WS_QL), (bf16*)(ws + WS_KVL),
                       (float*)(ws + WS_IW), (float*)(ws + WS_RSQQ), (float*)(ws + WS_RSQK), (const float*)(ws + WS_ROPE), (bf16*)(ws + WS_KR2)};
        pg8::gemm_phase<pg8::EpiProj, pg8::StaticOrder, true, true>(F.lds + RING_OFF, g, S, E);
        SEAM(2);
    }
    if (IN(3)) {
        { pg8::Gemm g{(const bf16*)(ws + WS_QL), (const bf16*)(ws + WS_WUQ), 512, 512}; pg8::StaticOrder S; S.init(M, 3072, F.G, (int)blockIdx.x);
          pg8::EpiUp<true> E{(bf16*)(ws + WS_QB), 3072, (const float*)(ws + WS_RSQQ), (const float*)(ws + WS_ROPE)};
          pg8::gemm_phase<pg8::EpiUp<true>, pg8::StaticOrder, true, true, true>(F.lds + RING_OFF, g, S, E); }
        { pg8::Gemm g{(const bf16*)(ws + WS_KVL), (const bf16*)(ws + WS_WUKV), 256, 256}; pg8::StaticOrder S; S.init(M, 2048, F.G, (int)blockIdx.x);
          pg8::EpiUp<false> E{(bf16*)(ws + WS_KN), 2048, (const float*)(ws + WS_RSQK), nullptr};
          pg8::gemm_phase<pg8::EpiUp<false>, pg8::StaticOrder, true, true, true>(F.lds + RING_OFF, g, S, E); }
        { pg8::Gemm g{(const bf16*)(ws + WS_WUKV) + (size_t)2048 * 256, (const bf16*)(ws + WS_KVL), 256, 256}; pg8::StaticOrder S; S.init(2048, M, F.G, (int)blockIdx.x);
          pg8::EpiVT E{(bf16*)(ws + WS_VT), (const float*)(ws + WS_RSQK)};
          pg8::gemm_phase<pg8::EpiVT, pg8::StaticOrder, true, true, true>(F.lds + RING_OFF, g, S, E); }
        __syncthreads();
        if (blockIdx.x < 128) av_transpose(F, (int)blockIdx.x);
        for (int P = F.vcu; P < 256; P += F.G)     { const int b = P >> 6, j = P & 63; for (int k = 0; k < 2; ++k) indexer_unit(F, b, 16 * (k ? 127 - j : j)); }
        SEAM(3);
    }
    if (IN(4)) {
        for (int P = F.vcu; P < 256; P += F.G)     { const int b = P >> 6, h = (P >> 2) & 15, j = P & 3; for (int k = 0; k < 2; ++k) att::attn_unit<0>(F, b, h, 256 * (k ? 7 - j : j), 0); }
        __syncthreads();
        for (int P = F.vcu; P < 256; P += F.G)     { const int b = P >> 6, j = P & 63;
            __syncthreads();
            for (int k = 0; k < 2; ++k) att::dsa_topk(F, b, 16 * (k ? 127 - j : j), k);
            for (int k = 0; k < 2; ++k) att::attn_unit<1>(F, b, 0, 16 * (k ? 127 - j : j), k); }
        SEAM(4);
    }
    if (IN(5)) {
        pg8::Gemm g{(const bf16*)(ws + WS_MIX), (const bf16*)(ws + WS_WO), D / 2, D / 2};     pg8::StaticOrder S; S.init(M, D, F.G, (int)blockIdx.x);
        pg8::EpiZ E{F.in[I_X], (float*)(ws + WS_Z1), (const float*)(ws + WS_MOD) + 2 * 4096, ALPHA, 1.0f / 2048.0f};
        pg8::gemm_phase<pg8::EpiZ, pg8::StaticOrder, true, true, true>(F.lds + RING_OFF, g, S, E);
        SEAM(5);
    }
    if (IN(6)) { p6_ln1(F); SEAM(6); }
    if (IN(7)) {
        pg8::Gemm g{(const bf16*)(ws + WS_U), (const bf16*)(ws + WS_WGU), D, D}; pg8::StaticOrder S; S.init(M, NGU, F.G, (int)blockIdx.x);
        pg8::EpiPlain E{(bf16*)(ws + WS_GU), NGU};
        pg8::gemm_phase<pg8::EpiPlain, pg8::StaticOrder, true, true>(F.lds + RING_OFF, g, S, E);
        SEAM(7);
    }
    if (IN(8)) { p8_hpass(F); SEAM(8); }
    if (IN(9)) {
        pg8::Gemm g{(const bf16*)(ws + WS_H), (const bf16*)(ws + WS_WD), FF, FF}; pg8::StaticOrder S; S.init(M, D, F.G, (int)blockIdx.x);
        pg8::EpiZ E{(const float*)(ws + WS_X1), F.out, (const float*)(ws + WS_MOD) + 5 * 4096, ALPHA, 1.0f};
        pg8::gemm_phase<pg8::EpiZ, pg8::StaticOrder, true, true>(F.lds + RING_OFF, g, S, E);
        SEAM(9);
    }
    if (IN(10)) { p10_ln2(F); }
#undef IN
#undef SEAM
}

extern "C" void kernel_launch(void* const* d_in, const int* in_sizes, int n_in, void* d_out, int out_size, void* d_ws, size_t ws_size, hipStream_t stream) {
    static int grid = 0;
    if (grid == 0) {
        if (n_in != 21 || in_sizes[0] != M * D || out_size != M * D || ws_size < WS_END) { fprintf(stderr, "kernel_launch: unexpected shapes (n_in %d, in0 %d, out %d, ws %zu); nothing launched\n", n_in, n_in > 0 ? in_sizes[0] : -1, out_size, ws_size); grid = -1; return; }
        int dev = 0, cus = 0, per_cu = 0;
        if (hipGetDevice(&dev) != hipSuccess || hipDeviceGetAttribute(&cus, hipDeviceAttributeMultiprocessorCount, dev) != hipSuccess) { grid = -1; return; }
        if (hipFuncSetAttribute((const void*)skel_fwd, hipFuncAttributeMaxDynamicSharedMemorySize, LDS_BYTES) != hipSuccess) { fprintf(stderr, "kernel_launch: hipFuncSetAttribute failed\n"); grid = -1; return; }
        if (hipOccupancyMaxActiveBlocksPerMultiprocessor(&per_cu, (const void*)skel_fwd, NWAVES * 64, LDS_BYTES) != hipSuccess || per_cu < 1)
            fprintf(stderr, "kernel_launch: note: occupancy query reports %d workgroups per CU\n", per_cu);
        (void)hipGetLastError();
        grid = cus;
    }
    if (grid < 0) return;
    if (hipMemsetAsync((char*)d_ws + WS_CTL, 0, CTL_ZERO_BYTES, stream) != hipSuccess) return;
    Args a{};
    for (int i = 0; i < 21; ++i) a.in[i] = (const float*)d_in[i];
    a.out = (float*)d_out; a.ws = (unsigned char*)d_ws;
#if MK_ONE_LAUNCH
    a.ph_lo = 0; a.ph_hi = N_PHASES;
    hipLaunchKernelGGL(skel_fwd, dim3(grid), dim3(NWAVES * 64), LDS_BYTES, stream, a);
#else
    for (int p = 0; p < N_PHASES; ++p) { a.ph_lo = p; a.ph_hi = p + 1; hipLaunchKernelGGL(skel_fwd, dim3(grid), dim3(NWAVES * 64), LDS_BYTES, stream, a); }
#endif
}
```

```cpp
#include <hip/hip_runtime.h>
#include <cstdio>
#include <cstdint>

namespace pg8 {
#define PG8_LAS __attribute__((address_space(3)))
typedef unsigned short bf16_t;
typedef short bf16x8 __attribute__((ext_vector_type(8)));
typedef float f32x4 __attribute__((ext_vector_type(4)));
typedef unsigned u32x4 __attribute__((ext_vector_type(4)));
constexpr int BM = 256, BK = 64, HALF = 128, HTB = HALF * BK * 2  , STAGE_BYTES = 8 * HTB, NXCD = 8, WGM = 8;

__host__ __device__ __forceinline__ int lds_byte(int r, int c) { const int st = (r >> 4) * 2 + (c >> 5), rr = r & 15, cc = c & 31, ob = rr * 64 + cc * 2; return st * 1024 + (ob ^ (((ob >> 9) & 1) << 5)); }
__host__ __device__ __forceinline__ void stage_rc(int b, int& R, int& C) { const int st = b / 1024, sb = b % 1024, swz = sb ^ (((sb >> 9) & 1) << 5); R = (st >> 1) * 16 + swz / 64; C = (st & 1) * 32 + (swz % 64) / 2; }
__host__ __device__ __forceinline__ int perm32(int rho) { const int n = rho >> 4, i = rho & 15; return 8 * (i >> 2) + 4 * n + (i & 3); }

struct Unit { int pm, pn; };
struct Gemm { const bf16_t* A; const bf16_t* Bt; int lda, K; };
typedef int i32x4 __attribute__((ext_vector_type(4)));
typedef int i32x8 __attribute__((ext_vector_type(8)));
__device__ __forceinline__ i32x8 cat8(bf16x8 lo, bf16x8 hi) { return __builtin_shufflevector(__builtin_bit_cast(i32x4, lo), __builtin_bit_cast(i32x4, hi), 0, 1, 2, 3, 4, 5, 6, 7); }

struct StaticOrder {
    int nM, nN, nwg, G, c;
    __host__ __device__ void init(int M, int N, int G_, int c_) { nM = M / BM; nN = N / BM; nwg = nM * nN; G = G_; c = c_; }
    __host__ __device__ bool next(int i, Unit& u) const {
        const long L = (long)i * G + c; if (L >= nwg) return false;
        int wgid = (int)L; { const int q = nwg / NXCD, r = nwg % NXCD, xcd = wgid % NXCD, off = wgid / NXCD; wgid = (xcd < r ? xcd * (q + 1) : r * (q + 1) + (xcd - r) * q) + off; }
        const int nig = WGM * nN, gid = wgid / nig, fm = gid * WGM, gsz = (nM - fm) < WGM ? (nM - fm) : WGM;
        u.pm = fm + ((wgid % nig) % gsz); u.pn = (wgid % nig) / gsz; return true;
    }
    __device__ __forceinline__ void a_ready(const Unit&) const {}
    __device__ __forceinline__ void done(const Unit&) const {}
};

__device__ __forceinline__ unsigned cvt_pk_bf16(float lo, float hi) { unsigned r; asm volatile("v_cvt_pk_bf16_f32 %0, %1, %2" : "=v"(r) : "v"(lo), "v"(hi)); return r; }
__device__ __forceinline__ u32x4 pack8(const f32x4 v0, const f32x4 v1) { u32x4 w; w.x = cvt_pk_bf16(v0[0], v0[1]); w.y = cvt_pk_bf16(v0[2], v0[3]); w.z = cvt_pk_bf16(v1[0], v1[1]); w.w = cvt_pk_bf16(v1[2], v1[3]); return w; }
__device__ __forceinline__ void rope8(f32x4& v0, f32x4& v1, const float* rp) {
    const f32x4 c0 = *(const f32x4*)rp, c1 = *(const f32x4*)(rp + 4);
    float a, b;
    a = v0[0] * c0[0] - v0[1] * c0[1]; b = v0[0] * c0[1] + v0[1] * c0[0]; v0[0] = a; v0[1] = b;
    a = v0[2] * c0[2] - v0[3] * c0[3]; b = v0[2] * c0[3] + v0[3] * c0[2]; v0[2] = a; v0[3] = b;
    a = v1[0] * c1[0] - v1[1] * c1[1]; b = v1[0] * c1[1] + v1[1] * c1[0]; v1[0] = a; v1[1] = b;
    a = v1[2] * c1[2] - v1[3] * c1[3]; b = v1[2] * c1[3] + v1[3] * c1[2]; v1[2] = a; v1[3] = b;
}

struct EpiPlain {
    static constexpr bool PERM = true, AFTER_DRAIN = false;
    bf16_t* O; int ldc;
    __device__ __forceinline__ void operator()(const f32x4 (&acc)[2][2][4][2], const Unit& u, int wr, int wc, int fr, int fq) const {
        const int row0 = u.pm * BM + wr * 64 + fr, col0 = u.pn * BM + wc * 32 + 8 * fq;
#pragma unroll
        for (int ai = 0; ai < 2; ++ai)
#pragma unroll
            for (int m = 0; m < 4; ++m) { bf16_t* rowp = O + (size_t)(row0 + ai * HALF + m * 16) * ldc + col0;
#pragma unroll
                for (int bj = 0; bj < 2; ++bj) *(u32x4*)(rowp + bj * HALF) = pack8(acc[ai][bj][m][0], acc[ai][bj][m][1]); }
    }
};

struct EpiProj {
    static constexpr bool PERM = true, AFTER_DRAIN = false;
    bf16_t *AQ, *AKV, *IQ, *IKX, *QL, *KVL; float *IW, *RSQQ, *RSQK; const float* ROPE;
    __device__ __forceinline__ void operator()(const f32x4 (&acc)[2][2][4][2], const Unit& u, int wr, int wc, int fr, int fq) const {
        const int pn = u.pn; bf16_t* dst; int pitch, coff, kind = 0; unsigned ropemask = 0u;
        if (pn < 8) { dst = AQ; pitch = 2048; coff = pn * 256; }
        else if (pn == 8) { dst = AKV; pitch = 256; coff = 0; }
        else if (pn < 25) { dst = IQ; pitch = 4096; coff = (pn - 9) * 256; ropemask = 0xAu; }
        else if (pn == 25) { dst = IKX; pitch = 256; coff = 0; ropemask = 0x6u; kind = 3; }
        else if (pn < 30) { dst = QL; pitch = 1024; coff = (pn - 26) * 256; kind = 1; }
        else { dst = KVL; pitch = 512; coff = (pn - 30) * 256; kind = 2; }
        const int row0 = u.pm * BM + wr * 64 + fr, lc0 = wc * 32 + 8 * fq, i0 = 16 * (wc & 1) + 4 * fq;
#pragma unroll
        for (int ai = 0; ai < 2; ++ai)
#pragma unroll
            for (int m = 0; m < 4; ++m) {
                const int row = row0 + ai * HALF + m * 16; float ss = 0.f;
#pragma unroll
                for (int bj = 0; bj < 2; ++bj) {
                    f32x4 v0 = acc[ai][bj][m][0], v1 = acc[ai][bj][m][1];
                    if (pn < 8) { v0 = v0 * (0.08838834764831845f * 1.4426950408889634f); v1 = v1 * (0.08838834764831845f * 1.4426950408889634f); }
                    if ((ropemask >> (2 * bj + (wc >> 1))) & 1u) rope8(v0, v1, ROPE + ((size_t)row * 32 + i0) * 2);
                    if (kind == 1 || kind == 2) ss += (v0[0] * v0[0] + v0[1] * v0[1]) + (v0[2] * v0[2] + v0[3] * v0[3]) + (v1[0] * v1[0] + v1[1] * v1[1]) + (v1[2] * v1[2] + v1[3] * v1[3]);
                    if (kind == 3 && bj == 1 && wc == 2) { float* iw = IW + (size_t)row * 32 + 8 * fq; *(f32x4*)iw = v0; *(f32x4*)(iw + 4) = v1; }
                    if (kind == 1 || kind == 2) {
                        int w0 = 0, w1 = 0; w0 = __builtin_amdgcn_cvt_pk_fp8_f32(v0[0], v0[1], w0, false); w0 = __builtin_amdgcn_cvt_pk_fp8_f32(v0[2], v0[3], w0, true);
                        w1 = __builtin_amdgcn_cvt_pk_fp8_f32(v1[0], v1[1], w1, false); w1 = __builtin_amdgcn_cvt_pk_fp8_f32(v1[2], v1[3], w1, true);
                        typedef unsigned u32x2 __attribute__((ext_vector_type(2)));
                        *(u32x2*)((unsigned char*)dst + (size_t)row * pitch + coff + lc0 + bj * HALF) = (u32x2){(unsigned)w0, (unsigned)w1}; }
                    else *(u32x4*)(dst + (size_t)row * pitch + coff + lc0 + bj * HALF) = pack8(v0, v1);
                }
                if (kind == 1 || kind == 2) {
                    ss += __shfl_xor(ss, 16); ss += __shfl_xor(ss, 32);
                    if (fq == 0) { if (kind == 1) RSQQ[(size_t)row * 16 + (pn - 26) * 4 + wc] = ss; else RSQK[(size_t)row * 8 + (pn - 30) * 4 + wc] = ss; }
                }
            }
    }
};

template <bool ISQ> struct EpiUp {
    static constexpr bool PERM = true, AFTER_DRAIN = false;
    bf16_t* O; int ldc; const float* RSQ; const float* ROPE;
    __device__ __forceinline__ void operator()(const f32x4 (&acc)[2][2][4][2], const Unit& u, int wr, int wc, int fr, int fq) const {
        const int row0 = u.pm * BM + wr * 64 + fr, col0 = u.pn * BM + wc * 32 + 8 * fq, i0 = 16 * (wc & 1) + 4 * fq;
#pragma unroll
        for (int ai = 0; ai < 2; ++ai)
#pragma unroll
            for (int m = 0; m < 4; ++m) {
                const int row = row0 + ai * HALF + m * 16; float rs;
                if (ISQ) { const f32x4* p = (const f32x4*)(RSQ + (size_t)row * 16); const f32x4 a = p[0], b = p[1], c = p[2], d = p[3];
                    const float s = ((a[0] + a[1]) + (a[2] + a[3])) + ((b[0] + b[1]) + (b[2] + b[3])) + ((c[0] + c[1]) + (c[2] + c[3])) + ((d[0] + d[1]) + (d[2] + d[3]));
                    rs = (0.07216878364870322f * 1.4426950408889634f / 32.0f) / sqrtf(s * (1.0f / 1024.0f) + 1e-6f); }
                else { const f32x4* p = (const f32x4*)(RSQ + (size_t)row * 8); const f32x4 a = p[0], b = p[1];
                    const float s = ((a[0] + a[1]) + (a[2] + a[3])) + ((b[0] + b[1]) + (b[2] + b[3]));
                    rs = (1.0f / 16.0f) / sqrtf(s * (1.0f / 512.0f) + 1e-6f); }
#pragma unroll
                for (int bj = 0; bj < 2; ++bj) {
                    f32x4 v0 = acc[ai][bj][m][0] * rs, v1 = acc[ai][bj][m][1] * rs;
                    if (ISQ) { if ((4 * u.pn + 2 * bj + (wc >> 1)) % 3 == 2) rope8(v0, v1, ROPE + ((size_t)row * 32 + i0) * 2); }
                    *(u32x4*)(O + (size_t)row * ldc + col0 + bj * HALF) = pack8(v0, v1);
                }
            }
    }
};

struct EpiVT {
    static constexpr bool PERM = true, AFTER_DRAIN = false;
    bf16_t* O; const float* RSQ;
    __device__ __forceinline__ void operator()(const f32x4 (&acc)[2][2][4][2], const Unit& u, int wr, int wc, int fr, int fq) const {
        const int row0 = u.pm * BM + wr * 64 + fr, col0 = u.pn * BM + wc * 32 + 8 * fq;
        f32x4 rs[2][2];
#pragma unroll
        for (int bj = 0; bj < 2; ++bj)
#pragma unroll
            for (int e = 0; e < 8; ++e) { const f32x4* p = (const f32x4*)(RSQ + (size_t)(col0 + bj * HALF + e) * 8); const f32x4 a = p[0], b = p[1];
                const float s = ((a[0] + a[1]) + (a[2] + a[3])) + ((b[0] + b[1]) + (b[2] + b[3]));
                rs[bj][e >> 2][e & 3] = (1.0f / 16.0f) / sqrtf(s * (1.0f / 512.0f) + 1e-6f); }
#pragma unroll
        for (int ai = 0; ai < 2; ++ai)
#pragma unroll
            for (int m = 0; m < 4; ++m) { bf16_t* rowp = O + (size_t)(row0 + ai * HALF + m * 16) * 8192 + col0;
#pragma unroll
                for (int bj = 0; bj < 2; ++bj) *(u32x4*)(rowp + bj * HALF) = pack8(acc[ai][bj][m][0] * rs[bj][0], acc[ai][bj][m][1] * rs[bj][1]); }
    }
};

template <bool LNR, int ASH> struct EpiZ {
    static constexpr bool PERM = false, AFTER_DRAIN = false;
    const float* R; float* Z; const float* gate;
    static constexpr float alpha = 1.189207115002721f, ascale = 1.0f / (float)(1 << ASH);
    const float* RS; const float* LG; const float* LB;
    __device__ __forceinline__ void operator()(const f32x4 (&acc)[2][2][4][2], const Unit& u, int wr, int wc, int fr, int fq) const {
        const int row0 = u.pm * BM + wr * 64 + fr, col0 = u.pn * BM + wc * 32 + 4 * fq;
        const float* gp = gate + (size_t)((u.pm * BM) >> 11) * 24576 + col0;
#pragma unroll
        for (int bj = 0; bj < 2; ++bj)
#pragma unroll
            for (int n = 0; n < 2; ++n) {
                const f32x4 gv = (*(const f32x4*)(gp + bj * HALF + 16 * n) + 1.0f) * ascale; f32x4 lg = gv, lb = gv;
                if (LNR) { lg = *(const f32x4*)(LG + col0 + bj * HALF + 16 * n) * alpha; lb = *(const f32x4*)(LB + col0 + bj * HALF + 16 * n) * alpha; }
#pragma unroll
                for (int ai = 0; ai < 2; ++ai)
#pragma unroll
                    for (int m = 0; m < 4; ++m) { const int row = row0 + ai * HALF + m * 16; const size_t ro = (size_t)row * 4096 + col0 + bj * HALF + 16 * n;
                        const f32x4 r = *(const f32x4*)(R + ro); f32x4 res;
                        if (LNR) { typedef float f32x2 __attribute__((ext_vector_type(2))); const f32x2 ms = *(const f32x2*)(RS + 2 * (size_t)row); res = (r - ms.x) * ms.y * lg + lb; } else res = r * alpha;
                        *(f32x4*)(Z + ro) = res + gv * acc[ai][bj][m][n]; } }
    }
};

template <class Epi, class Sched, bool ALIGN_EPI = false, bool SP2 = false, bool FP8 = false>
__device__ __forceinline__ void gemm_phase(PG8_LAS unsigned char* lds, const Gemm g, const Sched& S, const Epi& E) {
    const int tid = threadIdx.x, wid = __builtin_amdgcn_readfirstlane(tid >> 6), lane = tid & 63, wr = wid >> 2, wc = wid & 3, fr = lane & 15, fq = lane >> 4;
    const int K = g.K, nt = K / BK, lda = g.lda;
    unsigned voffA[2], voffB[2];
#pragma unroll
    for (int i = 0; i < 2; ++i) { int R, C; stage_rc(tid * 16 + i * 8192, R, C); const int Rb = Epi::PERM ? ((R & ~31) + perm32(R & 31)) : R;
        voffA[i] = (unsigned)(R * lda + C) * 2u; voffB[i] = (unsigned)(Rb * K + C) * 2u; }
    const size_t kstep = (size_t)(BK * 2);
    const size_t hstep = (size_t)HALF * K * 2, hstepA = (size_t)HALF * lda * 2;
    const size_t tstep = 2 * hstep, tstepA = 2 * hstepA;
    const unsigned ldsw = (unsigned)wid * 1024u;
    const int aoff = lds_byte(wr * 64 + fr, fq * 8), boff = lds_byte(wc * 32 + fr, fq * 8);
#define PG8_SA(b, h) (((b) * 2 + (h)) * HTB)
#define PG8_SB(b, h) ((4 + (b) * 2 + (h)) * HTB)
#define PG8_STAGE(bufoff, gbase, voff) do { _Pragma("unroll") for (int _i = 0; _i < 2; ++_i) \
        __builtin_amdgcn_global_load_lds((const unsigned*)((const char*)(gbase) + (voff)[_i]), (PG8_LAS unsigned*)(lds + (bufoff) + ldsw + _i * 8192), 16, 0, 0); } while (0)
#define PG8_LDA(dst, b, h) do { if constexpr (FP8) { _Pragma("unroll") for (int m = 0; m < 4; ++m) dst##8[m] = __builtin_shufflevector(*(const PG8_LAS i32x4*)(lds + PG8_SA(b, h) + aoff + m * 2048), *(const PG8_LAS i32x4*)(lds + PG8_SA(b, h) + aoff + m * 2048 + 1024), 0, 1, 2, 3, 4, 5, 6, 7); } \
        else { _Pragma("unroll") for (int m = 0; m < 4; ++m) _Pragma("unroll") for (int k = 0; k < 2; ++k) dst[m][k] = *(const PG8_LAS bf16x8*)(lds + PG8_SA(b, h) + aoff + m * 2048 + k * 1024); } } while (0)
#define PG8_LDB(dst, b, h) do { if constexpr (FP8) { _Pragma("unroll") for (int n = 0; n < 2; ++n) dst##8[n] = __builtin_shufflevector(*(const PG8_LAS i32x4*)(lds + PG8_SB(b, h) + boff + n * 2048), *(const PG8_LAS i32x4*)(lds + PG8_SB(b, h) + boff + n * 2048 + 1024), 0, 1, 2, 3, 4, 5, 6, 7); } \
        else { _Pragma("unroll") for (int n = 0; n < 2; ++n) _Pragma("unroll") for (int k = 0; k < 2; ++k) dst[n][k] = *(const PG8_LAS bf16x8*)(lds + PG8_SB(b, h) + boff + n * 2048 + k * 1024); } } while (0)
#define PG8_MMA(ai, bj, At, Bt) do { __builtin_amdgcn_s_setprio(1); \
        if constexpr (FP8) { _Pragma("unroll") for (int m = 0; m < 4; ++m) _Pragma("unroll") for (int n = 0; n < 2; ++n) \
            asm volatile("v_mfma_f32_16x16x128_f8f6f4 %0, %1, %2, %0" : "+v"(acc[ai][bj][m][n]) : "v"(Bt##8[n]), "v"(At##8[m])); } \
        else { _Pragma("unroll") for (int m = 0; m < 4; ++m) _Pragma("unroll") for (int n = 0; n < 2; ++n) _Pragma("unroll") for (int k = 0; k < 2; ++k) \
            acc[ai][bj][m][n] = __builtin_amdgcn_mfma_f32_16x16x32_bf16(Bt[n][k], At[m][k], acc[ai][bj][m][n], 0, 0, 0); } \
        __builtin_amdgcn_s_setprio(0); } while (0)
#define PG8_WAIT_V(n) asm volatile("s_waitcnt vmcnt(" #n ")" ::: "memory")
#define PG8_WAIT_L(n) asm volatile("s_waitcnt lgkmcnt(" #n ")" ::: "memory")
#define PG8_BAR __builtin_amdgcn_s_barrier()
#define PG8_SCHED __builtin_amdgcn_sched_barrier(0)
    Unit cur, nxt; int ui = 0;
    if (!S.next(0, cur)) return;
    f32x4 acc[2][2][4][2];
#pragma unroll
    for (int a = 0; a < 2; ++a)
#pragma unroll
        for (int b = 0; b < 2; ++b)
#pragma unroll
            for (int m = 0; m < 4; ++m)
#pragma unroll
                for (int n = 0; n < 2; ++n) acc[a][b][m][n] = (f32x4){0.f, 0.f, 0.f, 0.f};
    bf16x8 At[4][2], B0[2][2], B1[2][2]; i32x8 At8[4], B08[2], B18[2];
    const char* cA = (const char*)g.A + (size_t)cur.pm * tstepA; const char* cB = (const char*)g.Bt + (size_t)cur.pn * tstep;
    S.a_ready(cur);
    if constexpr (SP2) {
        PG8_STAGE(PG8_SB(0, 0), cB, voffB); PG8_STAGE(PG8_SB(0, 1), cB + hstep, voffB); PG8_STAGE(PG8_SA(0, 0), cA, voffA); PG8_STAGE(PG8_SA(0, 1), cA + hstepA, voffA);
        if (wr == 1) PG8_BAR;
        PG8_WAIT_V(2); PG8_BAR;
        PG8_STAGE(PG8_SB(1, 0), cB + kstep, voffB); PG8_STAGE(PG8_SA(1, 0), cA + kstep, voffA); PG8_STAGE(PG8_SB(1, 1), cB + hstep + kstep, voffB);
        PG8_WAIT_V(6); PG8_BAR;
    } else {
        PG8_STAGE(PG8_SB(0, 0), cB, voffB); PG8_STAGE(PG8_SA(0, 0), cA, voffA); PG8_STAGE(PG8_SB(0, 1), cB + hstep, voffB); PG8_STAGE(PG8_SA(0, 1), cA + hstepA, voffA);
        if (wr == 1) PG8_BAR;
        PG8_WAIT_V(4); PG8_BAR;
        PG8_STAGE(PG8_SB(1, 0), cB + kstep, voffB); PG8_STAGE(PG8_SA(1, 0), cA + kstep, voffA); PG8_STAGE(PG8_SB(1, 1), cB + hstep + kstep, voffB);
        PG8_WAIT_V(6); PG8_BAR;
    }
    for (;;) {
        const bool has_next = S.next(ui + 1, nxt);
        const char* nA = has_next ? (const char*)g.A + (size_t)nxt.pm * tstepA : cA; const char* nB = has_next ? (const char*)g.Bt + (size_t)nxt.pn * tstep : cB;
        for (int t = 0; t < nt; t += 2) {
            const bool last = (t == nt - 2);
            const char* a1 = cA + (size_t)(t + 1) * kstep;
            const char* a2 = last ? nA : cA + (size_t)(t + 2) * kstep; const char* b2 = last ? nB : cB + (size_t)(t + 2) * kstep;
            const char* a3 = a2 + kstep; const char* b3 = b2 + kstep;
            if (last && has_next) S.a_ready(nxt);
            if constexpr (SP2) {
            PG8_LDB(B0, 0, 0); PG8_LDB(B1, 0, 1); PG8_SCHED; PG8_LDA(At, 0, 0); PG8_STAGE(PG8_SA(1, 1), a1 + hstepA, voffA);
            PG8_WAIT_V(8); PG8_WAIT_L(0); PG8_BAR; PG8_MMA(0, 0, At, B0); PG8_MMA(0, 1, At, B1); PG8_BAR; PG8_SCHED;
            PG8_LDA(At, 0, 1); PG8_STAGE(PG8_SB(0, 0), b2, voffB); PG8_STAGE(PG8_SB(0, 1), b2 + hstep, voffB); PG8_STAGE(PG8_SA(0, 0), a2, voffA);
            PG8_WAIT_V(8); PG8_WAIT_L(0); PG8_BAR; PG8_MMA(1, 0, At, B0); PG8_MMA(1, 1, At, B1); PG8_BAR; PG8_SCHED;
            PG8_LDB(B0, 1, 0); PG8_LDB(B1, 1, 1); PG8_SCHED; PG8_LDA(At, 1, 0); PG8_STAGE(PG8_SA(0, 1), a2 + hstepA, voffA);
            PG8_WAIT_V(8); PG8_WAIT_L(0); PG8_BAR; PG8_MMA(0, 0, At, B0); PG8_MMA(0, 1, At, B1); PG8_BAR; PG8_SCHED;
            PG8_LDA(At, 1, 1); PG8_STAGE(PG8_SB(1, 0), b3, voffB); PG8_STAGE(PG8_SB(1, 1), b3 + hstep, voffB); PG8_STAGE(PG8_SA(1, 0), a3, voffA);
            PG8_WAIT_V(8); PG8_WAIT_L(0); PG8_BAR; PG8_MMA(1, 0, At, B0); PG8_MMA(1, 1, At, B1); PG8_BAR; PG8_SCHED;
            } else {
            PG8_LDB(B0, 0, 0); PG8_SCHED; PG8_LDA(At, 0, 0); PG8_STAGE(PG8_SA(1, 1), a1 + hstepA, voffA);
            PG8_WAIT_L(8); PG8_BAR; PG8_WAIT_L(0); PG8_MMA(0, 0, At, B0); PG8_BAR; PG8_SCHED;
            PG8_LDB(B1, 0, 1); PG8_STAGE(PG8_SB(0, 0), b2, voffB);
            PG8_BAR; PG8_WAIT_L(0); PG8_MMA(0, 1, At, B1); PG8_BAR;
            PG8_LDA(At, 0, 1); PG8_STAGE(PG8_SA(0, 0), a2, voffA);
            PG8_BAR; PG8_WAIT_L(0); PG8_MMA(1, 0, At, B0); PG8_BAR; PG8_SCHED;
            PG8_STAGE(PG8_SB(0, 1), b2 + hstep, voffB);
            PG8_WAIT_V(6); PG8_BAR; PG8_MMA(1, 1, At, B1); PG8_BAR;
            PG8_LDB(B0, 1, 0); PG8_SCHED; PG8_LDA(At, 1, 0); PG8_STAGE(PG8_SA(0, 1), a2 + hstepA, voffA);
            PG8_WAIT_L(8); PG8_BAR; PG8_WAIT_L(0); PG8_MMA(0, 0, At, B0); PG8_BAR; PG8_SCHED;
            PG8_LDB(B1, 1, 1); PG8_STAGE(PG8_SB(1, 0), b3, voffB);
            PG8_BAR; PG8_WAIT_L(0); PG8_MMA(0, 1, At, B1); PG8_BAR;
            PG8_LDA(At, 1, 1); PG8_STAGE(PG8_SA(1, 0), a3, voffA);
            PG8_BAR; PG8_WAIT_L(0); PG8_MMA(1, 0, At, B0); PG8_BAR; PG8_SCHED;
            PG8_STAGE(PG8_SB(1, 1), b3 + hstep, voffB);
            PG8_WAIT_V(6); PG8_BAR; PG8_MMA(1, 1, At, B1); PG8_BAR;
            }
        }
        if constexpr (ALIGN_EPI) { if (wr == 0) PG8_BAR; }
        if constexpr (!Epi::AFTER_DRAIN) { E(acc, cur, wr, wc, fr, fq); S.done(cur); }
        if (!has_next) break;
#pragma unroll
        for (int a = 0; a < 2; ++a)
#pragma unroll
            for (int b = 0; b < 2; ++b)
#pragma unroll
                for (int m = 0; m < 4; ++m)
#pragma unroll
                    for (int n = 0; n < 2; ++n) acc[a][b][m][n] = (f32x4){0.f, 0.f, 0.f, 0.f};
        cur = nxt; cA = nA; cB = nB; ++ui;
        if constexpr (ALIGN_EPI) { if (wr == 1) PG8_BAR; }
    }
    PG8_WAIT_V(0);
    if constexpr (!ALIGN_EPI) { if (wr == 0) PG8_BAR; }
    PG8_BAR;
    if constexpr (Epi::AFTER_DRAIN) { E.fused(acc, cur, wr, wc, fr, fq, lds, wid, lane); S.done(cur); }
#undef PG8_SA
#undef PG8_SB
#undef PG8_STAGE
#undef PG8_LDA
#undef PG8_LDB
#undef PG8_MMA
#undef PG8_WAIT_V
#undef PG8_WAIT_L
#undef PG8_BAR
#undef PG8_SCHED
}
}
constexpr int NWAVES = 8;
constexpr int BATCH = 4, SEQ = 2048, D = 4096, M = BATCH * SEQ, FF = 11008, NIN = 8192  , NGU = 2 * FF;
constexpr int N_PHASES = 11;
#ifndef DSA_NAIVE
#define DSA_NAIVE 0
#endif
#ifndef MK_ONE_LAUNCH
#define MK_ONE_LAUNCH 1
#endif
constexpr float LN_EPS = 1e-5f, ALPHA = 1.189207115002721f;

constexpr size_t MiB = 1u << 20;
constexpr size_t WS_CTL = 0, CTL_ZERO_BYTES = 1 * MiB;
constexpr size_t WS_MOD = 1 * MiB, WS_ROPE = 2 * MiB, WS_RSQQ = 4 * MiB, WS_RSQK = 4 * MiB + 512 * 1024, WS_IW = 5 * MiB, WS_VTA = 6 * MiB, WS_RS1 = 4 * MiB + 768 * 1024  ;
constexpr size_t WS_WIN = 8 * MiB, WS_WUQ = 72 * MiB, WS_WUKV = 78 * MiB, WS_WO = 82 * MiB, WS_WGU = 114 * MiB, WS_WD = 286 * MiB;
constexpr size_t WS_U = 372 * MiB, WS_AQ = 436 * MiB, WS_AKV = 468 * MiB, WS_IQ = 472 * MiB, WS_IKX = 536 * MiB, WS_QL = 540 * MiB, WS_KVL = 556 * MiB;
constexpr size_t WS_QB = 564 * MiB, WS_KV = 612 * MiB, WS_KN = 612 * MiB, WS_VT = 644 * MiB, WS_SC = 676 * MiB, WS_MIX = 740 * MiB, WS_Z1 = 804 * MiB, WS_X1 = 932 * MiB;
constexpr size_t WS_GU = 436 * MiB  , WS_H = 1060 * MiB, WS_END = 1232 * MiB;
static_assert(WS_GU + (size_t)M * NGU * 2 <= WS_X1, "GU overlay");
constexpr int CW_TMO = 0, CW_CODE = 1, CW_BAR = 4096;

constexpr int RING_OFF = 0, RING_BYTES = 131072;
constexpr int LDSCTL_OFF = 135168, MISC_OFF = LDSCTL_OFF + 320;
constexpr int LDS_BYTES = 147456;

#define GAS __attribute__((address_space(1)))
#define LAS __attribute__((address_space(3)))
typedef unsigned short bf16;
typedef unsigned v4u __attribute__((ext_vector_type(4)));
typedef unsigned v2u __attribute__((ext_vector_type(2)));
typedef float f32x4 __attribute__((ext_vector_type(4)));
typedef float f32x2 __attribute__((ext_vector_type(2)));
typedef GAS unsigned gu32;
#define RLX_AGENT __ATOMIC_RELAXED, __HIP_MEMORY_SCOPE_AGENT
#define LDS_WAIT() asm volatile("s_waitcnt lgkmcnt(0)" ::: "memory")
#define VM_WAIT() asm volatile("s_waitcnt vmcnt(0)" ::: "memory")
__device__ __forceinline__ unsigned f2bf(float f) { unsigned u = __builtin_bit_cast(unsigned, f); return (u + 0x7fffu + ((u >> 16) & 1u)) >> 16; }
__device__ __forceinline__ unsigned pk2(float lo, float hi) { return f2bf(lo) | (f2bf(hi) << 16); }
__device__ __forceinline__ float bflo(unsigned w) { return __builtin_bit_cast(float, w << 16); }
__device__ __forceinline__ float bfhi(unsigned w) { return __builtin_bit_cast(float, w & 0xffff0000u); }

#define XB_TMO      128
#define XB_XCNT(j)  (256  + 64 * (j))
#define XB_XSUB(j)  (1280 + 64 * (j))
#define XB_XGEN(j)  (2304 + 64 * (j))
#define XB_TOP      3328
#define XB_TOPGEN   3392
#define XCD_BAR_WORDS 3456
#define XB_SPIN_CAP (1u << 18)
__device__ __forceinline__ unsigned xb_ld(unsigned* p)              { return __hip_atomic_load(p, __ATOMIC_RELAXED, __HIP_MEMORY_SCOPE_AGENT); }
__device__ __forceinline__ unsigned xb_add(unsigned* p, unsigned v) { return __hip_atomic_fetch_add(p, v, __ATOMIC_RELAXED, __HIP_MEMORY_SCOPE_AGENT); }
__device__ __forceinline__ unsigned xb_xcc_id() { return (unsigned)__builtin_amdgcn_s_getreg((3 << 11) | 20) & 0xFu; }
#define XB_SPIN(cond, bar) do { unsigned _sp = 0; while (cond) { __builtin_amdgcn_s_sleep(1); \
    if ((++_sp & 255u) == 0u) { if (xb_ld(&(bar)[XB_TMO])) break; if (_sp > XB_SPIN_CAP) { atomicAdd(&(bar)[XB_TMO], 1u); break; } } } } while (0)
struct XcdBarrier { unsigned* bar; unsigned x; volatile LAS unsigned* st; };
__device__ __forceinline__ XcdBarrier xcd_barrier_post(unsigned* bar, volatile LAS unsigned* st) {
    XcdBarrier b; b.bar = bar; b.x = xb_xcc_id(); b.st = st;
    if (threadIdx.x == 0) (void)xb_add(&bar[XB_XCNT(b.x)], 1u);
    return b;
}
__device__ __forceinline__ void xcd_barrier_complete(unsigned* bar, unsigned x, unsigned& nloc, unsigned& nx) {
    const unsigned G = gridDim.x * gridDim.y * gridDim.z;
    unsigned sum, cnt, mine, sp = 0u;
    for (;;) {
        sum = 0u; cnt = 0u; mine = 0u;
#pragma unroll
        for (unsigned j = 0; j < 16; ++j) { const unsigned c = xb_ld(&bar[XB_XCNT(j)]); sum += c; cnt += (c > 0u) ? 1u : 0u; mine = (j == x) ? c : mine; }
        if (sum == G) break;
        __builtin_amdgcn_s_sleep(1);
        if ((++sp & 255u) == 0u) { if (xb_ld(&bar[XB_TMO])) break; if (sp > XB_SPIN_CAP) { atomicAdd(&bar[XB_TMO], 1u); break; } }
    }
    nloc = mine > 0u ? mine : 1u; nx = cnt > 0u ? cnt : 1u;
}
__device__ __forceinline__ void xcd_barrier(const XcdBarrier& b) {
    asm volatile("s_waitcnt vmcnt(0)" ::: "memory");
    __syncthreads();
    if (threadIdx.x == 0) {
        unsigned* bar = b.bar;
        __builtin_amdgcn_s_waitcnt(0);
        unsigned nloc = b.st[0], nx = b.st[1];
        if (nloc == 0u) { xcd_barrier_complete(bar, b.x, nloc, nx); b.st[0] = nloc; b.st[1] = nx; }
        const unsigned old = xb_add(&bar[XB_XSUB(b.x)], 1u);
        const unsigned gen = old / nloc;
        if (old + 1u == (gen + 1u) * nloc) {
            __builtin_amdgcn_fence(__ATOMIC_RELEASE, "agent");
            asm volatile("s_waitcnt vmcnt(0)" ::: "memory");
            const unsigned og = xb_add(&bar[XB_TOP], 1u);
            const unsigned tg = og / nx;
            if (og + 1u == (tg + 1u) * nx) xb_add(&bar[XB_TOPGEN], 1u);
            else XB_SPIN(xb_ld(&bar[XB_TOPGEN]) == tg, bar);
            __builtin_amdgcn_fence(__ATOMIC_ACQUIRE, "agent");
            xb_add(&bar[XB_XGEN(b.x)], 1u);
            asm volatile("s_waitcnt vmcnt(0)" ::: "memory");
        } else {
            XB_SPIN(xb_ld(&bar[XB_XGEN(b.x)]) == gen, bar);
            __builtin_amdgcn_fence(__ATOMIC_ACQUIRE, "agent");
            asm volatile("s_waitcnt vmcnt(0)" ::: "memory");
        }
    }
    __syncthreads();
}

struct Frame {
    LAS unsigned char* lds;
    volatile LAS unsigned* MISC;
    gu32* ctl;
    int tid, lane, wave;
    int vcu, G;
    unsigned char* ws;
    const float* in[21];
    float* out;
};
__device__ __forceinline__ float wave_sum(float v) {
#pragma unroll
    for (int o = 1; o < 64; o <<= 1) v += __shfl_xor(v, o);
    return v;
}
__device__ __forceinline__ float wave_max(float v) {
#pragma unroll
    for (int o = 1; o < 64; o <<= 1) v = fmaxf(v, __shfl_xor(v, o));
    return v;
}
__device__ __forceinline__ int wave_isum(int v) {
#pragma unroll
    for (int o = 1; o < 64; o <<= 1) v += __shfl_xor(v, o);
    return v;
}
enum { I_X = 0, I_C, I_POS, I_WADA, I_BADA, I_WIN, I_RELB, I_QG, I_WUQ, I_KVG, I_WUKV, I_WO, I_LN1G, I_LN1B, I_WG, I_WU, I_CW, I_CB, I_WD, I_LN2G, I_LN2B };

__device__ const unsigned char BUCKET_TAB[128] = {0, 1, 2, 3, 4, 5, 6, 7, 8, 9, 10, 11, 12, 13, 14, 15, 16, 16, 16, 17, 17, 18, 18, 18, 19, 19, 19, 20, 20, 20, 20, 21, 21, 21, 21, 22, 22, 22, 22, 22, 23, 23, 23, 23, 23, 23, 24, 24, 24, 24, 24, 24, 25, 25, 25, 25, 25, 25, 25, 26, 26, 26, 26, 26, 26, 26, 26, 27, 27, 27, 27, 27, 27, 27, 27, 27, 27, 28, 28, 28, 28, 28, 28, 28, 28, 28, 28, 29, 29, 29, 29, 29, 29, 29, 29, 29, 29, 29, 29, 30, 30, 30, 30, 30, 30, 30, 30, 30, 30, 30, 30, 30, 30, 31, 31, 31, 31, 31, 31, 31, 31, 31, 31, 31, 31, 31, 31, 31};
__device__ const double ROPE_FREV[32] = {
    0.15915494309189535, 0.11934937021124886, 0.08949940160889101, 0.06711508300522726,
    0.050329212104487035, 0.03774158471741977, 0.0283021958306234, 0.02122365276477766,
    0.015915494309189534, 0.011934937021124886, 0.008949940160889102, 0.006711508300522725,
    0.005032921210448704, 0.003774158471741977, 0.00283021958306234, 0.0021223652764777662,
    0.0015915494309189536, 0.0011934937021124885, 0.0008949940160889102, 0.0006711508300522726,
    0.0005032921210448703, 0.00037741584717419774, 0.00028302195830623395, 0.0002122365276477766,
    0.00015915494309189535, 0.00011934937021124886, 8.949940160889102e-05, 6.711508300522725e-05,
    5.0329212104487035e-05, 3.774158471741978e-05, 2.8302195830623396e-05, 2.122365276477766e-05
};

__device__ __forceinline__ int colmap(int kind, int c) {
    if (kind == 0) return c;
    if (kind == 1) {
        if (c < 2304) return c;
        if (c < 6528) { const int base = (c < 6400) ? 2304 : 6400; const int r = c - base, h = r >> 7, d = r & 127;
            if (d < 64) return c; const int j = d - 64; return base + h * 128 + 64 + 2 * (j & 31) + (j >> 5); }
        if (c < 6560) return 6592 + (c - 6528);
        if (c < 7584) return 6656 + (c - 6560);
        if (c < 8096) return 7680 + (c - 7584);
        const int j = c - 8096; return 6528 + 2 * (j & 31) + (j >> 5);
    }
    if (kind == 2) { const int h = c / 192, d = c - h * 192; if (d < 128) return c; const int j = d - 128; return h * 192 + 128 + 2 * (j & 31) + (j >> 5); }
    if (kind == 3) return (c >> 7) * 256 + (c & 127);
    if (kind == 5) return (c >> 8) * 128 + (c & 127) + ((c & 128) ? 2048 : 0);
    return (c >> 7) * 256 + 128 + (c & 127);
}
constexpr int TT_IN = 32 * 64, TT_UQ = 8 * 24, TT_UKV = 4 * 32, TT_O = 32 * 32, TT_G = 32 * 86, TT_D = 86 * 32;
constexpr int TT_TOTAL = TT_IN + TT_UQ + TT_UKV + TT_O + 2 * TT_G + TT_D;
struct TJob { const float* W; const float* scale; bf16* WT; int K, N, kind, k0, n0; float f8s; };
__device__ __forceinline__ TJob tjob(const Frame& F, int t) {
    TJob j; j.scale = nullptr; j.f8s = 0.f; int nnt;
    if (t < TT_IN) { j.W = F.in[I_WIN]; j.WT = (bf16*)(F.ws + WS_WIN); j.K = 4096; j.N = 8160; j.kind = 1; nnt = 64; }
    else if ((t -= TT_IN) < TT_UQ) { j.W = F.in[I_WUQ]; j.scale = F.in[I_QG]; j.WT = (bf16*)(F.ws + WS_WUQ); j.K = 1024; j.N = 3072; j.kind = 2; j.f8s = 32.0f; nnt = 24; }
    else if ((t -= TT_UQ) < TT_UKV) { j.W = F.in[I_WUKV]; j.scale = F.in[I_KVG]; j.WT = (bf16*)(F.ws + WS_WUKV); j.K = 512; j.N = 4096; j.kind = 5; j.f8s = 16.0f; nnt = 32; }
    else if ((t -= TT_UKV) < TT_O) { j.W = F.in[I_WO]; j.WT = (bf16*)(F.ws + WS_WO); j.K = 4096; j.N = 4096; j.kind = 0; j.f8s = 128.0f; nnt = 32; }
    else if ((t -= TT_O) < TT_G) { j.W = F.in[I_WG]; j.WT = (bf16*)(F.ws + WS_WGU); j.K = 4096; j.N = FF; j.kind = 3; nnt = 86; }
    else if ((t -= TT_G) < TT_G) { j.W = F.in[I_WU]; j.WT = (bf16*)(F.ws + WS_WGU); j.K = 4096; j.N = FF; j.kind = 4; nnt = 86; }
    else { t -= TT_G; j.W = F.in[I_WD]; j.WT = (bf16*)(F.ws + WS_WD); j.K = FF; j.N = 4096; j.kind = 0; nnt = 32; }
    j.k0 = (t / nnt) * 128; j.n0 = (t % nnt) * 128; return j;
}
__device__ __forceinline__ void tr_load(const Frame& F, int t, f32x4 (&ld)[8]) {
    const TJob j = tjob(F, t); const int rsub = F.lane >> 5, c4 = F.lane & 31, n = j.n0 + 4 * c4;
#pragma unroll
    for (int i = 0; i < 8; ++i) { const int k = j.k0 + 16 * F.wave + 2 * i + rsub;
        f32x4 v = (f32x4){0.f, 0.f, 0.f, 0.f};
        if (n < j.N) v = __builtin_nontemporal_load((const f32x4*)(j.W + (size_t)k * j.N + n));
        if (j.scale) v = v * j.scale[k];
        ld[i] = v; }
}
__device__ __forceinline__ void p0_prologue(Frame& F) {
    const int g = blockIdx.x, G = F.G;
    { float* ROPE = (float*)(F.ws + WS_ROPE); const int* pos = (const int*)F.in[I_POS];
      for (int idx = g * 512 + F.tid; idx < M * 32; idx += G * 512) { const int m = idx >> 5, i = idx & 31;
          const double r = (double)pos[m] * ROPE_FREV[i]; const float fr = (float)(r - __builtin_floor(r)) * 2.0f;
          ROPE[2 * idx] = cospif(fr); ROPE[2 * idx + 1] = sinpif(fr); } }
    { v4u* z = (v4u*)((bf16*)(F.ws + WS_WIN) + (size_t)6624 * 4096);
      for (int idx = g * 512 + F.tid; idx < 32 * 4096 / 8; idx += G * 512) z[idx] = (v4u){0u, 0u, 0u, 0u}; }
    {
        LAS float* CACT = (LAS float*)F.lds; LAS float* RED = (LAS float*)(F.lds + 65536);
        for (int idx = F.tid; idx < 4 * 4096; idx += 512) { const float c = F.in[I_C][idx]; CACT[idx] = c / (1.0f + __expf(-c)); }
        __syncthreads();
        for (int it = g; it < 256; it += G) {
            const int ln = F.lane < 48 ? F.lane : 47; const float* wp = F.in[I_WADA] + (size_t)(512 * F.wave) * 24576 + it * 96 + 2 * ln;
            f32x2 acc[4];
#pragma unroll
            for (int b = 0; b < 4; ++b) acc[b] = (f32x2){0.f, 0.f};
            for (int k = 0; k < 512; k += 16) {
                f32x2 wv[16];
#pragma unroll
                for (int i = 0; i < 16; ++i) wv[i] = __builtin_nontemporal_load((const f32x2*)(wp + (size_t)(k + i) * 24576));
#pragma unroll
                for (int i = 0; i < 16; ++i)
#pragma unroll
                    for (int b = 0; b < 4; ++b) acc[b] += wv[i] * CACT[b * 4096 + 512 * F.wave + k + i];
            }
            if (F.lane < 48) {
#pragma unroll
                for (int b = 0; b < 4; ++b) *(LAS f32x2*)(RED + (F.wave * 4 + b) * 96 + 2 * F.lane) = acc[b]; }
            __syncthreads();
            if (F.tid < 384) { const int b = F.tid / 96, c = F.tid % 96; float s = F.in[I_BADA][it * 96 + c];
#pragma unroll
              for (int w = 0; w < 8; ++w) s += RED[(w * 4 + b) * 96 + c];
              ((float*)(F.ws + WS_MOD))[b * 24576 + it * 96 + c] = s; }
            __syncthreads();
        }
    }
    {
        const int tb = (int)((long)TT_TOTAL * g / G), te = (int)((long)TT_TOTAL * (g + 1) / G);
        LAS float* T = (LAS float*)F.lds;
        f32x4 ldA[8], ldB[8];
        if (tb < te) tr_load(F, tb, ldA);
        if (tb + 1 < te) tr_load(F, tb + 1, ldB);
#define TR_STEP(LD, t_) do { \
            { const int rsub = F.lane >> 5, c4 = F.lane & 31; \
              _Pragma("unroll") for (int i = 0; i < 8; ++i) { const int k = 16 * F.wave + 2 * i + rsub; *(LAS f32x4*)(T + 132 * k + ((4 * c4) ^ (4 * ((k >> 3) & 15)))) = LD[i]; } } \
            __syncthreads(); \
            const TJob j = tjob(F, (t_)); \
            if ((t_) + 2 < te) tr_load(F, (t_) + 2, LD); \
            { const int c = F.lane & 15; \
              _Pragma("unroll") for (int q = 0; q < 4; ++q) { const int n = (F.lane >> 4) + 4 * F.wave + 32 * q; const LAS float* s = T + 132 * (8 * c) + (n ^ (4 * c)); \
                  if (j.f8s != 0.f) { const float fs = j.f8s; int w0 = 0, w1 = 0; \
                      w0 = __builtin_amdgcn_cvt_pk_fp8_f32(s[0] * fs, s[132] * fs, w0, false); w0 = __builtin_amdgcn_cvt_pk_fp8_f32(s[2 * 132] * fs, s[3 * 132] * fs, w0, true); \
                      w1 = __builtin_amdgcn_cvt_pk_fp8_f32(s[4 * 132] * fs, s[5 * 132] * fs, w1, false); w1 = __builtin_amdgcn_cvt_pk_fp8_f32(s[6 * 132] * fs, s[7 * 132] * fs, w1, true); \
                      if (j.n0 + n < j.N) *(v2u*)((unsigned char*)j.WT + (size_t)colmap(j.kind, j.n0 + n) * j.K + j.k0 + 8 * c) = (v2u){(unsigned)w0, (unsigned)w1}; } \
                  else { v4u o; o.x = pk2(s[0], s[132]); o.y = pk2(s[2 * 132], s[3 * 132]); o.z = pk2(s[4 * 132], s[5 * 132]); o.w = pk2(s[6 * 132], s[7 * 132]); \
                  if (j.n0 + n < j.N) *(v4u*)(j.WT + (size_t)colmap(j.kind, j.n0 + n) * j.K + j.k0 + 8 * c) = o; } } } \
            __syncthreads(); } while (0)
        for (int t = tb; t < te; t += 2) { TR_STEP(ldA, t); if (t + 1 < te) TR_STEP(ldB, t + 1); }
#undef TR_STEP
    }
}

__device__ __forceinline__ void p1_modulate(Frame& F) {
    const int gw = F.vcu * NWAVES + F.wave, NGW = F.G * NWAVES; const float* mod = (const float*)(F.ws + WS_MOD); bf16* U = (bf16*)(F.ws + WS_U);
    for (int m = gw; m < M; m += NGW) { const float* mb = mod + (size_t)(m >> 11) * 24576; const f32x4* xr = (const f32x4*)(F.in[I_X] + (size_t)m * D) + F.lane;
#pragma unroll 4
        for (int j = 0; j < 16; ++j) { const f32x4 v = xr[64 * j], sh = *((const f32x4*)mb + F.lane + 64 * j), sc = *((const f32x4*)(mb + 4096) + F.lane + 64 * j);
            const f32x4 o = v * (sc + 1.0f) + sh; v2u w; w.x = pk2(o[0], o[1]); w.y = pk2(o[2], o[3]);
            *((v2u*)(U + (size_t)m * D) + F.lane + 64 * j) = w; } }
}
__device__ __forceinline__ void ln_stats(const f32x4 (&v)[16], float& mean, float& rstd) {
    float s = 0.f;
#pragma unroll
    for (int j = 0; j < 16; ++j) s += (v[j][0] + v[j][1]) + (v[j][2] + v[j][3]);
    mean = wave_sum(s) * (1.0f / D); float q = 0.f;
#pragma unroll
    for (int j = 0; j < 16; ++j) { const f32x4 d = v[j] - mean; q += (d[0] * d[0] + d[1] * d[1]) + (d[2] * d[2] + d[3] * d[3]); }
    rstd = 1.0f / sqrtf(wave_sum(q) * (1.0f / D) + LN_EPS);
}
__device__ __forceinline__ void p6_ln1(Frame& F) {
    const int gw = F.vcu * NWAVES + F.wave, NGW = F.G * NWAVES; const float* mod = (const float*)(F.ws + WS_MOD); bf16* U = (bf16*)(F.ws + WS_U);
    const float* Z1 = (const float*)(F.ws + WS_Z1); float* RS1 = (float*)(F.ws + WS_RS1);
    for (int m = gw; m < M; m += NGW) { const float* mb = mod + (size_t)(m >> 11) * 24576; const f32x4* zr = (const f32x4*)(Z1 + (size_t)m * D) + F.lane;
        f32x4 v[16];
#pragma unroll
        for (int j = 0; j < 16; ++j) v[j] = zr[64 * j];
        float mean, rstd; ln_stats(v, mean, rstd);
        if (F.lane == 0) *(f32x2*)(RS1 + 2 * (size_t)m) = (f32x2){mean, rstd};
#pragma unroll
        for (int j = 0; j < 16; ++j) { const f32x4 gg = *((const f32x4*)F.in[I_LN1G] + F.lane + 64 * j), bb = *((const f32x4*)F.in[I_LN1B] + F.lane + 64 * j);
            const f32x4 x1 = (v[j] - mean) * rstd * gg + bb;
            const f32x4 sh = *((const f32x4*)(mb + 3 * 4096) + F.lane + 64 * j), sc = *((const f32x4*)(mb + 4 * 4096) + F.lane + 64 * j);
            const f32x4 o = x1 * (sc + 1.0f) + sh; v2u w; w.x = pk2(o[0], o[1]); w.y = pk2(o[2], o[3]);
            *((v2u*)(U + (size_t)m * D) + F.lane + 64 * j) = w; } }
}
__device__ __forceinline__ void p10_ln2(Frame& F) {
    const int gw = F.vcu * NWAVES + F.wave, NGW = F.G * NWAVES;
    for (int m = gw; m < M; m += NGW) { f32x4* zr = (f32x4*)(F.out + (size_t)m * D) + F.lane;
        f32x4 v[16];
#pragma unroll
        for (int j = 0; j < 16; ++j) v[j] = zr[64 * j];
        float mean, rstd; ln_stats(v, mean, rstd);
#pragma unroll
        for (int j = 0; j < 16; ++j) { const f32x4 gg = *((const f32x4*)F.in[I_LN2G] + F.lane + 64 * j), bb = *((const f32x4*)F.in[I_LN2B] + F.lane + 64 * j);
            zr[64 * j] = (v[j] - mean) * rstd * gg + bb; } }
}
__device__ __forceinline__ void p8_hpass(Frame& F) {
    const bf16* GU = (const bf16*)(F.ws + WS_GU); bf16* H = (bf16*)(F.ws + WS_H);
    const float* cw = F.in[I_CW]; const float* cb = F.in[I_CB];
    const size_t total = (size_t)M * (FF / 8);
    for (size_t idx = (size_t)blockIdx.x * 512 + F.tid; idx < total; idx += (size_t)F.G * 512) {
        const int m = (int)(idx / (FF / 8)), c = (int)(idx % (FF / 8)) * 8, t = m & (SEQ - 1);
        const size_t gcol = (size_t)(c >> 7) * 256 + (c & 127);
        const v4u g2 = *(const v4u*)(GU + (size_t)m * NGU + gcol), up = *(const v4u*)(GU + (size_t)m * NGU + gcol + 128);
        v4u g1 = (v4u){0u, 0u, 0u, 0u}, g0 = (v4u){0u, 0u, 0u, 0u};
        if (t >= 1) g1 = *(const v4u*)(GU + (size_t)(m - 1) * NGU + gcol);
        if (t >= 2) g0 = *(const v4u*)(GU + (size_t)(m - 2) * NGU + gcol);
        float o[8];
#pragma unroll
        for (int e = 0; e < 8; ++e) { const unsigned w2 = g2[e >> 1], w1 = g1[e >> 1], w0 = g0[e >> 1], wu = up[e >> 1];
            const float a2 = (e & 1) ? bfhi(w2) : bflo(w2), a1 = (e & 1) ? bfhi(w1) : bflo(w1), a0 = (e & 1) ? bfhi(w0) : bflo(w0), uu = (e & 1) ? bfhi(wu) : bflo(wu);
            const float gg = cb[c + e] + cw[c + e] * a0 + cw[FF + c + e] * a1 + cw[2 * FF + c + e] * a2;
            o[e] = gg / (1.0f + __expf(-gg)) * uu; }
        v4u w; w.x = pk2(o[0], o[1]); w.y = pk2(o[2], o[3]); w.z = pk2(o[4], o[5]); w.w = pk2(o[6], o[7]);
        *(v4u*)(H + (size_t)m * FF + c) = w;
    }
}


namespace att {
typedef float f32x16 __attribute__((ext_vector_type(16)));
typedef short bf16x8 __attribute__((ext_vector_type(8)));
constexpr int VP = 144;
constexpr int KREG = 32768, BUF_STRIDE = 57344;
constexpr int X_OFF = 2 * BUF_STRIDE;
__device__ __forceinline__ int swap23(int r) { return (r & ~12) | ((r & 4) << 1) | ((r & 8) >> 1); }
__device__ __forceinline__ unsigned sortable(float f) { const unsigned u = __builtin_bit_cast(unsigned, f); return (u & 0x80000000u) ? ~u : (u | 0x80000000u); }

template <int OFF> __device__ __forceinline__ void lds_rd128(bf16x8& d, unsigned addr) { asm volatile("ds_read_b128 %0, %1 offset:%2" : "=v"(d) : "v"(addr), "n"(OFF)); }
template <int N> __device__ __forceinline__ void lgkm_wait(bf16x8& d) { asm volatile("s_waitcnt lgkmcnt(%1)" : "+v"(d) : "n"(N)); }
struct Stg {
    const unsigned char* base;
    unsigned koff[4], kstep[4], voff[3];
    unsigned ldsk, ldsv;
    int nk, nv;
    template <int E> __device__ __forceinline__ void k() { if (E < nk) __builtin_amdgcn_global_load_lds((const unsigned*)(base + koff[E]), (LAS unsigned*)(unsigned long long)(ldsk + E * 1024), 16, 0, 0); }
    template <int E> __device__ __forceinline__ void v() { if (E < nv) __builtin_amdgcn_global_load_lds((const unsigned*)(base + voff[E]), (LAS unsigned*)(unsigned long long)(ldsv + E * 1024), 16, 0, 0); }
};
template <int N, int KSTEPS, int KP, int PF> struct SStep {
    static __device__ __forceinline__ void run(bf16x8 (&fr)[PF], f32x16 (&sa)[2], const bf16x8 (&qf)[KSTEPS], unsigned base, Stg& st, bool more) {
        constexpr int NMM = 2 * KSTEPS, kb = N / KSTEPS, s = N % KSTEPS, GAP = NMM / 4;
        lgkm_wait<((NMM - N < PF) ? NMM - N : PF) - 1>(fr[N % PF]);
        sa[kb] = __builtin_amdgcn_mfma_f32_32x32x16_bf16(fr[N % PF], qf[s], sa[kb], 0, 0, 0);
        if constexpr (N + PF < NMM) lds_rd128<32 * ((N + PF) / KSTEPS) * KP + 32 * ((N + PF) % KSTEPS)>(fr[N % PF], base);
        if constexpr (N % 2 == 1 && N < 8) st.template k<N / 2>();
        if constexpr (N % 2 == 1 && N >= 8 && N < 14) st.template v<(N - 8) / 2>();
        if constexpr (N + 1 < NMM) SStep<N + 1, KSTEPS, KP, PF>::run(fr, sa, qf, base, st, more);
    }
};
template <int N, int PF> struct PVStep {
    static __device__ __forceinline__ void run(bf16x8 (&fr)[PF], f32x16 (&o)[4], const bf16x8 (&pf)[4], unsigned base, Stg& st, bool more) {
        constexpr int d = N / 4, ks = N % 4;
        lgkm_wait<((16 - N < PF) ? 16 - N : PF) - 1>(fr[N % PF]);
        o[d] = __builtin_amdgcn_mfma_f32_32x32x16_bf16(fr[N % PF], pf[ks], o[d], 0, 0, 0);
        if constexpr (N + PF < 16) lds_rd128<32 * ((N + PF) / 4) * VP + 32 * ((N + PF) % 4)>(fr[N % PF], base);
        if constexpr (N + 1 < 16) PVStep<N + 1, PF>::run(fr, o, pf, base, st, more);
    }
};
template <int N, int KSTEPS, int KP, int PF> struct SPre { static __device__ __forceinline__ void run(bf16x8 (&fr)[PF], unsigned base) {
    lds_rd128<32 * (N / KSTEPS) * KP + 32 * (N % KSTEPS)>(fr[N], base); if constexpr (N + 1 < PF) SPre<N + 1, KSTEPS, KP, PF>::run(fr, base); } };
template <int N, int PF> struct PVPre { static __device__ __forceinline__ void run(bf16x8 (&fr)[PF], unsigned base) {
    lds_rd128<32 * (N / 4) * VP + 32 * (N % 4)>(fr[N], base); if constexpr (N + 1 < PF) PVPre<N + 1, PF>::run(fr, base); } };
__device__ __forceinline__ void dsa_topk(Frame& F, int b, int q0, int slot) {
    const int tid = F.tid, lane = F.lane, w = F.wave; LAS unsigned char* lds = F.lds; const size_t brow = (size_t)b * SEQ;
    LAS unsigned* bmp = (LAS unsigned*)(lds + X_OFF) + slot * 1024;
    LAS float* rb2 = (LAS float*)(lds + X_OFF + 8192 + 1024);
    {
        const float* SC = (const float*)(F.ws + WS_SC);
        for (int idx = tid; idx < 2048; idx += 512) rb2[idx] = F.in[I_RELB][(int)BUCKET_TAB[idx >> 4] * 16 + (idx & 15)] * 1.4426950408889634f;
        for (int tt = 0; tt < 2; ++tt) {
            const int t = q0 + 2 * w + tt, n = t + 1; const float* row = SC + (brow + t) * SEQ;
            unsigned u[32];
#pragma unroll
            for (int j = 0; j < 32; ++j) { const int s = 64 * j + lane; u[j] = 0u; if (64 * j < n) { if (s < n) u[j] = sortable(row[s]); } }
            unsigned T = 1u;
            bool exact = true;
            if (n > 256) {
                T = 0u; exact = false;
                for (int bit = 31; bit >= 0; --bit) {
                    const unsigned cand = T | (1u << bit); int c = 0;
#pragma unroll
                    for (int j = 0; j < 32; ++j) c += __popcll(__ballot(u[j] >= cand));
                    if (c >= 256) T = cand;
                    if (c == 256) { exact = true; break; }
                }
            }
            if (exact) {
#pragma unroll
                for (int j = 0; j < 32; ++j) { const unsigned long long mk = __ballot(u[j] >= T); if (lane < 2) bmp[(2 * w + tt) * 64 + 2 * j + lane] = (unsigned)(mk >> (32 * lane)); }
            } else {
                int need = 256;
#pragma unroll
                for (int j = 0; j < 32; ++j) need -= __popcll(__ballot(u[j] > T));
#pragma unroll
                for (int j = 0; j < 32; ++j) { unsigned long long mk = __ballot(u[j] > T), eq = __ballot(u[j] == T);
                    while (eq != 0ull && need > 0) { const unsigned long long low = eq & (~eq + 1ull); mk |= low; eq ^= low; --need; }
                    if (lane < 2) bmp[(2 * w + tt) * 64 + 2 * j + lane] = (unsigned)(mk >> (32 * lane)); }
            }
        }
    }
}
template <int MODE> __device__ __forceinline__ void attn_unit(Frame& F, int b, int h, int q0, int slot) {
    constexpr int KD = MODE == 0 ? 192 : 128, KCH = KD / 8, KP = (KCH + 1) * 16, KSTEPS = KD / 16, KTILE = 64 * KP;
    constexpr int KROWCH = KCH + 1;
    static_assert(64 * KP <= KREG && KREG + 128 * VP <= BUF_STRIDE, "tile buffers");
    const int tid = F.tid, lane = F.lane, w = F.wave, l32 = lane & 31, hh = lane >> 5;
    LAS unsigned char* lds = F.lds;
    unsigned long long wsl_ = (unsigned long long)F.ws; asm volatile("" : "+s"(wsl_));
    unsigned char* const WSP = (unsigned char*)wsl_;
    unsigned long long posl_ = (unsigned long long)F.in[I_POS]; asm volatile("" : "+s"(posl_)); const int* const POSP = (const int*)posl_;
    const bf16* QG; const bf16* KG; const bf16* K2G = nullptr; const bf16* VTG; bf16* MIX = (bf16*)(WSP + WS_MIX);
    if (MODE == 0) { QG = (const bf16*)(WSP + WS_QB); KG = (const bf16*)(WSP + WS_KN); K2G = (const bf16*)(WSP + WS_IKX); VTG = (const bf16*)(WSP + WS_VT) + (size_t)(h * 128) * M; }
    else { QG = (const bf16*)(WSP + WS_AQ); KG = (const bf16*)(WSP + WS_AKV); VTG = (const bf16*)(WSP + WS_VTA); }
    const size_t brow = (size_t)b * SEQ;
    int tq, qhead;
    if (MODE == 0) { tq = q0 + 32 * w + l32; qhead = h; } else { tq = q0 + 2 * w + (l32 >> 4); qhead = l32 & 15; }
    const int nt = MODE == 0 ? (q0 + 256) / 64 : (q0 + 16 + 63) / 64;
    LAS unsigned* bmp = (LAS unsigned*)(lds + X_OFF) + slot * 1024;
    LAS int* posk = (LAS int*)(lds + X_OFF + 8192);
    LAS int* farf = (LAS int*)(lds + X_OFF + 8192 + 512);
    LAS float* rb2 = (LAS float*)(lds + X_OFF + 8192 + 1024);
    bf16x8 qf[KSTEPS];
    int posq = 0, minposq = 0; float bias_far = 0.f;
    if (MODE == 1) { const int* pos = POSP; posq = pos[brow + tq]; const int p0 = pos[brow + q0 + 2 * w], p1 = pos[brow + q0 + 2 * w + 1]; minposq = p0 < p1 ? p0 : p1; }
    Stg st; st.base = WSP;
    { constexpr int NKI = (64 * KROWCH + 63) / 64, NVI = 18;
      int ln_ = lane; asm volatile("" : "+v"(ln_));
      st.nk = NKI - 4 * w; st.nk = st.nk < 0 ? 0 : (st.nk > 4 ? 4 : st.nk); st.nv = NVI - 3 * w; st.nv = st.nv < 0 ? 0 : (st.nv > 3 ? 3 : st.nv);
#pragma unroll
      for (int e = 0; e < 4; ++e) { const int q = (4 * w + e) * 64 + ln_, rho = q / KROWCH, c = q % KROWCH; const bool ok = rho < 64 && c < KCH; const unsigned kr = (unsigned)swap23(rho & 63);
          if (MODE == 0) { const bool two = c >= 16;
              st.koff[e] = !ok ? (unsigned)WS_KN : (two ? (unsigned)WS_IKX + ((unsigned)(brow + kr) * 256u + 128u + 8u * (c - 16)) * 2u : (unsigned)WS_KN + ((unsigned)(brow + kr) * 2048u + (unsigned)h * 128u + 8u * c) * 2u);
              st.kstep[e] = !ok ? 0u : (two ? 64u * 512u : 64u * 4096u); }
          else { st.koff[e] = !ok ? (unsigned)WS_AKV : (unsigned)WS_AKV + ((unsigned)(brow + kr) * 256u + 8u * c) * 2u; st.kstep[e] = !ok ? 0u : 64u * 512u; } }
#pragma unroll
      for (int e = 0; e < 3; ++e) { const int q = (3 * w + e) * 64 + ln_, d = q / 9, c = q % 9; const bool ok = d < 128 && c < 8;
          const unsigned vb = MODE == 0 ? (unsigned)WS_VT + (unsigned)(h * 128) * (unsigned)(M * 2) : (unsigned)WS_VTA;
          st.voff[e] = !ok ? vb : vb + (unsigned)d * (unsigned)(M * 2) + ((unsigned)brow + 8u * c) * 2u; } }
#define ATT_ADVANCE() do { _Pragma("unroll") for (int e = 0; e < 4; ++e) st.koff[e] += st.kstep[e]; _Pragma("unroll") for (int e = 0; e < 3; ++e) st.voff[e] += 128u; } while (0)
#define ATT_TARGET(i_) do { const unsigned tb_ = (unsigned)(unsigned long long)(lds + ((i_) & 1) * BUF_STRIDE); st.ldsk = tb_ + 4 * w * 1024; st.ldsv = tb_ + KREG + 3 * w * 1024; } while (0)
#define ATT_POS(i_) do { if (MODE == 1 && tid < 64) { const int* pos_ = POSP + brow + 64 * (i_); const int pk = pos_[tid]; posk[((i_) & 1) * 64 + tid] = pk; int mx = pk; \
            _Pragma("unroll") for (int o_ = 1; o_ < 64; o_ <<= 1) { const int y = __shfl_xor(mx, o_); mx = mx > y ? mx : y; } \
            if (tid == 0) farf[(i_) & 1] = mx; } } while (0)
    f32x16 o[4];
#pragma unroll
    for (int d = 0; d < 4; ++d)
#pragma unroll
        for (int r = 0; r < 16; ++r) o[d][r] = 0.f;
    float ninit = 0.f, lrun = 0.f;
    constexpr float THR = 8.0f;
    __syncthreads();
    if (MODE == 1) bias_far = rb2[127 * 16 + qhead];
    { const bf16* qp = MODE == 0 ? QG + (brow + tq) * 3072 + qhead * 192 + 8 * hh : QG + (brow + tq) * 2048 + qhead * 128 + 8 * hh;
#pragma unroll
      for (int s = 0; s < KSTEPS; ++s) qf[s] = *(const bf16x8*)(qp + 16 * s); }
    ATT_TARGET(0); st.k<0>(); st.k<1>(); st.k<2>(); st.k<3>(); st.v<0>(); st.v<1>(); st.v<2>(); ATT_POS(0); ATT_ADVANCE();
    asm volatile("s_waitcnt vmcnt(0)" ::: "memory"); __syncthreads();
    const int tmin = MODE == 0 ? q0 + 32 * w : q0;
    for (int i = 0; i < nt; ++i) {
        const bool more = i + 1 < nt;
        ATT_TARGET(i + 1); if (more) ATT_POS(i + 1);
        const int key0 = 64 * i;
        {
            const LAS unsigned char* kbuf = lds + (i & 1) * BUF_STRIDE; const LAS unsigned char* vbuf = kbuf + KREG;
            constexpr int PF = MODE == 0 ? 4 : 3;
            const unsigned kbase = (unsigned)(unsigned long long)(kbuf + l32 * KP + hh * 16), vbase = (unsigned)(unsigned long long)(vbuf + l32 * VP + hh * 16);
            f32x16 sa[2]; bf16x8 fr[PF];
            SPre<0, KSTEPS, KP, PF>::run(fr, kbase);
            if (MODE == 0) {
#pragma unroll
                for (int kb = 0; kb < 2; ++kb)
#pragma unroll
                    for (int r = 0; r < 16; ++r) sa[kb][r] = ninit;
            } else {
                const bool far_ = __builtin_amdgcn_readfirstlane(minposq - farf[i & 1]) >= 128;
#pragma unroll
                for (int kb = 0; kb < 2; ++kb)
#pragma unroll
                    for (int g = 0; g < 2; ++g) { float bia[8];
#pragma unroll
                        for (int e = 0; e < 8; ++e) bia[e] = bias_far;
                        if (!far_) { const LAS int* pp = posk + (i & 1) * 64 + 32 * kb + 16 * g + 8 * hh;
#pragma unroll
                            for (int e = 0; e < 8; ++e) { int rel = posq - pp[e]; rel = rel < 0 ? 0 : (rel > 127 ? 127 : rel); bia[e] = rb2[rel * 16 + qhead]; } }
#pragma unroll
                        for (int e = 0; e < 8; ++e) sa[kb][8 * g + e] = bia[e] + ninit;
                        __builtin_amdgcn_sched_barrier(0); }
            }
            SStep<0, KSTEPS, KP, PF>::run(fr, sa, qf, kbase, st, more);
            if (MODE == 0) {
                if (key0 + 63 > tmin) {
#pragma unroll
                    for (int kb = 0; kb < 2; ++kb)
#pragma unroll
                        for (int r = 0; r < 16; ++r) { const int key = key0 + 32 * kb + 16 * (r >> 3) + 8 * hh + (r & 7); const float xv = sa[kb][r]; sa[kb][r] = key > tq ? -__builtin_inff() : xv; }
                }
            } else {
                const v2u wds = *(const LAS v2u*)(bmp + (2 * w + (l32 >> 4)) * 64 + 2 * i);
#pragma unroll
                for (int kb = 0; kb < 2; ++kb) { const int wdh = (int)((kb == 0 ? wds.x : wds.y) >> (8 * hh));
#pragma unroll
                    for (int r = 0; r < 16; ++r) { const int mk = __builtin_amdgcn_sbfe(wdh, 16 * (r >> 3) + (r & 7), 1); const float xv = sa[kb][r];
                        sa[kb][r] = __builtin_bit_cast(float, (__builtin_bit_cast(int, xv) & mk) | ((int)0xff800000 & ~mk)); } }
            }
            float mloc = sa[0][0];
#pragma unroll
            for (int kb = 0; kb < 2; ++kb)
#pragma unroll
                for (int r = 0; r < 16; ++r) mloc = fmaxf(mloc, sa[kb][r]);
            mloc = fmaxf(mloc, __shfl_xor(mloc, 32));
            if (i == 0 || __any(mloc > THR)) {
                const float delta = i == 0 ? (mloc > -1.0e30f ? mloc : 0.f) : fmaxf(mloc, 0.f), alpha = __builtin_amdgcn_exp2f(-delta);
                ninit -= delta; lrun *= alpha;
#pragma unroll
                for (int kb = 0; kb < 2; ++kb)
#pragma unroll
                    for (int r = 0; r < 16; ++r) sa[kb][r] -= delta;
#pragma unroll
                for (int d = 0; d < 4; ++d)
#pragma unroll
                    for (int r = 0; r < 16; ++r) o[d][r] *= alpha;
            }
            float psum = 0.f;
#pragma unroll
            for (int kb = 0; kb < 2; ++kb)
#pragma unroll
                for (int r = 0; r < 16; ++r) { const float p = __builtin_amdgcn_exp2f(sa[kb][r]); sa[kb][r] = p; psum += p; }
            lrun += psum;
            bf16x8 pf[4];
#pragma unroll
            for (int ks = 0; ks < 4; ++ks) { v4u pk;
#pragma unroll
                for (int e = 0; e < 4; ++e) pk[e] = pg8::cvt_pk_bf16(sa[ks >> 1][8 * (ks & 1) + 2 * e], sa[ks >> 1][8 * (ks & 1) + 2 * e + 1]);
                pf[ks] = __builtin_bit_cast(bf16x8, pk); }
            PVPre<0, PF>::run(fr, vbase);
            PVStep<0, PF>::run(fr, o, pf, vbase, st, more);
        }
        ATT_ADVANCE();
        asm volatile("s_waitcnt vmcnt(0)" ::: "memory"); __syncthreads();
    }
    { const float lt = lrun + __shfl_xor(lrun, 32), inv = 16.0f / lt;
      int tq2 = tq; asm volatile("" : "+v"(tq2));
      const unsigned oo = (unsigned)(b * SEQ + tq2) * 4096u + (MODE == 0 ? 2048u + (unsigned)h * 128u : (unsigned)qhead * 128u);
      unsigned char* op = (unsigned char*)MIX + oo;
#pragma unroll
      for (int d = 0; d < 4; ++d)
#pragma unroll
          for (int g = 0; g < 4; ++g) { int wv = 0; wv = __builtin_amdgcn_cvt_pk_fp8_f32(o[d][4 * g] * inv, o[d][4 * g + 1] * inv, wv, false); wv = __builtin_amdgcn_cvt_pk_fp8_f32(o[d][4 * g + 2] * inv, o[d][4 * g + 3] * inv, wv, true);
              *(unsigned*)(op + 32 * d + 8 * g + 4 * hh) = (unsigned)wv; } }
}
#undef ATT_ADVANCE
#undef ATT_TARGET
#undef ATT_POS
}

__device__ __forceinline__ void indexer_unit(Frame& F, int b, int t0) {
    constexpr int KP = 272, KTILE = 64 * KP;
    const int tid = F.tid, lane = F.lane, w = F.wave, l32 = lane & 31, hh = lane >> 5;
    LAS unsigned char* lds = F.lds;
    const bf16* IQ = (const bf16*)(F.ws + WS_IQ); const bf16* IKX = (const bf16*)(F.ws + WS_IKX); const float* IW = (const float*)(F.ws + WS_IW); float* SC = (float*)(F.ws + WS_SC);
    const size_t brow = (size_t)b * SEQ, m0 = brow + t0 + 2 * w;
    att::bf16x8 af[2][8]; float wt[2][16];
#pragma unroll
    for (int tt = 0; tt < 2; ++tt) {
#pragma unroll
        for (int s = 0; s < 8; ++s) af[tt][s] = *(const att::bf16x8*)(IQ + (m0 + tt) * 4096 + l32 * 128 + 16 * s + 8 * hh);
#pragma unroll
        for (int g = 0; g < 4; ++g) { const f32x4 v = *(const f32x4*)(IW + (m0 + tt) * 32 + 8 * g + 4 * hh); wt[tt][4 * g] = v[0]; wt[tt][4 * g + 1] = v[1]; wt[tt][4 * g + 2] = v[2]; wt[tt][4 * g + 3] = v[3]; }
    }
    const int nt = (t0 + 16 + 63) / 64;
    v4u st[2];
#define IDX_LOAD(i_) do { _Pragma("unroll") for (int e = 0; e < 2; ++e) { const int q = tid + 512 * e, rho = q >> 4, c = q & 15; st[e] = *(const v4u*)(IKX + (brow + 64 * (i_) + rho) * 256 + 8 * c); } } while (0)
#define IDX_STORE(i_) do { _Pragma("unroll") for (int e = 0; e < 2; ++e) { const int q = tid + 512 * e, rho = q >> 4, c = q & 15; *(LAS v4u*)(lds + ((i_) & 1) * KTILE + rho * KP + c * 16) = st[e]; } } while (0)
    __syncthreads();
    IDX_LOAD(0); IDX_STORE(0);
    __syncthreads();
    for (int i = 0; i < nt; ++i) {
        if (i + 1 < nt) IDX_LOAD(i + 1);
        const LAS unsigned char* kbuf = lds + (i & 1) * KTILE;
#pragma unroll
        for (int kb = 0; kb < 2; ++kb) {
            att::bf16x8 bfr[8];
#pragma unroll
            for (int s = 0; s < 8; ++s) bfr[s] = *(const LAS att::bf16x8*)(kbuf + (32 * kb + l32) * KP + (2 * s + hh) * 16);
            float sc[2];
#pragma unroll
            for (int tt = 0; tt < 2; ++tt) {
                att::f32x16 acc;
#pragma unroll
                for (int r = 0; r < 16; ++r) acc[r] = 0.f;
#pragma unroll
                for (int s = 0; s < 8; ++s) acc = __builtin_amdgcn_mfma_f32_32x32x16_bf16(af[tt][s], bfr[s], acc, 0, 0, 0);
                float x = 0.f;
#pragma unroll
                for (int r = 0; r < 16; ++r) x += wt[tt][r] * fmaxf(acc[r], 0.f);
                sc[tt] = x + __shfl_xor(x, 32);
            }
            SC[(m0 + hh) * SEQ + 64 * i + 32 * kb + l32] = hh ? sc[1] : sc[0];
        }
        if (i + 1 < nt) IDX_STORE(i + 1);
        __syncthreads();
    }
#undef IDX_LOAD
#undef IDX_STORE
}
__device__ __forceinline__ void av_transpose(Frame& F, int tile) {
    const bf16* AKV = (const bf16*)(F.ws + WS_AKV); bf16* VTA = (bf16*)(F.ws + WS_VTA);
    LAS unsigned short* T = (LAS unsigned short*)F.lds;
    __syncthreads();
#pragma unroll
    for (int e = 0; e < 2; ++e) { const int tok = F.tid & 63, c = (F.tid >> 6) + 8 * e; const v4u v = *(const v4u*)(AKV + (size_t)(64 * tile + tok) * 256 + 128 + 8 * c);
#pragma unroll
        for (int k = 0; k < 4; ++k) { T[(8 * c + 2 * k) * 72 + tok] = (unsigned short)(v[k] & 0xffffu); T[(8 * c + 2 * k + 1) * 72 + tok] = (unsigned short)(v[k] >> 16); } }
    __syncthreads();
    { const int d = F.tid >> 2, part = F.tid & 3; const LAS v4u* s = (const LAS v4u*)(T + d * 72 + 16 * part);
      v4u* dst = (v4u*)(VTA + (size_t)d * M + 64 * tile + 16 * part); dst[0] = s[0]; dst[1] = s[1]; }
    __syncthreads();
}

struct Args { const float* in[21]; float* out; unsigned char* ws; int ph_lo, ph_hi; };
__global__ void __launch_bounds__(NWAVES * 64, 2) skel_fwd(Args args) {
    extern __shared__ __attribute__((aligned(16))) unsigned char lds[];
    Frame F;
    F.lds = (LAS unsigned char*)lds;
    F.MISC = (volatile LAS unsigned*)(F.lds + MISC_OFF);
    F.tid = threadIdx.x; F.lane = F.tid & 63; F.wave = __builtin_amdgcn_readfirstlane(F.tid >> 6);
    F.G = gridDim.x; { const int bx = blockIdx.x; F.vcu = (F.G % 8 == 0) ? (bx % 8) * (F.G / 8) + bx / 8 : bx; }
    F.ws = args.ws; F.ctl = (gu32*)(args.ws + WS_CTL); F.out = args.out;
#pragma unroll
    for (int i = 0; i < 21; ++i) F.in[i] = args.in[i];
    for (int u = F.tid; u < (LDS_BYTES - LDSCTL_OFF) / 4; u += NWAVES * 64) ((LAS unsigned*)(F.lds + LDSCTL_OFF))[u] = 0u;
    __syncthreads();
    XcdBarrier bar; bar.bar = (unsigned*)(F.ctl + CW_BAR); bar.x = 0; bar.st = nullptr;
    const int lo = args.ph_lo, hi = args.ph_hi;
    if (hi - lo > 1) bar = xcd_barrier_post((unsigned*)(F.ctl + CW_BAR), F.MISC + 8);
#define IN(k) (lo <= (k) && (k) < hi)
#define SEAM(k) do { if (IN(k) && IN((k) + 1)) xcd_barrier(bar); } while (0)
    unsigned char* ws = args.ws;

    if (IN(0)) { p0_prologue(F); SEAM(0); }
    if (IN(1)) { p1_modulate(F); SEAM(1); }
    if (IN(2)) {
        pg8::Gemm g{(const bf16*)(ws + WS_U), (const bf16*)(ws + WS_WIN), D, D}; pg8::StaticOrder S; S.init(M, NIN, F.G, (int)blockIdx.x);
        pg8::EpiProj E{(bf16*)(ws + WS_AQ), (bf16*)(ws + WS_AKV), (bf16*)(ws + WS_IQ), (bf16*)(ws + WS_IKX), (bf16*)(ws + WS_QL), (bf16*)(ws + WS_KVL),
                       (float*)(ws + WS_IW), (float*)(ws + WS_RSQQ), (float*)(ws + WS_RSQK), (const float*)(ws + WS_ROPE)};
        pg8::gemm_phase<pg8::EpiProj, pg8::StaticOrder, true, true>(F.lds + RING_OFF, g, S, E);
        SEAM(2);
    }
    if (IN(3)) {
        { pg8::Gemm g{(const bf16*)(ws + WS_QL), (const bf16*)(ws + WS_WUQ), 512, 512}; pg8::StaticOrder S; S.init(M, 3072, F.G, (int)blockIdx.x);
          pg8::EpiUp<true> E{(bf16*)(ws + WS_QB), 3072, (const float*)(ws + WS_RSQQ), (const float*)(ws + WS_ROPE)};
          pg8::gemm_phase<pg8::EpiUp<true>, pg8::StaticOrder, true, true, true>(F.lds + RING_OFF, g, S, E); }
        { pg8::Gemm g{(const bf16*)(ws + WS_KVL), (const bf16*)(ws + WS_WUKV), 256, 256}; pg8::StaticOrder S; S.init(M, 2048, F.G, (int)blockIdx.x);
          pg8::EpiUp<false> E{(bf16*)(ws + WS_KN), 2048, (const float*)(ws + WS_RSQK), nullptr};
          pg8::gemm_phase<pg8::EpiUp<false>, pg8::StaticOrder, true, true, true>(F.lds + RING_OFF, g, S, E); }
        { pg8::Gemm g{(const bf16*)(ws + WS_WUKV) + (size_t)2048 * 256, (const bf16*)(ws + WS_KVL), 256, 256}; pg8::StaticOrder S; S.init(2048, M, F.G, (int)blockIdx.x);
          pg8::EpiVT E{(bf16*)(ws + WS_VT), (const float*)(ws + WS_RSQK)};
          pg8::gemm_phase<pg8::EpiVT, pg8::StaticOrder, true, true, true>(F.lds + RING_OFF, g, S, E); }
        __syncthreads();
        if (blockIdx.x < 128) av_transpose(F, (int)blockIdx.x);
        for (int P = F.vcu; P < 256; P += F.G)     { const int b = P >> 6, j = P & 63; for (int k = 0; k < 2; ++k) indexer_unit(F, b, 16 * (k ? 127 - j : j)); }
        SEAM(3);
    }
    if (IN(4)) {
        for (int P = F.vcu; P < 256; P += F.G)     { const int b = P >> 6, h = (P >> 2) & 15, j = P & 3; for (int k = 0; k < 2; ++k) att::attn_unit<0>(F, b, h, 256 * (k ? 7 - j : j), 0); }
        __syncthreads();
        for (int P = F.vcu; P < 256; P += F.G)     { const int b = P >> 6, j = P & 63;
            __syncthreads();
            for (int k = 0; k < 2; ++k) att::dsa_topk(F, b, 16 * (k ? 127 - j : j), k);
            for (int k = 0; k < 2; ++k) att::attn_unit<1>(F, b, 0, 16 * (k ? 127 - j : j), k); }
        SEAM(4);
    }
    if (IN(5)) {
        pg8::Gemm g{(const bf16*)(ws + WS_MIX), (const bf16*)(ws + WS_WO), D / 2, D / 2};     pg8::StaticOrder S; S.init(M, D, F.G, (int)blockIdx.x);
        pg8::EpiZ<false, 11> E{F.in[I_X], (float*)(ws + WS_Z1), (const float*)(ws + WS_MOD) + 2 * 4096, nullptr, nullptr, nullptr};
        pg8::gemm_phase<pg8::EpiZ<false, 11>, pg8::StaticOrder, true, true, true>(F.lds + RING_OFF, g, S, E);
        SEAM(5);
    }
    if (IN(6)) { p6_ln1(F); SEAM(6); }
    if (IN(7)) {
        pg8::Gemm g{(const bf16*)(ws + WS_U), (const bf16*)(ws + WS_WGU), D, D}; pg8::StaticOrder S; S.init(M, NGU, F.G, (int)blockIdx.x);
        pg8::EpiPlain E{(bf16*)(ws + WS_GU), NGU};
        pg8::gemm_phase<pg8::EpiPlain, pg8::StaticOrder, true, true>(F.lds + RING_OFF, g, S, E);
        SEAM(7);
    }
    if (IN(8)) { p8_hpass(F); SEAM(8); }
    if (IN(9)) {
        pg8::Gemm g{(const bf16*)(ws + WS_H), (const bf16*)(ws + WS_WD), FF, FF}; pg8::StaticOrder S; S.init(M, D, F.G, (int)blockIdx.x);
        pg8::EpiZ<true, 0> E{(const float*)(ws + WS_Z1), F.out, (const float*)(ws + WS_MOD) + 5 * 4096, (const float*)(ws + WS_RS1), F.in[I_LN1G], F.in[I_LN1B]};
        pg8::gemm_phase<pg8::EpiZ<true, 0>, pg8::StaticOrder, true, true>(F.lds + RING_OFF, g, S, E);
        SEAM(9);
    }
    if (IN(10)) { p10_ln2(F); }
#undef IN
#undef SEAM
}

extern "C" void kernel_launch(void* const* d_in, const int* in_sizes, int n_in, void* d_out, int out_size, void* d_ws, size_t ws_size, hipStream_t stream) {
    static int grid = 0;
    if (grid == 0) {
        if (n_in != 21 || in_sizes[0] != M * D || out_size != M * D || ws_size < WS_END) { fprintf(stderr, "kernel_launch: unexpected shapes (n_in %d, in0 %d, out %d, ws %zu); nothing launched\n", n_in, n_in > 0 ? in_sizes[0] : -1, out_size, ws_size); grid = -1; return; }
        int dev = 0, cus = 0, per_cu = 0;
        if (hipGetDevice(&dev) != hipSuccess || hipDeviceGetAttribute(&cus, hipDeviceAttributeMultiprocessorCount, dev) != hipSuccess) { grid = -1; return; }
        if (hipFuncSetAttribute((const void*)skel_fwd, hipFuncAttributeMaxDynamicSharedMemorySize, LDS_BYTES) != hipSuccess) { fprintf(stderr, "kernel_launch: hipFuncSetAttribute failed\n"); grid = -1; return; }
        if (hipOccupancyMaxActiveBlocksPerMultiprocessor(&per_cu, (const void*)skel_fwd, NWAVES * 64, LDS_BYTES) != hipSuccess || per_cu < 1)
            fprintf(stderr, "kernel_launch: note: occupancy query reports %d workgroups per CU\n", per_cu);
        (void)hipGetLastError();
        grid = cus;
    }
    if (grid < 0) return;
    if (hipMemsetAsync((char*)d_ws + WS_CTL, 0, CTL_ZERO_BYTES, stream) != hipSuccess) return;
    Args a{};
    for (int i = 0; i < 21; ++i) a.in[i] = (const float*)d_in[i];
    a.out = (float*)d_out; a.ws = (unsigned char*)d_ws;
#if MK_ONE_LAUNCH
    a.ph_lo = 0; a.ph_hi = N_PHASES;
    hipLaunchKernelGGL(skel_fwd, dim3(grid), dim3(NWAVES * 64), LDS_BYTES, stream, a);
#else
    for (int p = 0; p < N_PHASES; ++p) { a.ph_lo = p; a.ph_hi = p + 1; hipLaunchKernelGGL(skel_fwd, dim3(grid), dim3(NWAVES * 64), LDS_BYTES, stream, a); }
#endif
}
```

```cpp
#include <hip/hip_runtime.h>
#include <cstdio>
#include <cstdint>

namespace pg8 {
#define PG8_LAS __attribute__((address_space(3)))
typedef unsigned short bf16_t;
typedef short bf16x8 __attribute__((ext_vector_type(8)));
typedef float f32x4 __attribute__((ext_vector_type(4)));
typedef unsigned u32x4 __attribute__((ext_vector_type(4)));
constexpr int BM = 256, BK = 64, HALF = 128, HTB = HALF * BK * 2  , STAGE_BYTES = 8 * HTB, NXCD = 8, WGM = 8;

__host__ __device__ __forceinline__ int lds_byte(int r, int c) { const int st = (r >> 4) * 2 + (c >> 5), rr = r & 15, cc = c & 31, ob = rr * 64 + cc * 2; return st * 1024 + (ob ^ (((ob >> 9) & 1) << 5)); }
__host__ __device__ __forceinline__ void stage_rc(int b, int& R, int& C) { const int st = b / 1024, sb = b % 1024, swz = sb ^ (((sb >> 9) & 1) << 5); R = (st >> 1) * 16 + swz / 64; C = (st & 1) * 32 + (swz % 64) / 2; }
__host__ __device__ __forceinline__ int perm32(int rho) { const int n = rho >> 4, i = rho & 15; return 8 * (i >> 2) + 4 * n + (i & 3); }

struct Unit { int pm, pn; };
struct Gemm { const bf16_t* A; const bf16_t* Bt; int lda, K; };
typedef int i32x4 __attribute__((ext_vector_type(4)));
typedef int i32x8 __attribute__((ext_vector_type(8)));
__device__ __forceinline__ i32x8 cat8(bf16x8 lo, bf16x8 hi) { return __builtin_shufflevector(__builtin_bit_cast(i32x4, lo), __builtin_bit_cast(i32x4, hi), 0, 1, 2, 3, 4, 5, 6, 7); }

struct StaticOrder {
    int nM, nN, nwg, G, c;
    __host__ __device__ void init(int M, int N, int G_, int c_) { nM = M / BM; nN = N / BM; nwg = nM * nN; G = G_; c = c_; }
    __host__ __device__ bool next(int i, Unit& u) const {
        const long L = (long)i * G + c; if (L >= nwg) return false;
        int wgid = (int)L; { const int q = nwg / NXCD, r = nwg % NXCD, xcd = wgid % NXCD, off = wgid / NXCD; wgid = (xcd < r ? xcd * (q + 1) : r * (q + 1) + (xcd - r) * q) + off; }
        const int nig = WGM * nN, gid = wgid / nig, fm = gid * WGM, gsz = (nM - fm) < WGM ? (nM - fm) : WGM;
        u.pm = fm + ((wgid % nig) % gsz); u.pn = (wgid % nig) / gsz; return true;
    }
    __device__ __forceinline__ void a_ready(const Unit&) const {}
    __device__ __forceinline__ void done(const Unit&) const {}
};

__device__ __forceinline__ unsigned cvt_pk_bf16(float lo, float hi) { unsigned r; asm volatile("v_cvt_pk_bf16_f32 %0, %1, %2" : "=v"(r) : "v"(lo), "v"(hi)); return r; }
__device__ __forceinline__ u32x4 pack8(const f32x4 v0, const f32x4 v1) { u32x4 w; w.x = cvt_pk_bf16(v0[0], v0[1]); w.y = cvt_pk_bf16(v0[2], v0[3]); w.z = cvt_pk_bf16(v1[0], v1[1]); w.w = cvt_pk_bf16(v1[2], v1[3]); return w; }
__device__ __forceinline__ void rope8(f32x4& v0, f32x4& v1, const float* rp) {
    const f32x4 c0 = *(const f32x4*)rp, c1 = *(const f32x4*)(rp + 4);
    float a, b;
    a = v0[0] * c0[0] - v0[1] * c0[1]; b = v0[0] * c0[1] + v0[1] * c0[0]; v0[0] = a; v0[1] = b;
    a = v0[2] * c0[2] - v0[3] * c0[3]; b = v0[2] * c0[3] + v0[3] * c0[2]; v0[2] = a; v0[3] = b;
    a = v1[0] * c1[0] - v1[1] * c1[1]; b = v1[0] * c1[1] + v1[1] * c1[0]; v1[0] = a; v1[1] = b;
    a = v1[2] * c1[2] - v1[3] * c1[3]; b = v1[2] * c1[3] + v1[3] * c1[2]; v1[2] = a; v1[3] = b;
}

struct EpiPlain {
    static constexpr bool PERM = true, AFTER_DRAIN = false;
    bf16_t* O; int ldc;
    __device__ __forceinline__ void operator()(const f32x4 (&acc)[2][2][4][2], const Unit& u, int wr, int wc, int fr, int fq) const {
        const int row0 = u.pm * BM + wr * 64 + fr, col0 = u.pn * BM + wc * 32 + 8 * fq;
#pragma unroll
        for (int ai = 0; ai < 2; ++ai)
#pragma unroll
            for (int m = 0; m < 4; ++m) { bf16_t* rowp = O + (size_t)(row0 + ai * HALF + m * 16) * ldc + col0;
#pragma unroll
                for (int bj = 0; bj < 2; ++bj) *(u32x4*)(rowp + bj * HALF) = pack8(acc[ai][bj][m][0], acc[ai][bj][m][1]); }
    }
};

struct EpiProj {
    static constexpr bool PERM = true, AFTER_DRAIN = false;
    bf16_t *AQ, *AKV, *IQ, *IKX, *QL, *KVL; float *IW, *RSQQ, *RSQK; const float* ROPE;
    __device__ __forceinline__ void operator()(const f32x4 (&acc)[2][2][4][2], const Unit& u, int wr, int wc, int fr, int fq) const {
        const int pn = u.pn; bf16_t* dst; int pitch, coff, kind = 0; unsigned ropemask = 0u;
        if (pn < 8) { dst = AQ; pitch = 2048; coff = pn * 256; }
        else if (pn == 8) { dst = AKV; pitch = 256; coff = 0; }
        else if (pn < 25) { dst = IQ; pitch = 4096; coff = (pn - 9) * 256; ropemask = 0xAu; }
        else if (pn == 25) { dst = IKX; pitch = 256; coff = 0; ropemask = 0x6u; kind = 3; }
        else if (pn < 30) { dst = QL; pitch = 1024; coff = (pn - 26) * 256; kind = 1; }
        else { dst = KVL; pitch = 512; coff = (pn - 30) * 256; kind = 2; }
        const int row0 = u.pm * BM + wr * 64 + fr, lc0 = wc * 32 + 8 * fq, i0 = 16 * (wc & 1) + 4 * fq;
#pragma unroll
        for (int ai = 0; ai < 2; ++ai)
#pragma unroll
            for (int m = 0; m < 4; ++m) {
                const int row = row0 + ai * HALF + m * 16; float ss = 0.f;
#pragma unroll
                for (int bj = 0; bj < 2; ++bj) {
                    f32x4 v0 = acc[ai][bj][m][0], v1 = acc[ai][bj][m][1];
                    if (pn < 8) { v0 = v0 * (0.08838834764831845f * 1.4426950408889634f); v1 = v1 * (0.08838834764831845f * 1.4426950408889634f); }
                    if ((ropemask >> (2 * bj + (wc >> 1))) & 1u) rope8(v0, v1, ROPE + ((size_t)row * 32 + i0) * 2);
                    if (kind == 1 || kind == 2) ss += (v0[0] * v0[0] + v0[1] * v0[1]) + (v0[2] * v0[2] + v0[3] * v0[3]) + (v1[0] * v1[0] + v1[1] * v1[1]) + (v1[2] * v1[2] + v1[3] * v1[3]);
                    if (kind == 3 && bj == 1 && wc == 2) { float* iw = IW + (size_t)row * 32 + 8 * fq; *(f32x4*)iw = v0; *(f32x4*)(iw + 4) = v1; }
                    if (kind == 1 || kind == 2) {
                        int w0 = 0, w1 = 0; w0 = __builtin_amdgcn_cvt_pk_fp8_f32(v0[0], v0[1], w0, false); w0 = __builtin_amdgcn_cvt_pk_fp8_f32(v0[2], v0[3], w0, true);
                        w1 = __builtin_amdgcn_cvt_pk_fp8_f32(v1[0], v1[1], w1, false); w1 = __builtin_amdgcn_cvt_pk_fp8_f32(v1[2], v1[3], w1, true);
                        typedef unsigned u32x2 __attribute__((ext_vector_type(2)));
                        *(u32x2*)((unsigned char*)dst + (size_t)row * pitch + coff + lc0 + bj * HALF) = (u32x2){(unsigned)w0, (unsigned)w1}; }
                    else *(u32x4*)(dst + (size_t)row * pitch + coff + lc0 + bj * HALF) = pack8(v0, v1);
                }
                if (kind == 1 || kind == 2) {
                    ss += __shfl_xor(ss, 16); ss += __shfl_xor(ss, 32);
                    if (fq == 0) { if (kind == 1) RSQQ[(size_t)row * 16 + (pn - 26) * 4 + wc] = ss; else RSQK[(size_t)row * 8 + (pn - 30) * 4 + wc] = ss; }
                }
            }
    }
};

template <bool ISQ> struct EpiUp {
    static constexpr bool PERM = true, AFTER_DRAIN = false;
    bf16_t* O; int ldc; const float* RSQ; const float* ROPE;
    __device__ __forceinline__ void operator()(const f32x4 (&acc)[2][2][4][2], const Unit& u, int wr, int wc, int fr, int fq) const {
        const int row0 = u.pm * BM + wr * 64 + fr, col0 = u.pn * BM + wc * 32 + 8 * fq, i0 = 16 * (wc & 1) + 4 * fq;
#pragma unroll
        for (int ai = 0; ai < 2; ++ai)
#pragma unroll
            for (int m = 0; m < 4; ++m) {
                const int row = row0 + ai * HALF + m * 16; float rs;
                if (ISQ) { const f32x4* p = (const f32x4*)(RSQ + (size_t)row * 16); const f32x4 a = p[0], b = p[1], c = p[2], d = p[3];
                    const float s = ((a[0] + a[1]) + (a[2] + a[3])) + ((b[0] + b[1]) + (b[2] + b[3])) + ((c[0] + c[1]) + (c[2] + c[3])) + ((d[0] + d[1]) + (d[2] + d[3]));
                    rs = (0.07216878364870322f * 1.4426950408889634f / 32.0f) / sqrtf(s * (1.0f / 1024.0f) + 1e-6f); }
                else { const f32x4* p = (const f32x4*)(RSQ + (size_t)row * 8); const f32x4 a = p[0], b = p[1];
                    const float s = ((a[0] + a[1]) + (a[2] + a[3])) + ((b[0] + b[1]) + (b[2] + b[3]));
                    rs = (1.0f / 16.0f) / sqrtf(s * (1.0f / 512.0f) + 1e-6f); }
#pragma unroll
                for (int bj = 0; bj < 2; ++bj) {
                    f32x4 v0 = acc[ai][bj][m][0] * rs, v1 = acc[ai][bj][m][1] * rs;
                    if (ISQ) { if ((4 * u.pn + 2 * bj + (wc >> 1)) % 3 == 2) rope8(v0, v1, ROPE + ((size_t)row * 32 + i0) * 2); }
                    *(u32x4*)(O + (size_t)row * ldc + col0 + bj * HALF) = pack8(v0, v1);
                }
            }
    }
};

struct EpiVT {
    static constexpr bool PERM = true, AFTER_DRAIN = false;
    bf16_t* O; const float* RSQ;
    __device__ __forceinline__ void operator()(const f32x4 (&acc)[2][2][4][2], const Unit& u, int wr, int wc, int fr, int fq) const {
        const int row0 = u.pm * BM + wr * 64 + fr, col0 = u.pn * BM + wc * 32 + 8 * fq;
        f32x4 rs[2][2];
#pragma unroll
        for (int bj = 0; bj < 2; ++bj)
#pragma unroll
            for (int e = 0; e < 8; ++e) { const f32x4* p = (const f32x4*)(RSQ + (size_t)(col0 + bj * HALF + e) * 8); const f32x4 a = p[0], b = p[1];
                const float s = ((a[0] + a[1]) + (a[2] + a[3])) + ((b[0] + b[1]) + (b[2] + b[3]));
                rs[bj][e >> 2][e & 3] = (1.0f / 16.0f) / sqrtf(s * (1.0f / 512.0f) + 1e-6f); }
#pragma unroll
        for (int ai = 0; ai < 2; ++ai)
#pragma unroll
            for (int m = 0; m < 4; ++m) { bf16_t* rowp = O + (size_t)(row0 + ai * HALF + m * 16) * 8192 + col0;
#pragma unroll
                for (int bj = 0; bj < 2; ++bj) *(u32x4*)(rowp + bj * HALF) = pack8(acc[ai][bj][m][0] * rs[bj][0], acc[ai][bj][m][1] * rs[bj][1]); }
    }
};

template <bool LNR, int ASH> struct EpiZ {
    static constexpr bool PERM = false, AFTER_DRAIN = false;
    const float* R; float* Z; const float* gate;
    static constexpr float alpha = 1.189207115002721f, ascale = 1.0f / (float)(1 << ASH);
    const float* RS; const float* LG; const float* LB;
    __device__ __forceinline__ void operator()(const f32x4 (&acc)[2][2][4][2], const Unit& u, int wr, int wc, int fr, int fq) const {
        const int row0 = u.pm * BM + wr * 64 + fr, col0 = u.pn * BM + wc * 32 + 4 * fq;
        const float* gp = gate + (size_t)((u.pm * BM) >> 11) * 24576 + col0;
#pragma unroll
        for (int bj = 0; bj < 2; ++bj)
#pragma unroll
            for (int n = 0; n < 2; ++n) {
                const f32x4 gv = (*(const f32x4*)(gp + bj * HALF + 16 * n) + 1.0f) * ascale; f32x4 lg = gv, lb = gv;
                if (LNR) { lg = *(const f32x4*)(LG + col0 + bj * HALF + 16 * n) * alpha; lb = *(const f32x4*)(LB + col0 + bj * HALF + 16 * n) * alpha; }
#pragma unroll
                for (int ai = 0; ai < 2; ++ai)
#pragma unroll
                    for (int m = 0; m < 4; ++m) { const int row = row0 + ai * HALF + m * 16; const size_t ro = (size_t)row * 4096 + col0 + bj * HALF + 16 * n;
                        const f32x4 r = *(const f32x4*)(R + ro); f32x4 res;
                        if (LNR) { typedef float f32x2 __attribute__((ext_vector_type(2))); const f32x2 ms = *(const f32x2*)(RS + 2 * (size_t)row); res = (r - ms.x) * ms.y * lg + lb; } else res = r * alpha;
                        *(f32x4*)(Z + ro) = res + gv * acc[ai][bj][m][n]; } }
    }
};

template <class Epi, class Sched, bool ALIGN_EPI = false, bool SP2 = false, bool FP8 = false>
__device__ __forceinline__ void gemm_phase(PG8_LAS unsigned char* lds, const Gemm g, const Sched& S, const Epi& E) {
    const int tid = threadIdx.x, wid = __builtin_amdgcn_readfirstlane(tid >> 6), lane = tid & 63, wr = wid >> 2, wc = wid & 3, fr = lane & 15, fq = lane >> 4;
    const int K = g.K, nt = K / BK, lda = g.lda;
    unsigned voffA[2], voffB[2];
#pragma unroll
    for (int i = 0; i < 2; ++i) { int R, C; stage_rc(tid * 16 + i * 8192, R, C); const int Rb = Epi::PERM ? ((R & ~31) + perm32(R & 31)) : R;
        voffA[i] = (unsigned)(R * lda + C) * 2u; voffB[i] = (unsigned)(Rb * K + C) * 2u; }
    const size_t kstep = (size_t)(BK * 2);
    const size_t hstep = (size_t)HALF * K * 2, hstepA = (size_t)HALF * lda * 2;
    const size_t tstep = 2 * hstep, tstepA = 2 * hstepA;
    const unsigned ldsw = (unsigned)wid * 1024u;
    const int aoff = lds_byte(wr * 64 + fr, fq * 8), boff = lds_byte(wc * 32 + fr, fq * 8);
#define PG8_SA(b, h) (((b) * 2 + (h)) * HTB)
#define PG8_SB(b, h) ((4 + (b) * 2 + (h)) * HTB)
#define PG8_STAGE(bufoff, gbase, voff) do { _Pragma("unroll") for (int _i = 0; _i < 2; ++_i) \
        __builtin_amdgcn_global_load_lds((const unsigned*)((const char*)(gbase) + (voff)[_i]), (PG8_LAS unsigned*)(lds + (bufoff) + ldsw + _i * 8192), 16, 0, 0); } while (0)
#define PG8_LDA(dst, b, h) do { if constexpr (FP8) { _Pragma("unroll") for (int m = 0; m < 4; ++m) dst##8[m] = __builtin_shufflevector(*(const PG8_LAS i32x4*)(lds + PG8_SA(b, h) + aoff + m * 2048), *(const PG8_LAS i32x4*)(lds + PG8_SA(b, h) + aoff + m * 2048 + 1024), 0, 1, 2, 3, 4, 5, 6, 7); } \
        else { _Pragma("unroll") for (int m = 0; m < 4; ++m) _Pragma("unroll") for (int k = 0; k < 2; ++k) dst[m][k] = *(const PG8_LAS bf16x8*)(lds + PG8_SA(b, h) + aoff + m * 2048 + k * 1024); } } while (0)
#define PG8_LDB(dst, b, h) do { if constexpr (FP8) { _Pragma("unroll") for (int n = 0; n < 2; ++n) dst##8[n] = __builtin_shufflevector(*(const PG8_LAS i32x4*)(lds + PG8_SB(b, h) + boff + n * 2048), *(const PG8_LAS i32x4*)(lds + PG8_SB(b, h) + boff + n * 2048 + 1024), 0, 1, 2, 3, 4, 5, 6, 7); } \
        else { _Pragma("unroll") for (int n = 0; n < 2; ++n) _Pragma("unroll") for (int k = 0; k < 2; ++k) dst[n][k] = *(const PG8_LAS bf16x8*)(lds + PG8_SB(b, h) + boff + n * 2048 + k * 1024); } } while (0)
#define PG8_MMA(ai, bj, At, Bt) do { __builtin_amdgcn_s_setprio(1); \
        if constexpr (FP8) { _Pragma("unroll") for (int m = 0; m < 4; ++m) _Pragma("unroll") for (int n = 0; n < 2; ++n) \
            asm volatile("v_mfma_f32_16x16x128_f8f6f4 %0, %1, %2, %0" : "+v"(acc[ai][bj][m][n]) : "v"(Bt##8[n]), "v"(At##8[m])); } \
        else { _Pragma("unroll") for (int m = 0; m < 4; ++m) _Pragma("unroll") for (int n = 0; n < 2; ++n) _Pragma("unroll") for (int k = 0; k < 2; ++k) \
            acc[ai][bj][m][n] = __builtin_amdgcn_mfma_f32_16x16x32_bf16(Bt[n][k], At[m][k], acc[ai][bj][m][n], 0, 0, 0); } \
        __builtin_amdgcn_s_setprio(0); } while (0)
#define PG8_WAIT_V(n) asm volatile("s_waitcnt vmcnt(" #n ")" ::: "memory")
#define PG8_WAIT_L(n) asm volatile("s_waitcnt lgkmcnt(" #n ")" ::: "memory")
#define PG8_BAR __builtin_amdgcn_s_barrier()
#define PG8_SCHED __builtin_amdgcn_sched_barrier(0)
    Unit cur, nxt; int ui = 0;
    if (!S.next(0, cur)) return;
    f32x4 acc[2][2][4][2];
#pragma unroll
    for (int a = 0; a < 2; ++a)
#pragma unroll
        for (int b = 0; b < 2; ++b)
#pragma unroll
            for (int m = 0; m < 4; ++m)
#pragma unroll
                for (int n = 0; n < 2; ++n) acc[a][b][m][n] = (f32x4){0.f, 0.f, 0.f, 0.f};
    bf16x8 At[4][2], B0[2][2], B1[2][2]; i32x8 At8[4], B08[2], B18[2];
    const char* cA = (const char*)g.A + (size_t)cur.pm * tstepA; const char* cB = (const char*)g.Bt + (size_t)cur.pn * tstep;
    S.a_ready(cur);
    if constexpr (SP2) {
        PG8_STAGE(PG8_SB(0, 0), cB, voffB); PG8_STAGE(PG8_SB(0, 1), cB + hstep, voffB); PG8_STAGE(PG8_SA(0, 0), cA, voffA); PG8_STAGE(PG8_SA(0, 1), cA + hstepA, voffA);
        if (wr == 1) PG8_BAR;
        PG8_WAIT_V(2); PG8_BAR;
        PG8_STAGE(PG8_SB(1, 0), cB + kstep, voffB); PG8_STAGE(PG8_SA(1, 0), cA + kstep, voffA); PG8_STAGE(PG8_SB(1, 1), cB + hstep + kstep, voffB);
        PG8_WAIT_V(6); PG8_BAR;
    } else {
        PG8_STAGE(PG8_SB(0, 0), cB, voffB); PG8_STAGE(PG8_SA(0, 0), cA, voffA); PG8_STAGE(PG8_SB(0, 1), cB + hstep, voffB); PG8_STAGE(PG8_SA(0, 1), cA + hstepA, voffA);
        if (wr == 1) PG8_BAR;
        PG8_WAIT_V(4); PG8_BAR;
        PG8_STAGE(PG8_SB(1, 0), cB + kstep, voffB); PG8_STAGE(PG8_SA(1, 0), cA + kstep, voffA); PG8_STAGE(PG8_SB(1, 1), cB + hstep + kstep, voffB);
        PG8_WAIT_V(6); PG8_BAR;
    }
    for (;;) {
        const bool has_next = S.next(ui + 1, nxt);
        const char* nA = has_next ? (const char*)g.A + (size_t)nxt.pm * tstepA : cA; const char* nB = has_next ? (const char*)g.Bt + (size_t)nxt.pn * tstep : cB;
        for (int t = 0; t < nt; t += 2) {
            const bool last = (t == nt - 2);
            const char* a1 = cA + (size_t)(t + 1) * kstep;
            const char* a2 = last ? nA : cA + (size_t)(t + 2) * kstep; const char* b2 = last ? nB : cB + (size_t)(t + 2) * kstep;
            const char* a3 = a2 + kstep; const char* b3 = b2 + kstep;
            if (last && has_next) S.a_ready(nxt);
            if constexpr (SP2) {
            PG8_LDB(B0, 0, 0); PG8_LDB(B1, 0, 1); PG8_SCHED; PG8_LDA(At, 0, 0); PG8_STAGE(PG8_SA(1, 1), a1 + hstepA, voffA);
            PG8_WAIT_V(8); PG8_WAIT_L(0); PG8_BAR; PG8_MMA(0, 0, At, B0); PG8_MMA(0, 1, At, B1); PG8_BAR; PG8_SCHED;
            PG8_LDA(At, 0, 1); PG8_STAGE(PG8_SB(0, 0), b2, voffB); PG8_STAGE(PG8_SB(0, 1), b2 + hstep, voffB); PG8_STAGE(PG8_SA(0, 0), a2, voffA);
            PG8_WAIT_V(8); PG8_WAIT_L(0); PG8_BAR; PG8_MMA(1, 0, At, B0); PG8_MMA(1, 1, At, B1); PG8_BAR; PG8_SCHED;
            PG8_LDB(B0, 1, 0); PG8_LDB(B1, 1, 1); PG8_SCHED; PG8_LDA(At, 1, 0); PG8_STAGE(PG8_SA(0, 1), a2 + hstepA, voffA);
            PG8_WAIT_V(8); PG8_WAIT_L(0); PG8_BAR; PG8_MMA(0, 0, At, B0); PG8_MMA(0, 1, At, B1); PG8_BAR; PG8_SCHED;
            PG8_LDA(At, 1, 1); PG8_STAGE(PG8_SB(1, 0), b3, voffB); PG8_STAGE(PG8_SB(1, 1), b3 + hstep, voffB); PG8_STAGE(PG8_SA(1, 0), a3, voffA);
            PG8_WAIT_V(8); PG8_WAIT_L(0); PG8_BAR; PG8_MMA(1, 0, At, B0); PG8_MMA(1, 1, At, B1); PG8_BAR; PG8_SCHED;
            } else {
            PG8_LDB(B0, 0, 0); PG8_SCHED; PG8_LDA(At, 0, 0); PG8_STAGE(PG8_SA(1, 1), a1 + hstepA, voffA);
            PG8_WAIT_L(8); PG8_BAR; PG8_WAIT_L(0); PG8_MMA(0, 0, At, B0); PG8_BAR; PG8_SCHED;
            PG8_LDB(B1, 0, 1); PG8_STAGE(PG8_SB(0, 0), b2, voffB);
            PG8_BAR; PG8_WAIT_L(0); PG8_MMA(0, 1, At, B1); PG8_BAR;
            PG8_LDA(At, 0, 1); PG8_STAGE(PG8_SA(0, 0), a2, voffA);
            PG8_BAR; PG8_WAIT_L(0); PG8_MMA(1, 0, At, B0); PG8_BAR; PG8_SCHED;
            PG8_STAGE(PG8_SB(0, 1), b2 + hstep, voffB);
            PG8_WAIT_V(6); PG8_BAR; PG8_MMA(1, 1, At, B1); PG8_BAR;
            PG8_LDB(B0, 1, 0); PG8_SCHED; PG8_LDA(At, 1, 0); PG8_STAGE(PG8_SA(0, 1), a2 + hstepA, voffA);
            PG8_WAIT_L(8); PG8_BAR; PG8_WAIT_L(0); PG8_MMA(0, 0, At, B0); PG8_BAR; PG8_SCHED;
            PG8_LDB(B1, 1, 1); PG8_STAGE(PG8_SB(1, 0), b3, voffB);
            PG8_BAR; PG8_WAIT_L(0); PG8_MMA(0, 1, At, B1); PG8_BAR;
            PG8_LDA(At, 1, 1); PG8_STAGE(PG8_SA(1, 0), a3, voffA);
            PG8_BAR; PG8_WAIT_L(0); PG8_MMA(1, 0, At, B0); PG8_BAR; PG8_SCHED;
            PG8_STAGE(PG8_SB(1, 1), b3 + hstep, voffB);
            PG8_WAIT_V(6); PG8_BAR; PG8_MMA(1, 1, At, B1); PG8_BAR;
            }
        }
        if constexpr (ALIGN_EPI) { if (wr == 0) PG8_BAR; }
        if constexpr (!Epi::AFTER_DRAIN) { E(acc, cur, wr, wc, fr, fq); S.done(cur); }
        if (!has_next) break;
#pragma unroll
        for (int a = 0; a < 2; ++a)
#pragma unroll
            for (int b = 0; b < 2; ++b)
#pragma unroll
                for (int m = 0; m < 4; ++m)
#pragma unroll
                    for (int n = 0; n < 2; ++n) acc[a][b][m][n] = (f32x4){0.f, 0.f, 0.f, 0.f};
        cur = nxt; cA = nA; cB = nB; ++ui;
        if constexpr (ALIGN_EPI) { if (wr == 1) PG8_BAR; }
    }
    PG8_WAIT_V(0);
    if constexpr (!ALIGN_EPI) { if (wr == 0) PG8_BAR; }
    PG8_BAR;
    if constexpr (Epi::AFTER_DRAIN) { E.fused(acc, cur, wr, wc, fr, fq, lds, wid, lane); S.done(cur); }
#undef PG8_SA
#undef PG8_SB
#undef PG8_STAGE
#undef PG8_LDA
#undef PG8_LDB
#undef PG8_MMA
#undef PG8_WAIT_V
#undef PG8_WAIT_L
#undef PG8_BAR
#undef PG8_SCHED
}
}
constexpr int NWAVES = 8;
constexpr int BATCH = 4, SEQ = 2048, D = 4096, M = BATCH * SEQ, FF = 11008, NIN = 8192  , NGU = 2 * FF;
constexpr int N_PHASES = 11;
#ifndef DSA_NAIVE
#define DSA_NAIVE 0
#endif
#ifndef MK_ONE_LAUNCH
#define MK_ONE_LAUNCH 1
#endif
constexpr float LN_EPS = 1e-5f, ALPHA = 1.189207115002721f;

constexpr size_t MiB = 1u << 20;
constexpr size_t WS_CTL = 0, CTL_ZERO_BYTES = 1 * MiB;
constexpr size_t WS_MOD = 1 * MiB, WS_ROPE = 2 * MiB, WS_RSQQ = 4 * MiB, WS_RSQK = 4 * MiB + 512 * 1024, WS_IW = 5 * MiB, WS_VTA = 6 * MiB, WS_RS1 = 4 * MiB + 768 * 1024  ;
constexpr size_t WS_WIN = 8 * MiB, WS_WUQ = 72 * MiB, WS_WUKV = 78 * MiB, WS_WO = 82 * MiB, WS_WGU = 114 * MiB, WS_WD = 286 * MiB;
constexpr size_t WS_U = 372 * MiB, WS_AQ = 436 * MiB, WS_AKV = 468 * MiB, WS_IQ = 472 * MiB, WS_IKX = 536 * MiB, WS_QL = 540 * MiB, WS_KVL = 556 * MiB;
constexpr size_t WS_QB = 564 * MiB, WS_KV = 612 * MiB, WS_KN = 612 * MiB, WS_VT = 644 * MiB, WS_SC = 676 * MiB, WS_MIX = 740 * MiB, WS_Z1 = 804 * MiB, WS_X1 = 932 * MiB;
constexpr size_t WS_GU = 436 * MiB  , WS_H = 1060 * MiB, WS_END = 1232 * MiB;
static_assert(WS_GU + (size_t)M * NGU * 2 <= WS_X1, "GU overlay");
constexpr int CW_TMO = 0, CW_CODE = 1, CW_BAR = 4096;

constexpr int RING_OFF = 0, RING_BYTES = 131072;
constexpr int LDSCTL_OFF = 135168, MISC_OFF = LDSCTL_OFF + 320;
constexpr int LDS_BYTES = 147456;

#define GAS __attribute__((address_space(1)))
#define LAS __attribute__((address_space(3)))
typedef unsigned short bf16;
typedef unsigned v4u __attribute__((ext_vector_type(4)));
typedef unsigned v2u __attribute__((ext_vector_type(2)));
typedef float f32x4 __attribute__((ext_vector_type(4)));
typedef float f32x2 __attribute__((ext_vector_type(2)));
typedef GAS unsigned gu32;
#define RLX_AGENT __ATOMIC_RELAXED, __HIP_MEMORY_SCOPE_AGENT
#define LDS_WAIT() asm volatile("s_waitcnt lgkmcnt(0)" ::: "memory")
#define VM_WAIT() asm volatile("s_waitcnt vmcnt(0)" ::: "memory")
__device__ __forceinline__ unsigned f2bf(float f) { unsigned u = __builtin_bit_cast(unsigned, f); return (u + 0x7fffu + ((u >> 16) & 1u)) >> 16; }
__device__ __forceinline__ unsigned pk2(float lo, float hi) { return f2bf(lo) | (f2bf(hi) << 16); }
__device__ __forceinline__ float bflo(unsigned w) { return __builtin_bit_cast(float, w << 16); }
__device__ __forceinline__ float bfhi(unsigned w) { return __builtin_bit_cast(float, w & 0xffff0000u); }

#define XB_TMO      128
#define XB_XCNT(j)  (256  + 64 * (j))
#define XB_XSUB(j)  (1280 + 64 * (j))
#define XB_XGEN(j)  (2304 + 64 * (j))
#define XB_TOP      3328
#define XB_TOPGEN   3392
#define XCD_BAR_WORDS 3456
#define XB_SPIN_CAP (1u << 18)
__device__ __forceinline__ unsigned xb_ld(unsigned* p)              { return __hip_atomic_load(p, __ATOMIC_RELAXED, __HIP_MEMORY_SCOPE_AGENT); }
__device__ __forceinline__ unsigned xb_add(unsigned* p, unsigned v) { return __hip_atomic_fetch_add(p, v, __ATOMIC_RELAXED, __HIP_MEMORY_SCOPE_AGENT); }
__device__ __forceinline__ unsigned xb_xcc_id() { return (unsigned)__builtin_amdgcn_s_getreg((3 << 11) | 20) & 0xFu; }
#define XB_SPIN(cond, bar) do { unsigned _sp = 0; while (cond) { __builtin_amdgcn_s_sleep(1); \
    if ((++_sp & 255u) == 0u) { if (xb_ld(&(bar)[XB_TMO])) break; if (_sp > XB_SPIN_CAP) { atomicAdd(&(bar)[XB_TMO], 1u); break; } } } } while (0)
struct XcdBarrier { unsigned* bar; unsigned x; volatile LAS unsigned* st; };
__device__ __forceinline__ XcdBarrier xcd_barrier_post(unsigned* bar, volatile LAS unsigned* st) {
    XcdBarrier b; b.bar = bar; b.x = xb_xcc_id(); b.st = st;
    if (threadIdx.x == 0) (void)xb_add(&bar[XB_XCNT(b.x)], 1u);
    return b;
}
__device__ __forceinline__ void xcd_barrier_complete(unsigned* bar, unsigned x, unsigned& nloc, unsigned& nx) {
    const unsigned G = gridDim.x * gridDim.y * gridDim.z;
    unsigned sum, cnt, mine, sp = 0u;
    for (;;) {
        sum = 0u; cnt = 0u; mine = 0u;
#pragma unroll
        for (unsigned j = 0; j < 16; ++j) { const unsigned c = xb_ld(&bar[XB_XCNT(j)]); sum += c; cnt += (c > 0u) ? 1u : 0u; mine = (j == x) ? c : mine; }
        if (sum == G) break;
        __builtin_amdgcn_s_sleep(1);
        if ((++sp & 255u) == 0u) { if (xb_ld(&bar[XB_TMO])) break; if (sp > XB_SPIN_CAP) { atomicAdd(&bar[XB_TMO], 1u); break; } }
    }
    nloc = mine > 0u ? mine : 1u; nx = cnt > 0u ? cnt : 1u;
}
__device__ __forceinline__ void xcd_barrier(const XcdBarrier& b) {
    asm volatile("s_waitcnt vmcnt(0)" ::: "memory");
    __syncthreads();
    if (threadIdx.x == 0) {
        unsigned* bar = b.bar;
        __builtin_amdgcn_s_waitcnt(0);
        unsigned nloc = b.st[0], nx = b.st[1];
        if (nloc == 0u) { xcd_barrier_complete(bar, b.x, nloc, nx); b.st[0] = nloc; b.st[1] = nx; }
        const unsigned old = xb_add(&bar[XB_XSUB(b.x)], 1u);
        const unsigned gen = old / nloc;
        if (old + 1u == (gen + 1u) * nloc) {
            __builtin_amdgcn_fence(__ATOMIC_RELEASE, "agent");
            asm volatile("s_waitcnt vmcnt(0)" ::: "memory");
            const unsigned og = xb_add(&bar[XB_TOP], 1u);
            const unsigned tg = og / nx;
            if (og + 1u == (tg + 1u) * nx) xb_add(&bar[XB_TOPGEN], 1u);
            else XB_SPIN(xb_ld(&bar[XB_TOPGEN]) == tg, bar);
            __builtin_amdgcn_fence(__ATOMIC_ACQUIRE, "agent");
            xb_add(&bar[XB_XGEN(b.x)], 1u);
            asm volatile("s_waitcnt vmcnt(0)" ::: "memory");
        } else {
            XB_SPIN(xb_ld(&bar[XB_XGEN(b.x)]) == gen, bar);
            __builtin_amdgcn_fence(__ATOMIC_ACQUIRE, "agent");
            asm volatile("s_waitcnt vmcnt(0)" ::: "memory");
        }
    }
    __syncthreads();
}

struct Frame {
    LAS unsigned char* lds;
    volatile LAS unsigned* MISC;
    gu32* ctl;
    int tid, lane, wave;
    int vcu, G;
    unsigned char* ws;
    const float* in[21];
    float* out;
};
__device__ __forceinline__ float wave_sum(float v) {
#pragma unroll
    for (int o = 1; o < 64; o <<= 1) v += __shfl_xor(v, o);
    return v;
}
__device__ __forceinline__ float wave_max(float v) {
#pragma unroll
    for (int o = 1; o < 64; o <<= 1) v = fmaxf(v, __shfl_xor(v, o));
    return v;
}
__device__ __forceinline__ int wave_isum(int v) {
#pragma unroll
    for (int o = 1; o < 64; o <<= 1) v += __shfl_xor(v, o);
    return v;
}
enum { I_X = 0, I_C, I_POS, I_WADA, I_BADA, I_WIN, I_RELB, I_QG, I_WUQ, I_KVG, I_WUKV, I_WO, I_LN1G, I_LN1B, I_WG, I_WU, I_CW, I_CB, I_WD, I_LN2G, I_LN2B };

__device__ const unsigned char BUCKET_TAB[128] = {0, 1, 2, 3, 4, 5, 6, 7, 8, 9, 10, 11, 12, 13, 14, 15, 16, 16, 16, 17, 17, 18, 18, 18, 19, 19, 19, 20, 20, 20, 20, 21, 21, 21, 21, 22, 22, 22, 22, 22, 23, 23, 23, 23, 23, 23, 24, 24, 24, 24, 24, 24, 25, 25, 25, 25, 25, 25, 25, 26, 26, 26, 26, 26, 26, 26, 26, 27, 27, 27, 27, 27, 27, 27, 27, 27, 27, 28, 28, 28, 28, 28, 28, 28, 28, 28, 28, 29, 29, 29, 29, 29, 29, 29, 29, 29, 29, 29, 29, 30, 30, 30, 30, 30, 30, 30, 30, 30, 30, 30, 30, 30, 30, 31, 31, 31, 31, 31, 31, 31, 31, 31, 31, 31, 31, 31, 31, 31};
__device__ const double ROPE_FREV[32] = {
    0.15915494309189535, 0.11934937021124886, 0.08949940160889101, 0.06711508300522726,
    0.050329212104487035, 0.03774158471741977, 0.0283021958306234, 0.02122365276477766,
    0.015915494309189534, 0.011934937021124886, 0.008949940160889102, 0.006711508300522725,
    0.005032921210448704, 0.003774158471741977, 0.00283021958306234, 0.0021223652764777662,
    0.0015915494309189536, 0.0011934937021124885, 0.0008949940160889102, 0.0006711508300522726,
    0.0005032921210448703, 0.00037741584717419774, 0.00028302195830623395, 0.0002122365276477766,
    0.00015915494309189535, 0.00011934937021124886, 8.949940160889102e-05, 6.711508300522725e-05,
    5.0329212104487035e-05, 3.774158471741978e-05, 2.8302195830623396e-05, 2.122365276477766e-05
};

__device__ __forceinline__ int colmap(int kind, int c) {
    if (kind == 0) return c;
    if (kind == 1) {
        if (c < 2304) return c;
        if (c < 6528) { const int base = (c < 6400) ? 2304 : 6400; const int r = c - base, h = r >> 7, d = r & 127;
            if (d < 64) return c; const int j = d - 64; return base + h * 128 + 64 + 2 * (j & 31) + (j >> 5); }
        if (c < 6560) return 6592 + (c - 6528);
        if (c < 7584) return 6656 + (c - 6560);
        if (c < 8096) return 7680 + (c - 7584);
        const int j = c - 8096; return 6528 + 2 * (j & 31) + (j >> 5);
    }
    if (kind == 2) { const int h = c / 192, d = c - h * 192; if (d < 128) return c; const int j = d - 128; return h * 192 + 128 + 2 * (j & 31) + (j >> 5); }
    if (kind == 3) return (c >> 7) * 256 + (c & 127);
    if (kind == 5) return (c >> 8) * 128 + (c & 127) + ((c & 128) ? 2048 : 0);
    return (c >> 7) * 256 + 128 + (c & 127);
}
constexpr int TT_IN = 32 * 64, TT_UQ = 8 * 24, TT_UKV = 4 * 32, TT_O = 32 * 32, TT_G = 32 * 86, TT_D = 86 * 32;
constexpr int TT_TOTAL = TT_IN + TT_UQ + TT_UKV + TT_O + 2 * TT_G + TT_D;
struct TJob { const float* W; const float* scale; bf16* WT; int K, N, kind, k0, n0; float f8s; };
__device__ __forceinline__ TJob tjob(const Frame& F, int t) {
    TJob j; j.scale = nullptr; j.f8s = 0.f; int nnt;
    if (t < TT_IN) { j.W = F.in[I_WIN]; j.WT = (bf16*)(F.ws + WS_WIN); j.K = 4096; j.N = 8160; j.kind = 1; nnt = 64; }
    else if ((t -= TT_IN) < TT_UQ) { j.W = F.in[I_WUQ]; j.scale = F.in[I_QG]; j.WT = (bf16*)(F.ws + WS_WUQ); j.K = 1024; j.N = 3072; j.kind = 2; j.f8s = 32.0f; nnt = 24; }
    else if ((t -= TT_UQ) < TT_UKV) { j.W = F.in[I_WUKV]; j.scale = F.in[I_KVG]; j.WT = (bf16*)(F.ws + WS_WUKV); j.K = 512; j.N = 4096; j.kind = 5; j.f8s = 16.0f; nnt = 32; }
    else if ((t -= TT_UKV) < TT_O) { j.W = F.in[I_WO]; j.WT = (bf16*)(F.ws + WS_WO); j.K = 4096; j.N = 4096; j.kind = 0; j.f8s = 128.0f; nnt = 32; }
    else if ((t -= TT_O) < TT_G) { j.W = F.in[I_WG]; j.WT = (bf16*)(F.ws + WS_WGU); j.K = 4096; j.N = FF; j.kind = 3; nnt = 86; }
    else if ((t -= TT_G) < TT_G) { j.W = F.in[I_WU]; j.WT = (bf16*)(F.ws + WS_WGU); j.K = 4096; j.N = FF; j.kind = 4; nnt = 86; }
    else { t -= TT_G; j.W = F.in[I_WD]; j.WT = (bf16*)(F.ws + WS_WD); j.K = FF; j.N = 4096; j.kind = 0; nnt = 32; }
    j.k0 = (t / nnt) * 128; j.n0 = (t % nnt) * 128; return j;
}
__device__ __forceinline__ void tr_load(const Frame& F, int t, f32x4 (&ld)[8]) {
    const TJob j = tjob(F, t); const int rsub = F.lane >> 5, c4 = F.lane & 31, n = j.n0 + 4 * c4;
#pragma unroll
    for (int i = 0; i < 8; ++i) { const int k = j.k0 + 16 * F.wave + 2 * i + rsub;
        f32x4 v = (f32x4){0.f, 0.f, 0.f, 0.f};
        if (n < j.N) v = __builtin_nontemporal_load((const f32x4*)(j.W + (size_t)k * j.N + n));
        if (j.scale) v = v * j.scale[k];
        ld[i] = v; }
}
__device__ __forceinline__ void p0_prologue(Frame& F) {
    const int g = blockIdx.x, G = F.G;
    { float* ROPE = (float*)(F.ws + WS_ROPE); const int* pos = (const int*)F.in[I_POS];
      for (int idx = g * 512 + F.tid; idx < M * 32; idx += G * 512) { const int m = idx >> 5, i = idx & 31;
          const double r = (double)pos[m] * ROPE_FREV[i]; const float fr = (float)(r - __builtin_floor(r)) * 2.0f;
          ROPE[2 * idx] = cospif(fr); ROPE[2 * idx + 1] = sinpif(fr); } }
    { v4u* z = (v4u*)((bf16*)(F.ws + WS_WIN) + (size_t)6624 * 4096);
      for (int idx = g * 512 + F.tid; idx < 32 * 4096 / 8; idx += G * 512) z[idx] = (v4u){0u, 0u, 0u, 0u}; }
    {
        LAS float* CACT = (LAS float*)F.lds; LAS float* RED = (LAS float*)(F.lds + 65536);
        for (int idx = F.tid; idx < 4 * 4096; idx += 512) { const float c = F.in[I_C][idx]; CACT[idx] = c / (1.0f + __expf(-c)); }
        __syncthreads();
        for (int it = g; it < 256; it += G) {
            const int ln = F.lane < 48 ? F.lane : 47; const float* wp = F.in[I_WADA] + (size_t)(512 * F.wave) * 24576 + it * 96 + 2 * ln;
            f32x2 acc[4];
#pragma unroll
            for (int b = 0; b < 4; ++b) acc[b] = (f32x2){0.f, 0.f};
            for (int k = 0; k < 512; k += 16) {
                f32x2 wv[16];
#pragma unroll
                for (int i = 0; i < 16; ++i) wv[i] = __builtin_nontemporal_load((const f32x2*)(wp + (size_t)(k + i) * 24576));
#pragma unroll
                for (int i = 0; i < 16; ++i)
#pragma unroll
                    for (int b = 0; b < 4; ++b) acc[b] += wv[i] * CACT[b * 4096 + 512 * F.wave + k + i];
            }
            if (F.lane < 48) {
#pragma unroll
                for (int b = 0; b < 4; ++b) *(LAS f32x2*)(RED + (F.wave * 4 + b) * 96 + 2 * F.lane) = acc[b]; }
            __syncthreads();
            if (F.tid < 384) { const int b = F.tid / 96, c = F.tid % 96; float s = F.in[I_BADA][it * 96 + c];
#pragma unroll
              for (int w = 0; w < 8; ++w) s += RED[(w * 4 + b) * 96 + c];
              ((float*)(F.ws + WS_MOD))[b * 24576 + it * 96 + c] = s; }
            __syncthreads();
        }
    }
    {
        const int tb = (int)((long)TT_TOTAL * g / G), te = (int)((long)TT_TOTAL * (g + 1) / G);
        LAS float* T = (LAS float*)F.lds;
        f32x4 ldA[8], ldB[8];
        if (tb < te) tr_load(F, tb, ldA);
        if (tb + 1 < te) tr_load(F, tb + 1, ldB);
#define TR_STEP(LD, t_) do { \
            { const int rsub = F.lane >> 5, c4 = F.lane & 31; \
              _Pragma("unroll") for (int i = 0; i < 8; ++i) { const int k = 16 * F.wave + 2 * i + rsub; *(LAS f32x4*)(T + 132 * k + ((4 * c4) ^ (4 * ((k >> 3) & 15)))) = LD[i]; } } \
            __syncthreads(); \
            const TJob j = tjob(F, (t_)); \
            if ((t_) + 2 < te) tr_load(F, (t_) + 2, LD); \
            { const int c = F.lane & 15; \
              _Pragma("unroll") for (int q = 0; q < 4; ++q) { const int n = (F.lane >> 4) + 4 * F.wave + 32 * q; const LAS float* s = T + 132 * (8 * c) + (n ^ (4 * c)); \
                  if (j.f8s != 0.f) { const float fs = j.f8s; int w0 = 0, w1 = 0; \
                      w0 = __builtin_amdgcn_cvt_pk_fp8_f32(s[0] * fs, s[132] * fs, w0, false); w0 = __builtin_amdgcn_cvt_pk_fp8_f32(s[2 * 132] * fs, s[3 * 132] * fs, w0, true); \
                      w1 = __builtin_amdgcn_cvt_pk_fp8_f32(s[4 * 132] * fs, s[5 * 132] * fs, w1, false); w1 = __builtin_amdgcn_cvt_pk_fp8_f32(s[6 * 132] * fs, s[7 * 132] * fs, w1, true); \
                      if (j.n0 + n < j.N) *(v2u*)((unsigned char*)j.WT + (size_t)colmap(j.kind, j.n0 + n) * j.K + j.k0 + 8 * c) = (v2u){(unsigned)w0, (unsigned)w1}; } \
                  else { v4u o; o.x = pk2(s[0], s[132]); o.y = pk2(s[2 * 132], s[3 * 132]); o.z = pk2(s[4 * 132], s[5 * 132]); o.w = pk2(s[6 * 132], s[7 * 132]); \
                  if (j.n0 + n < j.N) *(v4u*)(j.WT + (size_t)colmap(j.kind, j.n0 + n) * j.K + j.k0 + 8 * c) = o; } } } \
            __syncthreads(); } while (0)
        for (int t = tb; t < te; t += 2) { TR_STEP(ldA, t); if (t + 1 < te) TR_STEP(ldB, t + 1); }
#undef TR_STEP
    }
}

__device__ __forceinline__ void ln_stats(const f32x4 (&v)[16], float& mean, float& rstd) {
    float s = 0.f;
#pragma unroll
    for (int j = 0; j < 16; ++j) s += (v[j][0] + v[j][1]) + (v[j][2] + v[j][3]);
    mean = wave_sum(s) * (1.0f / D); float q = 0.f;
#pragma unroll
    for (int j = 0; j < 16; ++j) { const f32x4 d = v[j] - mean; q += (d[0] * d[0] + d[1] * d[1]) + (d[2] * d[2] + d[3] * d[3]); }
    rstd = 1.0f / sqrtf(wave_sum(q) * (1.0f / D) + LN_EPS);
}
template <int KIND> __device__ __forceinline__ void row_pass(Frame& F) {
    const float* mod = (const float*)(F.ws + WS_MOD); bf16* U = (bf16*)(F.ws + WS_U);
    LAS float* VA = (LAS float*)F.lds; LAS float* VB = VA + 4096;
    const float* src = KIND == 1 ? F.in[I_X] : (KIND == 6 ? (const float*)(F.ws + WS_Z1) : F.out);
    int cur = -1;
    for (int blk = F.vcu; blk < M / 32; blk += F.G) {
        const int bt = blk >> 6;
        if (KIND == 10 ? cur < 0 : bt != cur) {
            __syncthreads();
            const float* mb = mod + (size_t)bt * 24576; const int c = 8 * F.tid;
#pragma unroll
            for (int e = 0; e < 8; e += 4) { f32x4 va, vb;
                if (KIND == 1) { va = *(const f32x4*)(mb + 4096 + c + e) + 1.0f; vb = *(const f32x4*)(mb + c + e); }
                else if (KIND == 6) { const f32x4 s1 = *(const f32x4*)(mb + 4 * 4096 + c + e) + 1.0f; va = *(const f32x4*)(F.in[I_LN1G] + c + e) * s1; vb = *(const f32x4*)(F.in[I_LN1B] + c + e) * s1 + *(const f32x4*)(mb + 3 * 4096 + c + e); }
                else { va = *(const f32x4*)(F.in[I_LN2G] + c + e); vb = *(const f32x4*)(F.in[I_LN2B] + c + e); }
                *(LAS f32x4*)(VA + c + e) = va; *(LAS f32x4*)(VB + c + e) = vb; }
            __syncthreads(); cur = bt;
        }
#pragma unroll 1
        for (int r = 0; r < 4; ++r) { const int m = blk * 32 + 4 * F.wave + r; const char* rp = (const char*)(src + (size_t)m * D); const unsigned lo = (unsigned)F.lane * 16u;
            f32x4 v[16];
#pragma unroll
            for (int j = 0; j < 16; ++j) v[j] = KIND == 1 ? __builtin_nontemporal_load((const f32x4*)(rp + (lo + 1024u * j))) : *(const f32x4*)(rp + (lo + 1024u * j));
            float mean = 0.f, rstd = 1.f;
            if (KIND != 1) { ln_stats(v, mean, rstd); if (KIND == 6 && F.lane == 0) *(f32x2*)((float*)(F.ws + WS_RS1) + 2 * (size_t)m) = (f32x2){mean, rstd}; }
#pragma unroll
            for (int j = 0; j < 16; ++j) { const f32x4 va = *(const LAS f32x4*)(VA + 4 * F.lane + 256 * j), vb = *(const LAS f32x4*)(VB + 4 * F.lane + 256 * j);
                const f32x4 o = KIND == 1 ? v[j] * va + vb : (v[j] - mean) * rstd * va + vb;
                if (KIND == 10) *(f32x4*)((char*)(F.out + (size_t)m * D) + (lo + 1024u * j)) = o;
                else { v2u w; w.x = pk2(o[0], o[1]); w.y = pk2(o[2], o[3]); *(v2u*)((char*)(U + (size_t)m * D) + ((unsigned)F.lane * 8u + 512u * j)) = w; } } }
    }
    __syncthreads();
}
__device__ __forceinline__ void p8_hpass(Frame& F) {
    const bf16* GU = (const bf16*)(F.ws + WS_GU); bf16* H = (bf16*)(F.ws + WS_H);
    const float* cw = F.in[I_CW]; const float* cb = F.in[I_CB];
    constexpr int NCG = FF / 8, RB = 32, NITEM = NCG * (M / RB);
    for (int it = (int)blockIdx.x * 512 + F.tid; it < NITEM; it += F.G * 512) {
        const int cg = it % NCG, rb = it / NCG, c = cg * 8, m0 = rb * RB, t0 = m0 & (SEQ - 1);
        const size_t gcol = (size_t)(c >> 7) * 256 + (c & 127);
        float w0[8], w1[8], w2[8], bs[8];
#pragma unroll
        for (int e = 0; e < 8; e += 4) { const f32x4 a = *(const f32x4*)(cw + c + e), b = *(const f32x4*)(cw + FF + c + e), d = *(const f32x4*)(cw + 2 * FF + c + e), s = *(const f32x4*)(cb + c + e);
#pragma unroll
            for (int k = 0; k < 4; ++k) { w0[e + k] = a[k]; w1[e + k] = b[k]; w2[e + k] = d[k]; bs[e + k] = s[k]; } }
        v4u g1 = (v4u){0u, 0u, 0u, 0u}, g0 = (v4u){0u, 0u, 0u, 0u};
        const bf16* gp = GU + (size_t)m0 * NGU + gcol; bf16* hp = H + (size_t)m0 * FF + c;
        if (t0 >= 2) { g1 = *(const v4u*)(gp - NGU); g0 = *(const v4u*)(gp - 2 * NGU); }
#pragma unroll 1
        for (int r = 0; r < RB; r += 2) {
            v4u g2[2], up[2];
#pragma unroll
            for (int q = 0; q < 2; ++q) { g2[q] = __builtin_nontemporal_load((const v4u*)(gp + q * NGU)); up[q] = __builtin_nontemporal_load((const v4u*)(gp + q * NGU + 128)); }
#pragma unroll
            for (int q = 0; q < 2; ++q) { float o[8];
#pragma unroll
                for (int e = 0; e < 8; ++e) { const unsigned x2 = g2[q][e >> 1], x1 = g1[e >> 1], x0 = g0[e >> 1], xu = up[q][e >> 1];
                    const float a2 = (e & 1) ? bfhi(x2) : bflo(x2), a1 = (e & 1) ? bfhi(x1) : bflo(x1), a0 = (e & 1) ? bfhi(x0) : bflo(x0), uu = (e & 1) ? bfhi(xu) : bflo(xu);
                    const float gg = bs[e] + w0[e] * a0 + w1[e] * a1 + w2[e] * a2;
                    o[e] = gg / (1.0f + __expf(-gg)) * uu; }
                v4u w; w.x = pk2(o[0], o[1]); w.y = pk2(o[2], o[3]); w.z = pk2(o[4], o[5]); w.w = pk2(o[6], o[7]);
                *(v4u*)(hp + q * FF) = w;
                g0 = g1; g1 = g2[q]; }
            gp += 2 * NGU; hp += 2 * FF;
        }
    }
}


namespace att {
typedef float f32x16 __attribute__((ext_vector_type(16)));
typedef short bf16x8 __attribute__((ext_vector_type(8)));
constexpr int VP = 144;
constexpr int KREG = 32768, BUF_STRIDE = 57344;
constexpr int X_OFF = 2 * BUF_STRIDE;
__device__ __forceinline__ int swap23(int r) { return (r & ~12) | ((r & 4) << 1) | ((r & 8) >> 1); }
__device__ __forceinline__ unsigned sortable(float f) { const unsigned u = __builtin_bit_cast(unsigned, f); return (u & 0x80000000u) ? ~u : (u | 0x80000000u); }

template <int OFF> __device__ __forceinline__ void lds_rd128(bf16x8& d, unsigned addr) { asm volatile("ds_read_b128 %0, %1 offset:%2" : "=v"(d) : "v"(addr), "n"(OFF)); }
template <int N> __device__ __forceinline__ void lgkm_wait(bf16x8& d) { asm volatile("s_waitcnt lgkmcnt(%1)" : "+v"(d) : "n"(N)); }
struct Stg {
    const unsigned char* base;
    unsigned koff[4], kstep[4], voff[3];
    unsigned ldsk, ldsv;
    int nk, nv;
    template <int E> __device__ __forceinline__ void k() { if (E < nk) __builtin_amdgcn_global_load_lds((const unsigned*)(base + koff[E]), (LAS unsigned*)(unsigned long long)(ldsk + E * 1024), 16, 0, 0); }
    template <int E> __device__ __forceinline__ void v() { if (E < nv) __builtin_amdgcn_global_load_lds((const unsigned*)(base + voff[E]), (LAS unsigned*)(unsigned long long)(ldsv + E * 1024), 16, 0, 0); }
};
template <int N, int KSTEPS, int KP, int PF> struct SStep {
    static __device__ __forceinline__ void run(bf16x8 (&fr)[PF], f32x16 (&sa)[2], const bf16x8 (&qf)[KSTEPS], unsigned base, Stg& st, bool more) {
        constexpr int NMM = 2 * KSTEPS, kb = N / KSTEPS, s = N % KSTEPS, GAP = NMM / 4;
        lgkm_wait<((NMM - N < PF) ? NMM - N : PF) - 1>(fr[N % PF]);
        sa[kb] = __builtin_amdgcn_mfma_f32_32x32x16_bf16(fr[N % PF], qf[s], sa[kb], 0, 0, 0);
        if constexpr (N + PF < NMM) lds_rd128<32 * ((N + PF) / KSTEPS) * KP + 32 * ((N + PF) % KSTEPS)>(fr[N % PF], base);
        if constexpr (N % 2 == 1 && N < 8) st.template k<N / 2>();
        if constexpr (N % 2 == 1 && N >= 8 && N < 14) st.template v<(N - 8) / 2>();
        if constexpr (N + 1 < NMM) SStep<N + 1, KSTEPS, KP, PF>::run(fr, sa, qf, base, st, more);
    }
};
template <int N, int PF> struct PVStep {
    static __device__ __forceinline__ void run(bf16x8 (&fr)[PF], f32x16 (&o)[4], const bf16x8 (&pf)[4], unsigned base, Stg& st, bool more) {
        constexpr int d = N / 4, ks = N % 4;
        lgkm_wait<((16 - N < PF) ? 16 - N : PF) - 1>(fr[N % PF]);
        o[d] = __builtin_amdgcn_mfma_f32_32x32x16_bf16(fr[N % PF], pf[ks], o[d], 0, 0, 0);
        if constexpr (N + PF < 16) lds_rd128<32 * ((N + PF) / 4) * VP + 32 * ((N + PF) % 4)>(fr[N % PF], base);
        if constexpr (N + 1 < 16) PVStep<N + 1, PF>::run(fr, o, pf, base, st, more);
    }
};
template <int N, int KSTEPS, int KP, int PF> struct SPre { static __device__ __forceinline__ void run(bf16x8 (&fr)[PF], unsigned base) {
    lds_rd128<32 * (N / KSTEPS) * KP + 32 * (N % KSTEPS)>(fr[N], base); if constexpr (N + 1 < PF) SPre<N + 1, KSTEPS, KP, PF>::run(fr, base); } };
template <int N, int PF> struct PVPre { static __device__ __forceinline__ void run(bf16x8 (&fr)[PF], unsigned base) {
    lds_rd128<32 * (N / 4) * VP + 32 * (N % 4)>(fr[N], base); if constexpr (N + 1 < PF) PVPre<N + 1, PF>::run(fr, base); } };
__device__ __forceinline__ void dsa_topk(Frame& F, int b, int q0, int slot) {
    const int tid = F.tid, lane = F.lane, w = F.wave; LAS unsigned char* lds = F.lds; const size_t brow = (size_t)b * SEQ;
    LAS unsigned* bmp = (LAS unsigned*)(lds + X_OFF) + slot * 1024;
    LAS float* rb2 = (LAS float*)(lds + X_OFF + 8192 + 1024);
    {
        const float* SC = (const float*)(F.ws + WS_SC);
        for (int idx = tid; idx < 2048; idx += 512) rb2[idx] = F.in[I_RELB][(int)BUCKET_TAB[idx >> 4] * 16 + (idx & 15)] * 1.4426950408889634f;
        for (int tt = 0; tt < 2; ++tt) {
            const int t = q0 + 2 * w + tt, n = t + 1; const float* row = SC + (brow + t) * SEQ;
            unsigned u[32];
#pragma unroll
            for (int j = 0; j < 32; ++j) { const int s = 64 * j + lane; u[j] = 0u; if (64 * j < n) { if (s < n) u[j] = sortable(row[s]); } }
            unsigned T = 1u;
            bool exact = true;
            if (n > 256) {
                T = 0u; exact = false;
                for (int bit = 31; bit >= 0; --bit) {
                    const unsigned cand = T | (1u << bit); int c = 0;
#pragma unroll
                    for (int j = 0; j < 32; ++j) c += __popcll(__ballot(u[j] >= cand));
                    if (c >= 256) T = cand;
                    if (c == 256) { exact = true; break; }
                }
            }
            if (exact) {
#pragma unroll
                for (int j = 0; j < 32; ++j) { const unsigned long long mk = __ballot(u[j] >= T); if (lane < 2) bmp[(2 * w + tt) * 64 + 2 * j + lane] = (unsigned)(mk >> (32 * lane)); }
            } else {
                int need = 256;
#pragma unroll
                for (int j = 0; j < 32; ++j) need -= __popcll(__ballot(u[j] > T));
#pragma unroll
                for (int j = 0; j < 32; ++j) { unsigned long long mk = __ballot(u[j] > T), eq = __ballot(u[j] == T);
                    while (eq != 0ull && need > 0) { const unsigned long long low = eq & (~eq + 1ull); mk |= low; eq ^= low; --need; }
                    if (lane < 2) bmp[(2 * w + tt) * 64 + 2 * j + lane] = (unsigned)(mk >> (32 * lane)); }
            }
        }
    }
}
template <int MODE> __device__ __forceinline__ void attn_unit(Frame& F, int b, int h, int q0, int slot) {
    constexpr int KD = MODE == 0 ? 192 : 128, KCH = KD / 8, KP = (KCH + 1) * 16, KSTEPS = KD / 16, KTILE = 64 * KP;
    constexpr int KROWCH = KCH + 1;
    static_assert(64 * KP <= KREG && KREG + 128 * VP <= BUF_STRIDE, "tile buffers");
    const int tid = F.tid, lane = F.lane, w = F.wave, l32 = lane & 31, hh = lane >> 5;
    LAS unsigned char* lds = F.lds;
    unsigned long long wsl_ = (unsigned long long)F.ws; asm volatile("" : "+s"(wsl_));
    unsigned char* const WSP = (unsigned char*)wsl_;
    unsigned long long posl_ = (unsigned long long)F.in[I_POS]; asm volatile("" : "+s"(posl_)); const int* const POSP = (const int*)posl_;
    const bf16* QG; const bf16* KG; const bf16* K2G = nullptr; const bf16* VTG; bf16* MIX = (bf16*)(WSP + WS_MIX);
    if (MODE == 0) { QG = (const bf16*)(WSP + WS_QB); KG = (const bf16*)(WSP + WS_KN); K2G = (const bf16*)(WSP + WS_IKX); VTG = (const bf16*)(WSP + WS_VT) + (size_t)(h * 128) * M; }
    else { QG = (const bf16*)(WSP + WS_AQ); KG = (const bf16*)(WSP + WS_AKV); VTG = (const bf16*)(WSP + WS_VTA); }
    const size_t brow = (size_t)b * SEQ;
    int tq, qhead;
    if (MODE == 0) { tq = q0 + 32 * w + l32; qhead = h; } else { tq = q0 + 2 * w + (l32 >> 4); qhead = l32 & 15; }
    const int nt = MODE == 0 ? (q0 + 256) / 64 : (q0 + 16 + 63) / 64;
    LAS unsigned* bmp = (LAS unsigned*)(lds + X_OFF) + slot * 1024;
    LAS int* posk = (LAS int*)(lds + X_OFF + 8192);
    LAS int* farf = (LAS int*)(lds + X_OFF + 8192 + 512);
    LAS float* rb2 = (LAS float*)(lds + X_OFF + 8192 + 1024);
    bf16x8 qf[KSTEPS];
    int posq = 0, minposq = 0; float bias_far = 0.f;
    if (MODE == 1) { const int* pos = POSP; posq = pos[brow + tq]; const int p0 = pos[brow + q0 + 2 * w], p1 = pos[brow + q0 + 2 * w + 1]; minposq = p0 < p1 ? p0 : p1; }
    Stg st; st.base = WSP;
    { constexpr int NKI = (64 * KROWCH + 63) / 64, NVI = 18;
      int ln_ = lane; asm volatile("" : "+v"(ln_));
      st.nk = NKI - 4 * w; st.nk = st.nk < 0 ? 0 : (st.nk > 4 ? 4 : st.nk); st.nv = NVI - 3 * w; st.nv = st.nv < 0 ? 0 : (st.nv > 3 ? 3 : st.nv);
#pragma unroll
      for (int e = 0; e < 4; ++e) { const int q = (4 * w + e) * 64 + ln_, rho = q / KROWCH, c = q % KROWCH; const bool ok = rho < 64 && c < KCH; const unsigned kr = (unsigned)swap23(rho & 63);
          if (MODE == 0) { const bool two = c >= 16;
              st.koff[e] = !ok ? (unsigned)WS_KN : (two ? (unsigned)WS_IKX + ((unsigned)(brow + kr) * 256u + 128u + 8u * (c - 16)) * 2u : (unsigned)WS_KN + ((unsigned)(brow + kr) * 2048u + (unsigned)h * 128u + 8u * c) * 2u);
              st.kstep[e] = !ok ? 0u : (two ? 64u * 512u : 64u * 4096u); }
          else { st.koff[e] = !ok ? (unsigned)WS_AKV : (unsigned)WS_AKV + ((unsigned)(brow + kr) * 256u + 8u * c) * 2u; st.kstep[e] = !ok ? 0u : 64u * 512u; } }
#pragma unroll
      for (int e = 0; e < 3; ++e) { const int q = (3 * w + e) * 64 + ln_, d = q / 9, c = q % 9; const bool ok = d < 128 && c < 8;
          const unsigned vb = MODE == 0 ? (unsigned)WS_VT + (unsigned)(h * 128) * (unsigned)(M * 2) : (unsigned)WS_VTA;
          st.voff[e] = !ok ? vb : vb + (unsigned)d * (unsigned)(M * 2) + ((unsigned)brow + 8u * c) * 2u; } }
#define ATT_ADVANCE() do { _Pragma("unroll") for (int e = 0; e < 4; ++e) st.koff[e] += st.kstep[e]; _Pragma("unroll") for (int e = 0; e < 3; ++e) st.voff[e] += 128u; } while (0)
#define ATT_TARGET(i_) do { const unsigned tb_ = (unsigned)(unsigned long long)(lds + ((i_) & 1) * BUF_STRIDE); st.ldsk = tb_ + 4 * w * 1024; st.ldsv = tb_ + KREG + 3 * w * 1024; } while (0)
#define ATT_POS(i_) do { if (MODE == 1 && tid < 64) { const int* pos_ = POSP + brow + 64 * (i_); const int pk = pos_[tid]; posk[((i_) & 1) * 64 + tid] = pk; int mx = pk; \
            _Pragma("unroll") for (int o_ = 1; o_ < 64; o_ <<= 1) { const int y = __shfl_xor(mx, o_); mx = mx > y ? mx : y; } \
            if (tid == 0) farf[(i_) & 1] = mx; } } while (0)
    f32x16 o[4];
#pragma unroll
    for (int d = 0; d < 4; ++d)
#pragma unroll
        for (int r = 0; r < 16; ++r) o[d][r] = 0.f;
    float ninit = 0.f, lrun = 0.f;
    constexpr float THR = 8.0f;
    __syncthreads();
    if (MODE == 1) bias_far = rb2[127 * 16 + qhead];
    { const bf16* qp = MODE == 0 ? QG + (brow + tq) * 3072 + qhead * 192 + 8 * hh : QG + (brow + tq) * 2048 + qhead * 128 + 8 * hh;
#pragma unroll
      for (int s = 0; s < KSTEPS; ++s) qf[s] = *(const bf16x8*)(qp + 16 * s); }
    ATT_TARGET(0); st.k<0>(); st.k<1>(); st.k<2>(); st.k<3>(); st.v<0>(); st.v<1>(); st.v<2>(); ATT_POS(0); ATT_ADVANCE();
    asm volatile("s_waitcnt vmcnt(0)" ::: "memory"); __syncthreads();
    const int tmin = MODE == 0 ? q0 + 32 * w : q0;
    for (int i = 0; i < nt; ++i) {
        const bool more = i + 1 < nt;
        ATT_TARGET(i + 1); if (more) ATT_POS(i + 1);
        const int key0 = 64 * i;
        {
            const LAS unsigned char* kbuf = lds + (i & 1) * BUF_STRIDE; const LAS unsigned char* vbuf = kbuf + KREG;
            constexpr int PF = MODE == 0 ? 4 : 3;
            const unsigned kbase = (unsigned)(unsigned long long)(kbuf + l32 * KP + hh * 16), vbase = (unsigned)(unsigned long long)(vbuf + l32 * VP + hh * 16);
            f32x16 sa[2]; bf16x8 fr[PF];
            SPre<0, KSTEPS, KP, PF>::run(fr, kbase);
            if (MODE == 0) {
#pragma unroll
                for (int kb = 0; kb < 2; ++kb)
#pragma unroll
                    for (int r = 0; r < 16; ++r) sa[kb][r] = ninit;
            } else {
                const bool far_ = __builtin_amdgcn_readfirstlane(minposq - farf[i & 1]) >= 128;
#pragma unroll
                for (int kb = 0; kb < 2; ++kb)
#pragma unroll
                    for (int g = 0; g < 2; ++g) { float bia[8];
#pragma unroll
                        for (int e = 0; e < 8; ++e) bia[e] = bias_far;
                        if (!far_) { const LAS int* pp = posk + (i & 1) * 64 + 32 * kb + 16 * g + 8 * hh;
#pragma unroll
                            for (int e = 0; e < 8; ++e) { int rel = posq - pp[e]; rel = rel < 0 ? 0 : (rel > 127 ? 127 : rel); bia[e] = rb2[rel * 16 + qhead]; } }
#pragma unroll
                        for (int e = 0; e < 8; ++e) sa[kb][8 * g + e] = bia[e] + ninit;
                        __builtin_amdgcn_sched_barrier(0); }
            }
            SStep<0, KSTEPS, KP, PF>::run(fr, sa, qf, kbase, st, more);
            if (MODE == 0) {
                if (key0 + 63 > tmin) {
#pragma unroll
                    for (int kb = 0; kb < 2; ++kb)
#pragma unroll
                        for (int r = 0; r < 16; ++r) { const int key = key0 + 32 * kb + 16 * (r >> 3) + 8 * hh + (r & 7); const float xv = sa[kb][r]; sa[kb][r] = key > tq ? -__builtin_inff() : xv; }
                }
            } else {
                const v2u wds = *(const LAS v2u*)(bmp + (2 * w + (l32 >> 4)) * 64 + 2 * i);
#pragma unroll
                for (int kb = 0; kb < 2; ++kb) { const int wdh = (int)((kb == 0 ? wds.x : wds.y) >> (8 * hh));
#pragma unroll
                    for (int r = 0; r < 16; ++r) { const int mk = __builtin_amdgcn_sbfe(wdh, 16 * (r >> 3) + (r & 7), 1); const float xv = sa[kb][r];
                        sa[kb][r] = __builtin_bit_cast(float, (__builtin_bit_cast(int, xv) & mk) | ((int)0xff800000 & ~mk)); } }
            }
            float mloc = sa[0][0];
#pragma unroll
            for (int kb = 0; kb < 2; ++kb)
#pragma unroll
                for (int r = 0; r < 16; ++r) mloc = fmaxf(mloc, sa[kb][r]);
            mloc = fmaxf(mloc, __shfl_xor(mloc, 32));
            if (i == 0 || __any(mloc > THR)) {
                const float delta = i == 0 ? (mloc > -1.0e30f ? mloc : 0.f) : fmaxf(mloc, 0.f), alpha = __builtin_amdgcn_exp2f(-delta);
                ninit -= delta; lrun *= alpha;
#pragma unroll
                for (int kb = 0; kb < 2; ++kb)
#pragma unroll
                    for (int r = 0; r < 16; ++r) sa[kb][r] -= delta;
#pragma unroll
                for (int d = 0; d < 4; ++d)
#pragma unroll
                    for (int r = 0; r < 16; ++r) o[d][r] *= alpha;
            }
            float psum = 0.f;
#pragma unroll
            for (int kb = 0; kb < 2; ++kb)
#pragma unroll
                for (int r = 0; r < 16; ++r) { const float p = __builtin_amdgcn_exp2f(sa[kb][r]); sa[kb][r] = p; psum += p; }
            lrun += psum;
            bf16x8 pf[4];
#pragma unroll
            for (int ks = 0; ks < 4; ++ks) { v4u pk;
#pragma unroll
                for (int e = 0; e < 4; ++e) pk[e] = pg8::cvt_pk_bf16(sa[ks >> 1][8 * (ks & 1) + 2 * e], sa[ks >> 1][8 * (ks & 1) + 2 * e + 1]);
                pf[ks] = __builtin_bit_cast(bf16x8, pk); }
            PVPre<0, PF>::run(fr, vbase);
            PVStep<0, PF>::run(fr, o, pf, vbase, st, more);
        }
        ATT_ADVANCE();
        asm volatile("s_waitcnt vmcnt(0)" ::: "memory"); __syncthreads();
    }
    { const float lt = lrun + __shfl_xor(lrun, 32), inv = 16.0f / lt;
      int tq2 = tq; asm volatile("" : "+v"(tq2));
      const unsigned oo = (unsigned)(b * SEQ + tq2) * 4096u + (MODE == 0 ? 2048u + (unsigned)h * 128u : (unsigned)qhead * 128u);
      unsigned char* op = (unsigned char*)MIX + oo;
#pragma unroll
      for (int d = 0; d < 4; ++d)
#pragma unroll
          for (int g = 0; g < 4; ++g) { int wv = 0; wv = __builtin_amdgcn_cvt_pk_fp8_f32(o[d][4 * g] * inv, o[d][4 * g + 1] * inv, wv, false); wv = __builtin_amdgcn_cvt_pk_fp8_f32(o[d][4 * g + 2] * inv, o[d][4 * g + 3] * inv, wv, true);
              *(unsigned*)(op + 32 * d + 8 * g + 4 * hh) = (unsigned)wv; } }
}
#undef ATT_ADVANCE
#undef ATT_TARGET
#undef ATT_POS
}

__device__ __forceinline__ void indexer_unit(Frame& F, int b, int t0) {
    constexpr int KP = 272, KTILE = 64 * KP;
    const int tid = F.tid, lane = F.lane, w = F.wave, l32 = lane & 31, hh = lane >> 5;
    LAS unsigned char* lds = F.lds;
    const bf16* IQ = (const bf16*)(F.ws + WS_IQ); const bf16* IKX = (const bf16*)(F.ws + WS_IKX); const float* IW = (const float*)(F.ws + WS_IW); float* SC = (float*)(F.ws + WS_SC);
    const size_t brow = (size_t)b * SEQ, m0 = brow + t0 + 2 * w;
    att::bf16x8 af[2][8]; float wt[2][16];
#pragma unroll
    for (int tt = 0; tt < 2; ++tt) {
#pragma unroll
        for (int s = 0; s < 8; ++s) af[tt][s] = *(const att::bf16x8*)(IQ + (m0 + tt) * 4096 + l32 * 128 + 16 * s + 8 * hh);
#pragma unroll
        for (int g = 0; g < 4; ++g) { const f32x4 v = *(const f32x4*)(IW + (m0 + tt) * 32 + 8 * g + 4 * hh); wt[tt][4 * g] = v[0]; wt[tt][4 * g + 1] = v[1]; wt[tt][4 * g + 2] = v[2]; wt[tt][4 * g + 3] = v[3]; }
    }
    const int nt = (t0 + 16 + 63) / 64;
    v4u st[2];
#define IDX_LOAD(i_) do { _Pragma("unroll") for (int e = 0; e < 2; ++e) { const int q = tid + 512 * e, rho = q >> 4, c = q & 15; st[e] = *(const v4u*)(IKX + (brow + 64 * (i_) + rho) * 256 + 8 * c); } } while (0)
#define IDX_STORE(i_) do { _Pragma("unroll") for (int e = 0; e < 2; ++e) { const int q = tid + 512 * e, rho = q >> 4, c = q & 15; *(LAS v4u*)(lds + ((i_) & 1) * KTILE + rho * KP + c * 16) = st[e]; } } while (0)
    __syncthreads();
    IDX_LOAD(0); IDX_STORE(0);
    __syncthreads();
    for (int i = 0; i < nt; ++i) {
        if (i + 1 < nt) IDX_LOAD(i + 1);
        const LAS unsigned char* kbuf = lds + (i & 1) * KTILE;
#pragma unroll
        for (int kb = 0; kb < 2; ++kb) {
            att::bf16x8 bfr[8];
#pragma unroll
            for (int s = 0; s < 8; ++s) bfr[s] = *(const LAS att::bf16x8*)(kbuf + (32 * kb + l32) * KP + (2 * s + hh) * 16);
            float sc[2];
#pragma unroll
            for (int tt = 0; tt < 2; ++tt) {
                att::f32x16 acc;
#pragma unroll
                for (int r = 0; r < 16; ++r) acc[r] = 0.f;
#pragma unroll
                for (int s = 0; s < 8; ++s) acc = __builtin_amdgcn_mfma_f32_32x32x16_bf16(af[tt][s], bfr[s], acc, 0, 0, 0);
                float x = 0.f;
#pragma unroll
                for (int r = 0; r < 16; ++r) x += wt[tt][r] * fmaxf(acc[r], 0.f);
                sc[tt] = x + __shfl_xor(x, 32);
            }
            SC[(m0 + hh) * SEQ + 64 * i + 32 * kb + l32] = hh ? sc[1] : sc[0];
        }
        if (i + 1 < nt) IDX_STORE(i + 1);
        __syncthreads();
    }
#undef IDX_LOAD
#undef IDX_STORE
}
__device__ __forceinline__ void av_transpose(Frame& F, int tile) {
    const bf16* AKV = (const bf16*)(F.ws + WS_AKV); bf16* VTA = (bf16*)(F.ws + WS_VTA);
    LAS unsigned short* T = (LAS unsigned short*)F.lds;
    __syncthreads();
#pragma unroll
    for (int e = 0; e < 2; ++e) { const int tok = F.tid & 63, c = (F.tid >> 6) + 8 * e; const v4u v = *(const v4u*)(AKV + (size_t)(64 * tile + tok) * 256 + 128 + 8 * c);
#pragma unroll
        for (int k = 0; k < 4; ++k) { T[(8 * c + 2 * k) * 72 + tok] = (unsigned short)(v[k] & 0xffffu); T[(8 * c + 2 * k + 1) * 72 + tok] = (unsigned short)(v[k] >> 16); } }
    __syncthreads();
    { const int d = F.tid >> 2, part = F.tid & 3; const LAS v4u* s = (const LAS v4u*)(T + d * 72 + 16 * part);
      v4u* dst = (v4u*)(VTA + (size_t)d * M + 64 * tile + 16 * part); dst[0] = s[0]; dst[1] = s[1]; }
    __syncthreads();
}

struct Args { const float* in[21]; float* out; unsigned char* ws; int ph_lo, ph_hi; };
__global__ void __launch_bounds__(NWAVES * 64, 2) skel_fwd(Args args) {
    extern __shared__ __attribute__((aligned(16))) unsigned char lds[];
    Frame F;
    F.lds = (LAS unsigned char*)lds;
    F.MISC = (volatile LAS unsigned*)(F.lds + MISC_OFF);
    F.tid = threadIdx.x; F.lane = F.tid & 63; F.wave = __builtin_amdgcn_readfirstlane(F.tid >> 6);
    F.G = gridDim.x; { const int bx = blockIdx.x; F.vcu = (F.G % 8 == 0) ? (bx % 8) * (F.G / 8) + bx / 8 : bx; }
    F.ws = args.ws; F.ctl = (gu32*)(args.ws + WS_CTL); F.out = args.out;
#pragma unroll
    for (int i = 0; i < 21; ++i) F.in[i] = args.in[i];
    for (int u = F.tid; u < (LDS_BYTES - LDSCTL_OFF) / 4; u += NWAVES * 64) ((LAS unsigned*)(F.lds + LDSCTL_OFF))[u] = 0u;
    __syncthreads();
    XcdBarrier bar; bar.bar = (unsigned*)(F.ctl + CW_BAR); bar.x = 0; bar.st = nullptr;
    const int lo = args.ph_lo, hi = args.ph_hi;
    if (hi - lo > 1) bar = xcd_barrier_post((unsigned*)(F.ctl + CW_BAR), F.MISC + 8);
#define IN(k) (lo <= (k) && (k) < hi)
#define SEAM(k) do { if (IN(k) && IN((k) + 1)) xcd_barrier(bar); } while (0)
    unsigned char* ws = args.ws;

    if (IN(0)) { p0_prologue(F); SEAM(0); }
    if (IN(1)) { row_pass<1>(F); SEAM(1); }
    if (IN(2)) {
        pg8::Gemm g{(const bf16*)(ws + WS_U), (const bf16*)(ws + WS_WIN), D, D}; pg8::StaticOrder S; S.init(M, NIN, F.G, (int)blockIdx.x);
        pg8::EpiProj E{(bf16*)(ws + WS_AQ), (bf16*)(ws + WS_AKV), (bf16*)(ws + WS_IQ), (bf16*)(ws + WS_IKX), (bf16*)(ws + WS_QL), (bf16*)(ws + WS_KVL),
                       (float*)(ws + WS_IW), (float*)(ws + WS_RSQQ), (float*)(ws + WS_RSQK), (const float*)(ws + WS_ROPE)};
        pg8::gemm_phase<pg8::EpiProj, pg8::StaticOrder, true, true>(F.lds + RING_OFF, g, S, E);
        SEAM(2);
    }
    if (IN(3)) {
        { pg8::Gemm g{(const bf16*)(ws + WS_QL), (const bf16*)(ws + WS_WUQ), 512, 512}; pg8::StaticOrder S; S.init(M, 3072, F.G, (int)blockIdx.x);
          pg8::EpiUp<true> E{(bf16*)(ws + WS_QB), 3072, (const float*)(ws + WS_RSQQ), (const float*)(ws + WS_ROPE)};
          pg8::gemm_phase<pg8::EpiUp<true>, pg8::StaticOrder, true, true, true>(F.lds + RING_OFF, g, S, E); }
        { pg8::Gemm g{(const bf16*)(ws + WS_KVL), (const bf16*)(ws + WS_WUKV), 256, 256}; pg8::StaticOrder S; S.init(M, 2048, F.G, (int)blockIdx.x);
          pg8::EpiUp<false> E{(bf16*)(ws + WS_KN), 2048, (const float*)(ws + WS_RSQK), nullptr};
          pg8::gemm_phase<pg8::EpiUp<false>, pg8::StaticOrder, true, true, true>(F.lds + RING_OFF, g, S, E); }
        { pg8::Gemm g{(const bf16*)(ws + WS_WUKV) + (size_t)2048 * 256, (const bf16*)(ws + WS_KVL), 256, 256}; pg8::StaticOrder S; S.init(2048, M, F.G, (int)blockIdx.x);
          pg8::EpiVT E{(bf16*)(ws + WS_VT), (const float*)(ws + WS_RSQK)};
          pg8::gemm_phase<pg8::EpiVT, pg8::StaticOrder, true, true, true>(F.lds + RING_OFF, g, S, E); }
        __syncthreads();
        if (blockIdx.x < 128) av_transpose(F, (int)blockIdx.x);
        for (int P = F.vcu; P < 256; P += F.G)     { const int b = P >> 6, j = P & 63; for (int k = 0; k < 2; ++k) indexer_unit(F, b, 16 * (k ? 127 - j : j)); }
        SEAM(3);
    }
    if (IN(4)) {
        for (int P = F.vcu; P < 256; P += F.G)     { const int b = P >> 6, h = (P >> 2) & 15, j = P & 3; for (int k = 0; k < 2; ++k) att::attn_unit<0>(F, b, h, 256 * (k ? 7 - j : j), 0); }
        __syncthreads();
        for (int P = F.vcu; P < 256; P += F.G)     { const int b = P >> 6, j = P & 63;
            __syncthreads();
            for (int k = 0; k < 2; ++k) att::dsa_topk(F, b, 16 * (k ? 127 - j : j), k);
            for (int k = 0; k < 2; ++k) att::attn_unit<1>(F, b, 0, 16 * (k ? 127 - j : j), k); }
        SEAM(4);
    }
    if (IN(5)) {
        pg8::Gemm g{(const bf16*)(ws + WS_MIX), (const bf16*)(ws + WS_WO), D / 2, D / 2};     pg8::StaticOrder S; S.init(M, D, F.G, (int)blockIdx.x);
        pg8::EpiZ<false, 11> E{F.in[I_X], (float*)(ws + WS_Z1), (const float*)(ws + WS_MOD) + 2 * 4096, nullptr, nullptr, nullptr};
        pg8::gemm_phase<pg8::EpiZ<false, 11>, pg8::StaticOrder, true, true, true>(F.lds + RING_OFF, g, S, E);
        SEAM(5);
    }
    if (IN(6)) { row_pass<6>(F); SEAM(6); }
    if (IN(7)) {
        pg8::Gemm g{(const bf16*)(ws + WS_U), (const bf16*)(ws + WS_WGU), D, D}; pg8::StaticOrder S; S.init(M, NGU, F.G, (int)blockIdx.x);
        pg8::EpiPlain E{(bf16*)(ws + WS_GU), NGU};
        pg8::gemm_phase<pg8::EpiPlain, pg8::StaticOrder, true, true>(F.lds + RING_OFF, g, S, E);
        SEAM(7);
    }
    if (IN(8)) { p8_hpass(F); SEAM(8); }
    if (IN(9)) {
        pg8::Gemm g{(const bf16*)(ws + WS_H), (const bf16*)(ws + WS_WD), FF, FF}; pg8::StaticOrder S; S.init(M, D, F.G, (int)blockIdx.x);
        pg8::EpiZ<true, 0> E{(const float*)(ws + WS_Z1), F.out, (const float*)(ws + WS_MOD) + 5 * 4096, (const float*)(ws + WS_RS1), F.in[I_LN1G], F.in[I_LN1B]};
        pg8::gemm_phase<pg8::EpiZ<true, 0>, pg8::StaticOrder, true, true>(F.lds + RING_OFF, g, S, E);
        SEAM(9);
    }
    if (IN(10)) { row_pass<10>(F); }
#undef IN
#undef SEAM
}

extern "C" void kernel_launch(void* const* d_in, const int* in_sizes, int n_in, void* d_out, int out_size, void* d_ws, size_t ws_size, hipStream_t stream) {
    static int grid = 0;
    if (grid == 0) {
        if (n_in != 21 || in_sizes[0] != M * D || out_size != M * D || ws_size < WS_END) { fprintf(stderr, "kernel_launch: unexpected shapes (n_in %d, in0 %d, out %d, ws %zu); nothing launched\n", n_in, n_in > 0 ? in_sizes[0] : -1, out_size, ws_size); grid = -1; return; }
        int dev = 0, cus = 0, per_cu = 0;
        if (hipGetDevice(&dev) != hipSuccess || hipDeviceGetAttribute(&cus, hipDeviceAttributeMultiprocessorCount, dev) != hipSuccess) { grid = -1; return; }
        if (hipFuncSetAttribute((const void*)skel_fwd, hipFuncAttributeMaxDynamicSharedMemorySize, LDS_BYTES) != hipSuccess) { fprintf(stderr, "kernel_launch: hipFuncSetAttribute failed\n"); grid = -1; return; }
        if (hipOccupancyMaxActiveBlocksPerMultiprocessor(&per_cu, (const void*)skel_fwd, NWAVES * 64, LDS_BYTES) != hipSuccess || per_cu < 1)
            fprintf(stderr, "kernel_launch: note: occupancy query reports %d workgroups per CU\n", per_cu);
        (void)hipGetLastError();
        grid = cus;
    }
    if (grid < 0) return;
    if (hipMemsetAsync((char*)d_ws + WS_CTL, 0, CTL_ZERO_BYTES, stream) != hipSuccess) return;
    Args a{};
    for (int i = 0; i < 21; ++i) a.in[i] = (const float*)d_in[i];
    a.out = (float*)d_out; a.ws = (unsigned char*)d_ws;
#if MK_ONE_LAUNCH
    a.ph_lo = 0; a.ph_hi = N_PHASES;
    hipLaunchKernelGGL(skel_fwd, dim3(grid), dim3(NWAVES * 64), LDS_BYTES, stream, a);
#else
    for (int p = 0; p < N_PHASES; ++p) { a.ph_lo = p; a.ph_hi = p + 1; hipLaunchKernelGGL(skel_fwd, dim3(grid), dim3(NWAVES * 64), LDS_BYTES, stream, a); }
#endif
}
```

```cpp
#include <hip/hip_runtime.h>
#include <cstdio>
#include <cstdint>

namespace pg8 {
#define PG8_LAS __attribute__((address_space(3)))
typedef unsigned short bf16_t;
typedef short bf16x8 __attribute__((ext_vector_type(8)));
typedef float f32x4 __attribute__((ext_vector_type(4)));
typedef unsigned u32x4 __attribute__((ext_vector_type(4)));
constexpr int BM = 256, BK = 64, HALF = 128, HTB = HALF * BK * 2  , STAGE_BYTES = 8 * HTB, NXCD = 8, WGM = 8;

__host__ __device__ __forceinline__ int lds_byte(int r, int c) { const int st = (r >> 4) * 2 + (c >> 5), rr = r & 15, cc = c & 31, ob = rr * 64 + cc * 2; return st * 1024 + (ob ^ (((ob >> 9) & 1) << 5)); }
__host__ __device__ __forceinline__ void stage_rc(int b, int& R, int& C) { const int st = b / 1024, sb = b % 1024, swz = sb ^ (((sb >> 9) & 1) << 5); R = (st >> 1) * 16 + swz / 64; C = (st & 1) * 32 + (swz % 64) / 2; }
__host__ __device__ __forceinline__ int perm32(int rho) { const int n = rho >> 4, i = rho & 15; return 8 * (i >> 2) + 4 * n + (i & 3); }

struct Unit { int pm, pn; };
struct Gemm { const bf16_t* A; const bf16_t* Bt; int lda, K; };
typedef int i32x4 __attribute__((ext_vector_type(4)));
typedef int i32x8 __attribute__((ext_vector_type(8)));
__device__ __forceinline__ i32x8 cat8(bf16x8 lo, bf16x8 hi) { return __builtin_shufflevector(__builtin_bit_cast(i32x4, lo), __builtin_bit_cast(i32x4, hi), 0, 1, 2, 3, 4, 5, 6, 7); }

struct StaticOrder {
    int nM, nN, nwg, G, c;
    __host__ __device__ void init(int M, int N, int G_, int c_) { nM = M / BM; nN = N / BM; nwg = nM * nN; G = G_; c = c_; }
    __host__ __device__ bool next(int i, Unit& u) const {
        const long L = (long)i * G + c; if (L >= nwg) return false;
        int wgid = (int)L; { const int q = nwg / NXCD, r = nwg % NXCD, xcd = wgid % NXCD, off = wgid / NXCD; wgid = (xcd < r ? xcd * (q + 1) : r * (q + 1) + (xcd - r) * q) + off; }
        const int nig = WGM * nN, gid = wgid / nig, fm = gid * WGM, gsz = (nM - fm) < WGM ? (nM - fm) : WGM;
        u.pm = fm + ((wgid % nig) % gsz); u.pn = (wgid % nig) / gsz; return true;
    }
    __device__ __forceinline__ void a_ready(const Unit&) const {}
    __device__ __forceinline__ void done(const Unit&) const {}
};

__device__ __forceinline__ unsigned cvt_pk_bf16(float lo, float hi) { unsigned r; asm volatile("v_cvt_pk_bf16_f32 %0, %1, %2" : "=v"(r) : "v"(lo), "v"(hi)); return r; }
__device__ __forceinline__ u32x4 pack8(const f32x4 v0, const f32x4 v1) { u32x4 w; w.x = cvt_pk_bf16(v0[0], v0[1]); w.y = cvt_pk_bf16(v0[2], v0[3]); w.z = cvt_pk_bf16(v1[0], v1[1]); w.w = cvt_pk_bf16(v1[2], v1[3]); return w; }
__device__ __forceinline__ void rope8(f32x4& v0, f32x4& v1, const float* rp) {
    const f32x4 c0 = *(const f32x4*)rp, c1 = *(const f32x4*)(rp + 4);
    float a, b;
    a = v0[0] * c0[0] - v0[1] * c0[1]; b = v0[0] * c0[1] + v0[1] * c0[0]; v0[0] = a; v0[1] = b;
    a = v0[2] * c0[2] - v0[3] * c0[3]; b = v0[2] * c0[3] + v0[3] * c0[2]; v0[2] = a; v0[3] = b;
    a = v1[0] * c1[0] - v1[1] * c1[1]; b = v1[0] * c1[1] + v1[1] * c1[0]; v1[0] = a; v1[1] = b;
    a = v1[2] * c1[2] - v1[3] * c1[3]; b = v1[2] * c1[3] + v1[3] * c1[2]; v1[2] = a; v1[3] = b;
}

struct EpiPlain {
    static constexpr bool PERM = true, AFTER_DRAIN = false;
    bf16_t* O; int ldc;
    __device__ __forceinline__ void operator()(const f32x4 (&acc)[2][2][4][2], const Unit& u, int wr, int wc, int fr, int fq) const {
        const int row0 = u.pm * BM + wr * 64 + fr, col0 = u.pn * BM + wc * 32 + 8 * fq;
#pragma unroll
        for (int ai = 0; ai < 2; ++ai)
#pragma unroll
            for (int m = 0; m < 4; ++m) { bf16_t* rowp = O + (size_t)(row0 + ai * HALF + m * 16) * ldc + col0;
#pragma unroll
                for (int bj = 0; bj < 2; ++bj) *(u32x4*)(rowp + bj * HALF) = pack8(acc[ai][bj][m][0], acc[ai][bj][m][1]); }
    }
};

template <bool F8> struct EpiProj {
    static constexpr bool PERM = true, AFTER_DRAIN = false;
    bf16_t *AQ, *AKV, *IQ, *IKX, *QL, *KVL; float *IW, *RSQQ, *RSQK; const float* ROPE;
    __device__ __forceinline__ void operator()(const f32x4 (&acc)[2][2][4][2], const Unit& u, int wr, int wc, int fr, int fq) const {
        const int pn = F8 ? (u.pn <= 9 ? u.pn : u.pn + 16) : (u.pn < 15 ? u.pn + 10 : 25);
        bf16_t* dst; int pitch, coff, kind = 0; unsigned ropemask = 0u;
        if (pn < 8) { dst = AQ; pitch = 2048; coff = pn * 256; }
        else if (pn == 8) { dst = AKV; pitch = 256; coff = 0; }
        else if (pn < 25) { dst = IQ; pitch = 4096; coff = (pn - 9) * 256; ropemask = 0xAu; }
        else if (pn == 25) { dst = IKX; pitch = 256; coff = 0; ropemask = 0x6u; kind = 3; }
        else if (pn < 30) { dst = QL; pitch = 1024; coff = (pn - 26) * 256; kind = 1; }
        else { dst = KVL; pitch = 512; coff = (pn - 30) * 256; kind = 2; }
        const int row0 = u.pm * BM + wr * 64 + fr, lc0 = wc * 32 + 8 * fq, i0 = 16 * (wc & 1) + 4 * fq;
#pragma unroll
        for (int ai = 0; ai < 2; ++ai)
#pragma unroll
            for (int m = 0; m < 4; ++m) {
                const int row = row0 + ai * HALF + m * 16; float ss = 0.f;
#pragma unroll
                for (int bj = 0; bj < 2; ++bj) {
                    f32x4 v0 = acc[ai][bj][m][0], v1 = acc[ai][bj][m][1];
                    if (F8) { v0 = v0 * (1.0f / 64.0f); v1 = v1 * (1.0f / 64.0f); }
                    if (pn < 8) { v0 = v0 * (0.08838834764831845f * 1.4426950408889634f); v1 = v1 * (0.08838834764831845f * 1.4426950408889634f); }
                    if ((ropemask >> (2 * bj + (wc >> 1))) & 1u) rope8(v0, v1, ROPE + ((size_t)row * 32 + i0) * 2);
                    if (kind == 1 || kind == 2) ss += (v0[0] * v0[0] + v0[1] * v0[1]) + (v0[2] * v0[2] + v0[3] * v0[3]) + (v1[0] * v1[0] + v1[1] * v1[1]) + (v1[2] * v1[2] + v1[3] * v1[3]);
                    if (kind == 3 && bj == 1 && wc == 2) { float* iw = IW + (size_t)row * 32 + 8 * fq; *(f32x4*)iw = v0; *(f32x4*)(iw + 4) = v1; }
                    if (kind == 1 || kind == 2) {
                        int w0 = 0, w1 = 0; w0 = __builtin_amdgcn_cvt_pk_fp8_f32(v0[0], v0[1], w0, false); w0 = __builtin_amdgcn_cvt_pk_fp8_f32(v0[2], v0[3], w0, true);
                        w1 = __builtin_amdgcn_cvt_pk_fp8_f32(v1[0], v1[1], w1, false); w1 = __builtin_amdgcn_cvt_pk_fp8_f32(v1[2], v1[3], w1, true);
                        typedef unsigned u32x2 __attribute__((ext_vector_type(2)));
                        *(u32x2*)((unsigned char*)dst + (size_t)row * pitch + coff + lc0 + bj * HALF) = (u32x2){(unsigned)w0, (unsigned)w1}; }
                    else *(u32x4*)(dst + (size_t)row * pitch + coff + lc0 + bj * HALF) = pack8(v0, v1);
                }
                if (kind == 1 || kind == 2) {
                    ss += __shfl_xor(ss, 16); ss += __shfl_xor(ss, 32);
                    if (fq == 0) { if (kind == 1) RSQQ[(size_t)row * 16 + (pn - 26) * 4 + wc] = ss; else RSQK[(size_t)row * 8 + (pn - 30) * 4 + wc] = ss; }
                }
            }
    }
};

template <bool ISQ> struct EpiUp {
    static constexpr bool PERM = true, AFTER_DRAIN = false;
    bf16_t* O; int ldc; const float* RSQ; const float* ROPE;
    __device__ __forceinline__ void operator()(const f32x4 (&acc)[2][2][4][2], const Unit& u, int wr, int wc, int fr, int fq) const {
        const int row0 = u.pm * BM + wr * 64 + fr, col0 = u.pn * BM + wc * 32 + 8 * fq, i0 = 16 * (wc & 1) + 4 * fq;
#pragma unroll
        for (int ai = 0; ai < 2; ++ai)
#pragma unroll
            for (int m = 0; m < 4; ++m) {
                const int row = row0 + ai * HALF + m * 16; float rs;
                if (ISQ) { const f32x4* p = (const f32x4*)(RSQ + (size_t)row * 16); const f32x4 a = p[0], b = p[1], c = p[2], d = p[3];
                    const float s = ((a[0] + a[1]) + (a[2] + a[3])) + ((b[0] + b[1]) + (b[2] + b[3])) + ((c[0] + c[1]) + (c[2] + c[3])) + ((d[0] + d[1]) + (d[2] + d[3]));
                    rs = (0.07216878364870322f * 1.4426950408889634f / 32.0f) / sqrtf(s * (1.0f / 1024.0f) + 1e-6f); }
                else { const f32x4* p = (const f32x4*)(RSQ + (size_t)row * 8); const f32x4 a = p[0], b = p[1];
                    const float s = ((a[0] + a[1]) + (a[2] + a[3])) + ((b[0] + b[1]) + (b[2] + b[3]));
                    rs = (1.0f / 16.0f) / sqrtf(s * (1.0f / 512.0f) + 1e-6f); }
#pragma unroll
                for (int bj = 0; bj < 2; ++bj) {
                    f32x4 v0 = acc[ai][bj][m][0] * rs, v1 = acc[ai][bj][m][1] * rs;
                    if (ISQ) { if ((4 * u.pn + 2 * bj + (wc >> 1)) % 3 == 2) rope8(v0, v1, ROPE + ((size_t)row * 32 + i0) * 2); }
                    *(u32x4*)(O + (size_t)row * ldc + col0 + bj * HALF) = pack8(v0, v1);
                }
            }
    }
};

struct EpiVT {
    static constexpr bool PERM = true, AFTER_DRAIN = false;
    bf16_t* O; const float* RSQ;
    __device__ __forceinline__ void operator()(const f32x4 (&acc)[2][2][4][2], const Unit& u, int wr, int wc, int fr, int fq) const {
        const int row0 = u.pm * BM + wr * 64 + fr, col0 = u.pn * BM + wc * 32 + 8 * fq;
        f32x4 rs[2][2];
#pragma unroll
        for (int bj = 0; bj < 2; ++bj)
#pragma unroll
            for (int e = 0; e < 8; ++e) { const f32x4* p = (const f32x4*)(RSQ + (size_t)(col0 + bj * HALF + e) * 8); const f32x4 a = p[0], b = p[1];
                const float s = ((a[0] + a[1]) + (a[2] + a[3])) + ((b[0] + b[1]) + (b[2] + b[3]));
                rs[bj][e >> 2][e & 3] = (1.0f / 16.0f) / sqrtf(s * (1.0f / 512.0f) + 1e-6f); }
#pragma unroll
        for (int ai = 0; ai < 2; ++ai)
#pragma unroll
            for (int m = 0; m < 4; ++m) { bf16_t* rowp = O + (size_t)(row0 + ai * HALF + m * 16) * 8192 + col0;
#pragma unroll
                for (int bj = 0; bj < 2; ++bj) *(u32x4*)(rowp + bj * HALF) = pack8(acc[ai][bj][m][0] * rs[bj][0], acc[ai][bj][m][1] * rs[bj][1]); }
    }
};

template <bool LNR, int ASH> struct EpiZ {
    static constexpr bool PERM = false, AFTER_DRAIN = false;
    const float* R; float* Z; const float* gate;
    static constexpr float alpha = 1.189207115002721f, ascale = 1.0f / (float)(1 << ASH);
    const float* RS; const float* LG; const float* LB;
    __device__ __forceinline__ void operator()(const f32x4 (&acc)[2][2][4][2], const Unit& u, int wr, int wc, int fr, int fq) const {
        const int row0 = u.pm * BM + wr * 64 + fr, col0 = u.pn * BM + wc * 32 + 4 * fq;
        const float* gp = gate + (size_t)((u.pm * BM) >> 11) * 24576 + col0;
#pragma unroll
        for (int bj = 0; bj < 2; ++bj)
#pragma unroll
            for (int n = 0; n < 2; ++n) {
                const f32x4 gv = (*(const f32x4*)(gp + bj * HALF + 16 * n) + 1.0f) * ascale; f32x4 lg = gv, lb = gv;
                if (LNR) { lg = *(const f32x4*)(LG + col0 + bj * HALF + 16 * n) * alpha; lb = *(const f32x4*)(LB + col0 + bj * HALF + 16 * n) * alpha; }
#pragma unroll
                for (int ai = 0; ai < 2; ++ai)
#pragma unroll
                    for (int m = 0; m < 4; ++m) { const int row = row0 + ai * HALF + m * 16; const size_t ro = (size_t)row * 4096 + col0 + bj * HALF + 16 * n;
                        const f32x4 r = *(const f32x4*)(R + ro); f32x4 res;
                        if (LNR) { typedef float f32x2 __attribute__((ext_vector_type(2))); const f32x2 ms = *(const f32x2*)(RS + 2 * (size_t)row); res = (r - ms.x) * ms.y * lg + lb; } else res = r * alpha;
                        *(f32x4*)(Z + ro) = res + gv * acc[ai][bj][m][n]; } }
    }
};

template <class Epi, class Sched, bool ALIGN_EPI = false, bool SP2 = false, bool FP8 = false>
__device__ __forceinline__ void gemm_phase(PG8_LAS unsigned char* lds, const Gemm g, const Sched& S, const Epi& E) {
    const int tid = threadIdx.x, wid = __builtin_amdgcn_readfirstlane(tid >> 6), lane = tid & 63, wr = wid >> 2, wc = wid & 3, fr = lane & 15, fq = lane >> 4;
    const int K = g.K, nt = K / BK, lda = g.lda;
    unsigned voffA[2], voffB[2];
#pragma unroll
    for (int i = 0; i < 2; ++i) { int R, C; stage_rc(tid * 16 + i * 8192, R, C); const int Rb = Epi::PERM ? ((R & ~31) + perm32(R & 31)) : R;
        voffA[i] = (unsigned)(R * lda + C) * 2u; voffB[i] = (unsigned)(Rb * K + C) * 2u; }
    const size_t kstep = (size_t)(BK * 2);
    const size_t hstep = (size_t)HALF * K * 2, hstepA = (size_t)HALF * lda * 2;
    const size_t tstep = 2 * hstep, tstepA = 2 * hstepA;
    const unsigned ldsw = (unsigned)wid * 1024u;
    const int aoff = lds_byte(wr * 64 + fr, fq * 8), boff = lds_byte(wc * 32 + fr, fq * 8);
#define PG8_SA(b, h) (((b) * 2 + (h)) * HTB)
#define PG8_SB(b, h) ((4 + (b) * 2 + (h)) * HTB)
#define PG8_STAGE(bufoff, gbase, voff) do { _Pragma("unroll") for (int _i = 0; _i < 2; ++_i) \
        __builtin_amdgcn_global_load_lds((const unsigned*)((const char*)(gbase) + (voff)[_i]), (PG8_LAS unsigned*)(lds + (bufoff) + ldsw + _i * 8192), 16, 0, 0); } while (0)
#define PG8_LDA(dst, b, h) do { if constexpr (FP8) { _Pragma("unroll") for (int m = 0; m < 4; ++m) dst##8[m] = __builtin_shufflevector(*(const PG8_LAS i32x4*)(lds + PG8_SA(b, h) + aoff + m * 2048), *(const PG8_LAS i32x4*)(lds + PG8_SA(b, h) + aoff + m * 2048 + 1024), 0, 1, 2, 3, 4, 5, 6, 7); } \
        else { _Pragma("unroll") for (int m = 0; m < 4; ++m) _Pragma("unroll") for (int k = 0; k < 2; ++k) dst[m][k] = *(const PG8_LAS bf16x8*)(lds + PG8_SA(b, h) + aoff + m * 2048 + k * 1024); } } while (0)
#define PG8_LDB(dst, b, h) do { if constexpr (FP8) { _Pragma("unroll") for (int n = 0; n < 2; ++n) dst##8[n] = __builtin_shufflevector(*(const PG8_LAS i32x4*)(lds + PG8_SB(b, h) + boff + n * 2048), *(const PG8_LAS i32x4*)(lds + PG8_SB(b, h) + boff + n * 2048 + 1024), 0, 1, 2, 3, 4, 5, 6, 7); } \
        else { _Pragma("unroll") for (int n = 0; n < 2; ++n) _Pragma("unroll") for (int k = 0; k < 2; ++k) dst[n][k] = *(const PG8_LAS bf16x8*)(lds + PG8_SB(b, h) + boff + n * 2048 + k * 1024); } } while (0)
#define PG8_MMA(ai, bj, At, Bt) do { __builtin_amdgcn_s_setprio(1); \
        if constexpr (FP8) { _Pragma("unroll") for (int m = 0; m < 4; ++m) _Pragma("unroll") for (int n = 0; n < 2; ++n) \
            asm volatile("v_mfma_f32_16x16x128_f8f6f4 %0, %1, %2, %0" : "+v"(acc[ai][bj][m][n]) : "v"(Bt##8[n]), "v"(At##8[m])); } \
        else { _Pragma("unroll") for (int m = 0; m < 4; ++m) _Pragma("unroll") for (int n = 0; n < 2; ++n) _Pragma("unroll") for (int k = 0; k < 2; ++k) \
            acc[ai][bj][m][n] = __builtin_amdgcn_mfma_f32_16x16x32_bf16(Bt[n][k], At[m][k], acc[ai][bj][m][n], 0, 0, 0); } \
        __builtin_amdgcn_s_setprio(0); } while (0)
#define PG8_WAIT_V(n) asm volatile("s_waitcnt vmcnt(" #n ")" ::: "memory")
#define PG8_WAIT_L(n) asm volatile("s_waitcnt lgkmcnt(" #n ")" ::: "memory")
#define PG8_BAR __builtin_amdgcn_s_barrier()
#define PG8_SCHED __builtin_amdgcn_sched_barrier(0)
    Unit cur, nxt; int ui = 0;
    if (!S.next(0, cur)) return;
    f32x4 acc[2][2][4][2];
#pragma unroll
    for (int a = 0; a < 2; ++a)
#pragma unroll
        for (int b = 0; b < 2; ++b)
#pragma unroll
            for (int m = 0; m < 4; ++m)
#pragma unroll
                for (int n = 0; n < 2; ++n) acc[a][b][m][n] = (f32x4){0.f, 0.f, 0.f, 0.f};
    bf16x8 At[4][2], B0[2][2], B1[2][2]; i32x8 At8[4], B08[2], B18[2];
    const char* cA = (const char*)g.A + (size_t)cur.pm * tstepA; const char* cB = (const char*)g.Bt + (size_t)cur.pn * tstep;
    S.a_ready(cur);
    if constexpr (SP2) {
        PG8_STAGE(PG8_SB(0, 0), cB, voffB); PG8_STAGE(PG8_SB(0, 1), cB + hstep, voffB); PG8_STAGE(PG8_SA(0, 0), cA, voffA); PG8_STAGE(PG8_SA(0, 1), cA + hstepA, voffA);
        if (wr == 1) PG8_BAR;
        PG8_WAIT_V(2); PG8_BAR;
        PG8_STAGE(PG8_SB(1, 0), cB + kstep, voffB); PG8_STAGE(PG8_SA(1, 0), cA + kstep, voffA); PG8_STAGE(PG8_SB(1, 1), cB + hstep + kstep, voffB);
        PG8_WAIT_V(6); PG8_BAR;
    } else {
        PG8_STAGE(PG8_SB(0, 0), cB, voffB); PG8_STAGE(PG8_SA(0, 0), cA, voffA); PG8_STAGE(PG8_SB(0, 1), cB + hstep, voffB); PG8_STAGE(PG8_SA(0, 1), cA + hstepA, voffA);
        if (wr == 1) PG8_BAR;
        PG8_WAIT_V(4); PG8_BAR;
        PG8_STAGE(PG8_SB(1, 0), cB + kstep, voffB); PG8_STAGE(PG8_SA(1, 0), cA + kstep, voffA); PG8_STAGE(PG8_SB(1, 1), cB + hstep + kstep, voffB);
        PG8_WAIT_V(6); PG8_BAR;
    }
    for (;;) {
        const bool has_next = S.next(ui + 1, nxt);
        const char* nA = has_next ? (const char*)g.A + (size_t)nxt.pm * tstepA : cA; const char* nB = has_next ? (const char*)g.Bt + (size_t)nxt.pn * tstep : cB;
        for (int t = 0; t < nt; t += 2) {
            const bool last = (t == nt - 2);
            const char* a1 = cA + (size_t)(t + 1) * kstep;
            const char* a2 = last ? nA : cA + (size_t)(t + 2) * kstep; const char* b2 = last ? nB : cB + (size_t)(t + 2) * kstep;
            const char* a3 = a2 + kstep; const char* b3 = b2 + kstep;
            if (last && has_next) S.a_ready(nxt);
            if constexpr (SP2) {
            PG8_LDB(B0, 0, 0); PG8_LDB(B1, 0, 1); PG8_SCHED; PG8_LDA(At, 0, 0); PG8_STAGE(PG8_SA(1, 1), a1 + hstepA, voffA);
            PG8_WAIT_V(8); PG8_WAIT_L(0); PG8_BAR; PG8_MMA(0, 0, At, B0); PG8_MMA(0, 1, At, B1); PG8_BAR; PG8_SCHED;
            PG8_LDA(At, 0, 1); PG8_STAGE(PG8_SB(0, 0), b2, voffB); PG8_STAGE(PG8_SB(0, 1), b2 + hstep, voffB); PG8_STAGE(PG8_SA(0, 0), a2, voffA);
            PG8_WAIT_V(8); PG8_WAIT_L(0); PG8_BAR; PG8_MMA(1, 0, At, B0); PG8_MMA(1, 1, At, B1); PG8_BAR; PG8_SCHED;
            PG8_LDB(B0, 1, 0); PG8_LDB(B1, 1, 1); PG8_SCHED; PG8_LDA(At, 1, 0); PG8_STAGE(PG8_SA(0, 1), a2 + hstepA, voffA);
            PG8_WAIT_V(8); PG8_WAIT_L(0); PG8_BAR; PG8_MMA(0, 0, At, B0); PG8_MMA(0, 1, At, B1); PG8_BAR; PG8_SCHED;
            PG8_LDA(At, 1, 1); PG8_STAGE(PG8_SB(1, 0), b3, voffB); PG8_STAGE(PG8_SB(1, 1), b3 + hstep, voffB); PG8_STAGE(PG8_SA(1, 0), a3, voffA);
            PG8_WAIT_V(8); PG8_WAIT_L(0); PG8_BAR; PG8_MMA(1, 0, At, B0); PG8_MMA(1, 1, At, B1); PG8_BAR; PG8_SCHED;
            } else {
            PG8_LDB(B0, 0, 0); PG8_SCHED; PG8_LDA(At, 0, 0); PG8_STAGE(PG8_SA(1, 1), a1 + hstepA, voffA);
            PG8_WAIT_L(8); PG8_BAR; PG8_WAIT_L(0); PG8_MMA(0, 0, At, B0); PG8_BAR; PG8_SCHED;
            PG8_LDB(B1, 0, 1); PG8_STAGE(PG8_SB(0, 0), b2, voffB);
            PG8_BAR; PG8_WAIT_L(0); PG8_MMA(0, 1, At, B1); PG8_BAR;
            PG8_LDA(At, 0, 1); PG8_STAGE(PG8_SA(0, 0), a2, voffA);
            PG8_BAR; PG8_WAIT_L(0); PG8_MMA(1, 0, At, B0); PG8_BAR; PG8_SCHED;
            PG8_STAGE(PG8_SB(0, 1), b2 + hstep, voffB);
            PG8_WAIT_V(6); PG8_BAR; PG8_MMA(1, 1, At, B1); PG8_BAR;
            PG8_LDB(B0, 1, 0); PG8_SCHED; PG8_LDA(At, 1, 0); PG8_STAGE(PG8_SA(0, 1), a2 + hstepA, voffA);
            PG8_WAIT_L(8); PG8_BAR; PG8_WAIT_L(0); PG8_MMA(0, 0, At, B0); PG8_BAR; PG8_SCHED;
            PG8_LDB(B1, 1, 1); PG8_STAGE(PG8_SB(1, 0), b3, voffB);
            PG8_BAR; PG8_WAIT_L(0); PG8_MMA(0, 1, At, B1); PG8_BAR;
            PG8_LDA(At, 1, 1); PG8_STAGE(PG8_SA(1, 0), a3, voffA);
            PG8_BAR; PG8_WAIT_L(0); PG8_MMA(1, 0, At, B0); PG8_BAR; PG8_SCHED;
            PG8_STAGE(PG8_SB(1, 1), b3 + hstep, voffB);
            PG8_WAIT_V(6); PG8_BAR; PG8_MMA(1, 1, At, B1); PG8_BAR;
            }
        }
        if constexpr (ALIGN_EPI) { if (wr == 0) PG8_BAR; }
        if constexpr (!Epi::AFTER_DRAIN) { E(acc, cur, wr, wc, fr, fq); S.done(cur); }
        if (!has_next) break;
#pragma unroll
        for (int a = 0; a < 2; ++a)
#pragma unroll
            for (int b = 0; b < 2; ++b)
#pragma unroll
                for (int m = 0; m < 4; ++m)
#pragma unroll
                    for (int n = 0; n < 2; ++n) acc[a][b][m][n] = (f32x4){0.f, 0.f, 0.f, 0.f};
        cur = nxt; cA = nA; cB = nB; ++ui;
        if constexpr (ALIGN_EPI) { if (wr == 1) PG8_BAR; }
    }
    PG8_WAIT_V(0);
    if constexpr (!ALIGN_EPI) { if (wr == 0) PG8_BAR; }
    PG8_BAR;
    if constexpr (Epi::AFTER_DRAIN) { E.fused(acc, cur, wr, wc, fr, fq, lds, wid, lane); S.done(cur); }
#undef PG8_SA
#undef PG8_SB
#undef PG8_STAGE
#undef PG8_LDA
#undef PG8_LDB
#undef PG8_MMA
#undef PG8_WAIT_V
#undef PG8_WAIT_L
#undef PG8_BAR
#undef PG8_SCHED
}
}
constexpr int NWAVES = 8;
constexpr int BATCH = 4, SEQ = 2048, D = 4096, M = BATCH * SEQ, FF = 11008, NIN = 8192  , NGU = 2 * FF;
constexpr int N_PHASES = 11;
#ifndef DSA_NAIVE
#define DSA_NAIVE 0
#endif
#ifndef MK_ONE_LAUNCH
#define MK_ONE_LAUNCH 1
#endif
constexpr float LN_EPS = 1e-5f, ALPHA = 1.189207115002721f;

constexpr size_t MiB = 1u << 20;
constexpr size_t WS_CTL = 0, CTL_ZERO_BYTES = 1 * MiB;
constexpr size_t WS_MOD = 1 * MiB, WS_ROPE = 2 * MiB, WS_RSQQ = 4 * MiB, WS_RSQK = 4 * MiB + 512 * 1024, WS_IW = 5 * MiB, WS_VTA = 6 * MiB, WS_RS1 = 4 * MiB + 768 * 1024  ;
constexpr size_t WS_WIN = 8 * MiB  , WS_WINB = 24 * MiB  , WS_WUQ = 72 * MiB, WS_WUKV = 78 * MiB, WS_WO = 82 * MiB, WS_WGU = 114 * MiB, WS_WD = 286 * MiB;
constexpr size_t WS_U = 372 * MiB, WS_AQ = 436 * MiB, WS_AKV = 468 * MiB, WS_IQ = 472 * MiB, WS_IKX = 536 * MiB, WS_QL = 540 * MiB, WS_KVL = 556 * MiB;
constexpr size_t WS_QB = 564 * MiB, WS_KV = 612 * MiB, WS_KN = 612 * MiB, WS_VT = 644 * MiB, WS_SC = 676 * MiB, WS_MIX = 740 * MiB, WS_Z1 = 804 * MiB, WS_X1 = 932 * MiB;
constexpr size_t WS_GU = 436 * MiB  , WS_H = 1060 * MiB, WS_U8 = 1232 * MiB  , WS_END = 1264 * MiB;
static_assert(WS_GU + (size_t)M * NGU * 2 <= WS_X1, "GU overlay");
constexpr int CW_TMO = 0, CW_CODE = 1, CW_BAR = 4096;

constexpr int RING_OFF = 0, RING_BYTES = 131072;
constexpr int LDSCTL_OFF = 135168, MISC_OFF = LDSCTL_OFF + 320;
constexpr int LDS_BYTES = 147456;

#define GAS __attribute__((address_space(1)))
#define LAS __attribute__((address_space(3)))
typedef unsigned short bf16;
typedef unsigned v4u __attribute__((ext_vector_type(4)));
typedef unsigned v2u __attribute__((ext_vector_type(2)));
typedef float f32x4 __attribute__((ext_vector_type(4)));
typedef float f32x2 __attribute__((ext_vector_type(2)));
typedef GAS unsigned gu32;
#define RLX_AGENT __ATOMIC_RELAXED, __HIP_MEMORY_SCOPE_AGENT
#define LDS_WAIT() asm volatile("s_waitcnt lgkmcnt(0)" ::: "memory")
#define VM_WAIT() asm volatile("s_waitcnt vmcnt(0)" ::: "memory")
__device__ __forceinline__ unsigned f2bf(float f) { unsigned u = __builtin_bit_cast(unsigned, f); return (u + 0x7fffu + ((u >> 16) & 1u)) >> 16; }
__device__ __forceinline__ unsigned pk2(float lo, float hi) { return f2bf(lo) | (f2bf(hi) << 16); }
__device__ __forceinline__ float bflo(unsigned w) { return __builtin_bit_cast(float, w << 16); }
__device__ __forceinline__ float bfhi(unsigned w) { return __builtin_bit_cast(float, w & 0xffff0000u); }

#define XB_TMO      128
#define XB_XCNT(j)  (256  + 64 * (j))
#define XB_XSUB(j)  (1280 + 64 * (j))
#define XB_XGEN(j)  (2304 + 64 * (j))
#define XB_TOP      3328
#define XB_TOPGEN   3392
#define XCD_BAR_WORDS 3456
#define XB_SPIN_CAP (1u << 18)
__device__ __forceinline__ unsigned xb_ld(unsigned* p)              { return __hip_atomic_load(p, __ATOMIC_RELAXED, __HIP_MEMORY_SCOPE_AGENT); }
__device__ __forceinline__ unsigned xb_add(unsigned* p, unsigned v) { return __hip_atomic_fetch_add(p, v, __ATOMIC_RELAXED, __HIP_MEMORY_SCOPE_AGENT); }
__device__ __forceinline__ unsigned xb_xcc_id() { return (unsigned)__builtin_amdgcn_s_getreg((3 << 11) | 20) & 0xFu; }
#define XB_SPIN(cond, bar) do { unsigned _sp = 0; while (cond) { __builtin_amdgcn_s_sleep(1); \
    if ((++_sp & 255u) == 0u) { if (xb_ld(&(bar)[XB_TMO])) break; if (_sp > XB_SPIN_CAP) { atomicAdd(&(bar)[XB_TMO], 1u); break; } } } } while (0)
struct XcdBarrier { unsigned* bar; unsigned x; volatile LAS unsigned* st; };
__device__ __forceinline__ XcdBarrier xcd_barrier_post(unsigned* bar, volatile LAS unsigned* st) {
    XcdBarrier b; b.bar = bar; b.x = xb_xcc_id(); b.st = st;
    if (threadIdx.x == 0) (void)xb_add(&bar[XB_XCNT(b.x)], 1u);
    return b;
}
__device__ __forceinline__ void xcd_barrier_complete(unsigned* bar, unsigned x, unsigned& nloc, unsigned& nx) {
    const unsigned G = gridDim.x * gridDim.y * gridDim.z;
    unsigned sum, cnt, mine, sp = 0u;
    for (;;) {
        sum = 0u; cnt = 0u; mine = 0u;
#pragma unroll
        for (unsigned j = 0; j < 16; ++j) { const unsigned c = xb_ld(&bar[XB_XCNT(j)]); sum += c; cnt += (c > 0u) ? 1u : 0u; mine = (j == x) ? c : mine; }
        if (sum == G) break;
        __builtin_amdgcn_s_sleep(1);
        if ((++sp & 255u) == 0u) { if (xb_ld(&bar[XB_TMO])) break; if (sp > XB_SPIN_CAP) { atomicAdd(&bar[XB_TMO], 1u); break; } }
    }
    nloc = mine > 0u ? mine : 1u; nx = cnt > 0u ? cnt : 1u;
}
__device__ __forceinline__ void xcd_barrier(const XcdBarrier& b) {
    asm volatile("s_waitcnt vmcnt(0)" ::: "memory");
    __syncthreads();
    if (threadIdx.x == 0) {
        unsigned* bar = b.bar;
        __builtin_amdgcn_s_waitcnt(0);
        unsigned nloc = b.st[0], nx = b.st[1];
        if (nloc == 0u) { xcd_barrier_complete(bar, b.x, nloc, nx); b.st[0] = nloc; b.st[1] = nx; }
        const unsigned old = xb_add(&bar[XB_XSUB(b.x)], 1u);
        const unsigned gen = old / nloc;
        if (old + 1u == (gen + 1u) * nloc) {
            __builtin_amdgcn_fence(__ATOMIC_RELEASE, "agent");
            asm volatile("s_waitcnt vmcnt(0)" ::: "memory");
            const unsigned og = xb_add(&bar[XB_TOP], 1u);
            const unsigned tg = og / nx;
            if (og + 1u == (tg + 1u) * nx) xb_add(&bar[XB_TOPGEN], 1u);
            else XB_SPIN(xb_ld(&bar[XB_TOPGEN]) == tg, bar);
            __builtin_amdgcn_fence(__ATOMIC_ACQUIRE, "agent");
            xb_add(&bar[XB_XGEN(b.x)], 1u);
            asm volatile("s_waitcnt vmcnt(0)" ::: "memory");
        } else {
            XB_SPIN(xb_ld(&bar[XB_XGEN(b.x)]) == gen, bar);
            __builtin_amdgcn_fence(__ATOMIC_ACQUIRE, "agent");
            asm volatile("s_waitcnt vmcnt(0)" ::: "memory");
        }
    }
    __syncthreads();
}

struct Frame {
    LAS unsigned char* lds;
    volatile LAS unsigned* MISC;
    gu32* ctl;
    int tid, lane, wave;
    int vcu, G;
    unsigned char* ws;
    const float* in[21];
    float* out;
};
__device__ __forceinline__ float wave_sum(float v) {
#pragma unroll
    for (int o = 1; o < 64; o <<= 1) v += __shfl_xor(v, o);
    return v;
}
__device__ __forceinline__ float wave_max(float v) {
#pragma unroll
    for (int o = 1; o < 64; o <<= 1) v = fmaxf(v, __shfl_xor(v, o));
    return v;
}
__device__ __forceinline__ int wave_isum(int v) {
#pragma unroll
    for (int o = 1; o < 64; o <<= 1) v += __shfl_xor(v, o);
    return v;
}
enum { I_X = 0, I_C, I_POS, I_WADA, I_BADA, I_WIN, I_RELB, I_QG, I_WUQ, I_KVG, I_WUKV, I_WO, I_LN1G, I_LN1B, I_WG, I_WU, I_CW, I_CB, I_WD, I_LN2G, I_LN2B };

__device__ const unsigned char BUCKET_TAB[128] = {0, 1, 2, 3, 4, 5, 6, 7, 8, 9, 10, 11, 12, 13, 14, 15, 16, 16, 16, 17, 17, 18, 18, 18, 19, 19, 19, 20, 20, 20, 20, 21, 21, 21, 21, 22, 22, 22, 22, 22, 23, 23, 23, 23, 23, 23, 24, 24, 24, 24, 24, 24, 25, 25, 25, 25, 25, 25, 25, 26, 26, 26, 26, 26, 26, 26, 26, 27, 27, 27, 27, 27, 27, 27, 27, 27, 27, 28, 28, 28, 28, 28, 28, 28, 28, 28, 28, 29, 29, 29, 29, 29, 29, 29, 29, 29, 29, 29, 29, 30, 30, 30, 30, 30, 30, 30, 30, 30, 30, 30, 30, 30, 30, 31, 31, 31, 31, 31, 31, 31, 31, 31, 31, 31, 31, 31, 31, 31};
__device__ const double ROPE_FREV[32] = {
    0.15915494309189535, 0.11934937021124886, 0.08949940160889101, 0.06711508300522726,
    0.050329212104487035, 0.03774158471741977, 0.0283021958306234, 0.02122365276477766,
    0.015915494309189534, 0.011934937021124886, 0.008949940160889102, 0.006711508300522725,
    0.005032921210448704, 0.003774158471741977, 0.00283021958306234, 0.0021223652764777662,
    0.0015915494309189536, 0.0011934937021124885, 0.0008949940160889102, 0.0006711508300522726,
    0.0005032921210448703, 0.00037741584717419774, 0.00028302195830623395, 0.0002122365276477766,
    0.00015915494309189535, 0.00011934937021124886, 8.949940160889102e-05, 6.711508300522725e-05,
    5.0329212104487035e-05, 3.774158471741978e-05, 2.8302195830623396e-05, 2.122365276477766e-05
};

__device__ __forceinline__ int colmap(int kind, int c) {
    if (kind == 0) return c;
    if (kind == 1) {
        if (c < 2304) return c;
        if (c < 6400) { const int r = c - 2304, h = r >> 7, d = r & 127; const int dd = d < 64 ? d : 64 + 2 * ((d - 64) & 31) + ((d - 64) >> 5);
            return h < 2 ? 2304 + h * 128 + dd : 4096 + (h - 2) * 128 + dd; }
        if (c < 6528) { const int d = c - 6400; return 4096 + 3840 + (d < 64 ? d : 64 + 2 * ((d - 64) & 31) + ((d - 64) >> 5)); }
        if (c < 6560) return 4096 + 3840 + 192 + (c - 6528);
        if (c < 7584) return 2560 + (c - 6560);
        if (c < 8096) return 3584 + (c - 7584);
        const int j = c - 8096; return 4096 + 3840 + 128 + 2 * (j & 31) + (j >> 5);
    }
    if (kind == 2) { const int h = c / 192, d = c - h * 192; if (d < 128) return c; const int j = d - 128; return h * 192 + 128 + 2 * (j & 31) + (j >> 5); }
    if (kind == 3) return (c >> 7) * 256 + (c & 127);
    if (kind == 5) return (c >> 8) * 128 + (c & 127) + ((c & 128) ? 2048 : 0);
    return (c >> 7) * 256 + 128 + (c & 127);
}
constexpr int TT_IN = 32 * 64, TT_UQ = 8 * 24, TT_UKV = 4 * 32, TT_O = 32 * 32, TT_G = 32 * 86, TT_D = 86 * 32;
constexpr int TT_TOTAL = TT_IN + TT_UQ + TT_UKV + TT_O + 2 * TT_G + TT_D;
struct TJob { const float* W; const float* scale; bf16* WT; int K, N, kind, k0, n0; float f8s; };
__device__ __forceinline__ TJob tjob(const Frame& F, int t) {
    TJob j; j.scale = nullptr; j.f8s = 0.f; int nnt;
    if (t < TT_IN) { j.W = F.in[I_WIN]; j.WT = (bf16*)(F.ws + WS_WIN); j.K = 4096; j.N = 8160; j.kind = 1; nnt = 64; }
    else if ((t -= TT_IN) < TT_UQ) { j.W = F.in[I_WUQ]; j.scale = F.in[I_QG]; j.WT = (bf16*)(F.ws + WS_WUQ); j.K = 1024; j.N = 3072; j.kind = 2; j.f8s = 32.0f; nnt = 24; }
    else if ((t -= TT_UQ) < TT_UKV) { j.W = F.in[I_WUKV]; j.scale = F.in[I_KVG]; j.WT = (bf16*)(F.ws + WS_WUKV); j.K = 512; j.N = 4096; j.kind = 5; j.f8s = 16.0f; nnt = 32; }
    else if ((t -= TT_UKV) < TT_O) { j.W = F.in[I_WO]; j.WT = (bf16*)(F.ws + WS_WO); j.K = 4096; j.N = 4096; j.kind = 0; j.f8s = 128.0f; nnt = 32; }
    else if ((t -= TT_O) < TT_G) { j.W = F.in[I_WG]; j.WT = (bf16*)(F.ws + WS_WGU); j.K = 4096; j.N = FF; j.kind = 3; nnt = 86; }
    else if ((t -= TT_G) < TT_G) { j.W = F.in[I_WU]; j.WT = (bf16*)(F.ws + WS_WGU); j.K = 4096; j.N = FF; j.kind = 4; nnt = 86; }
    else { t -= TT_G; j.W = F.in[I_WD]; j.WT = (bf16*)(F.ws + WS_WD); j.K = FF; j.N = 4096; j.kind = 0; nnt = 32; }
    j.k0 = (t / nnt) * 128; j.n0 = (t % nnt) * 128; return j;
}
__device__ __forceinline__ void tr_load(const Frame& F, int t, f32x4 (&ld)[8]) {
    const TJob j = tjob(F, t); const int rsub = F.lane >> 5, c4 = F.lane & 31, n = j.n0 + 4 * c4;
#pragma unroll
    for (int i = 0; i < 8; ++i) { const int k = j.k0 + 16 * F.wave + 2 * i + rsub;
        f32x4 v = (f32x4){0.f, 0.f, 0.f, 0.f};
        if (n < j.N) v = __builtin_nontemporal_load((const f32x4*)(j.W + (size_t)k * j.N + n));
        if (j.scale) v = v * j.scale[k];
        ld[i] = v; }
}
__device__ __forceinline__ void p0_prologue(Frame& F) {
    const int g = blockIdx.x, G = F.G;
    { float* ROPE = (float*)(F.ws + WS_ROPE); const int* pos = (const int*)F.in[I_POS];
      for (int idx = g * 512 + F.tid; idx < M * 32; idx += G * 512) { const int m = idx >> 5, i = idx & 31;
          const double r = (double)pos[m] * ROPE_FREV[i]; const float fr = (float)(r - __builtin_floor(r)) * 2.0f;
          ROPE[2 * idx] = cospif(fr); ROPE[2 * idx + 1] = sinpif(fr); } }
    { v4u* z = (v4u*)((bf16*)(F.ws + WS_WINB) + (size_t)4064 * 4096);
      for (int idx = g * 512 + F.tid; idx < 32 * 4096 / 8; idx += G * 512) z[idx] = (v4u){0u, 0u, 0u, 0u}; }
    {
        LAS float* CACT = (LAS float*)F.lds; LAS float* RED = (LAS float*)(F.lds + 65536);
        for (int idx = F.tid; idx < 4 * 4096; idx += 512) { const float c = F.in[I_C][idx]; CACT[idx] = c / (1.0f + __expf(-c)); }
        __syncthreads();
        for (int it = g; it < 256; it += G) {
            const int ln = F.lane < 48 ? F.lane : 47; const float* wp = F.in[I_WADA] + (size_t)(512 * F.wave) * 24576 + it * 96 + 2 * ln;
            f32x2 acc[4];
#pragma unroll
            for (int b = 0; b < 4; ++b) acc[b] = (f32x2){0.f, 0.f};
            for (int k = 0; k < 512; k += 16) {
                f32x2 wv[16];
#pragma unroll
                for (int i = 0; i < 16; ++i) wv[i] = __builtin_nontemporal_load((const f32x2*)(wp + (size_t)(k + i) * 24576));
#pragma unroll
                for (int i = 0; i < 16; ++i)
#pragma unroll
                    for (int b = 0; b < 4; ++b) acc[b] += wv[i] * CACT[b * 4096 + 512 * F.wave + k + i];
            }
            if (F.lane < 48) {
#pragma unroll
                for (int b = 0; b < 4; ++b) *(LAS f32x2*)(RED + (F.wave * 4 + b) * 96 + 2 * F.lane) = acc[b]; }
            __syncthreads();
            if (F.tid < 384) { const int b = F.tid / 96, c = F.tid % 96; float s = F.in[I_BADA][it * 96 + c];
#pragma unroll
              for (int w = 0; w < 8; ++w) s += RED[(w * 4 + b) * 96 + c];
              ((float*)(F.ws + WS_MOD))[b * 24576 + it * 96 + c] = s; }
            __syncthreads();
        }
    }
    {
        const int tb = (int)((long)TT_TOTAL * g / G), te = (int)((long)TT_TOTAL * (g + 1) / G);
        LAS float* T = (LAS float*)F.lds;
        f32x4 ldA[8], ldB[8];
        if (tb < te) tr_load(F, tb, ldA);
        if (tb + 1 < te) tr_load(F, tb + 1, ldB);
#define TR_STEP(LD, t_) do { \
            { const int rsub = F.lane >> 5, c4 = F.lane & 31; \
              _Pragma("unroll") for (int i = 0; i < 8; ++i) { const int k = 16 * F.wave + 2 * i + rsub; *(LAS f32x4*)(T + 132 * k + ((4 * c4) ^ (4 * ((k >> 3) & 15)))) = LD[i]; } } \
            __syncthreads(); \
            const TJob j = tjob(F, (t_)); \
            if ((t_) + 2 < te) tr_load(F, (t_) + 2, LD); \
            { const int c = F.lane & 15; \
              _Pragma("unroll") for (int q = 0; q < 4; ++q) { const int n = (F.lane >> 4) + 4 * F.wave + 32 * q; const LAS float* s = T + 132 * (8 * c) + (n ^ (4 * c)); \
                  int R_ = (j.n0 + n < j.N) ? colmap(j.kind, j.n0 + n) : 0; const bool f8_ = j.kind == 1 ? R_ < 4096 : j.f8s != 0.f; if (j.kind == 1 && !f8_) R_ -= 4096; \
                  if (f8_) { const float fs = j.kind == 1 ? 64.0f : j.f8s; int w0 = 0, w1 = 0; \
                      w0 = __builtin_amdgcn_cvt_pk_fp8_f32(s[0] * fs, s[132] * fs, w0, false); w0 = __builtin_amdgcn_cvt_pk_fp8_f32(s[2 * 132] * fs, s[3 * 132] * fs, w0, true); \
                      w1 = __builtin_amdgcn_cvt_pk_fp8_f32(s[4 * 132] * fs, s[5 * 132] * fs, w1, false); w1 = __builtin_amdgcn_cvt_pk_fp8_f32(s[6 * 132] * fs, s[7 * 132] * fs, w1, true); \
                      if (j.n0 + n < j.N) *(v2u*)((unsigned char*)j.WT + (size_t)R_ * j.K + j.k0 + 8 * c) = (v2u){(unsigned)w0, (unsigned)w1}; } \
                  else { v4u o; o.x = pk2(s[0], s[132]); o.y = pk2(s[2 * 132], s[3 * 132]); o.z = pk2(s[4 * 132], s[5 * 132]); o.w = pk2(s[6 * 132], s[7 * 132]); \
                  if (j.n0 + n < j.N) *(v4u*)((j.kind == 1 ? (bf16*)(F.ws + WS_WINB) : j.WT) + (size_t)R_ * j.K + j.k0 + 8 * c) = o; } } } \
            __syncthreads(); } while (0)
        for (int t = tb; t < te; t += 2) { TR_STEP(ldA, t); if (t + 1 < te) TR_STEP(ldB, t + 1); }
#undef TR_STEP
    }
}

__device__ __forceinline__ void ln_stats(const f32x4 (&v)[16], float& mean, float& rstd) {
    float s = 0.f;
#pragma unroll
    for (int j = 0; j < 16; ++j) s += (v[j][0] + v[j][1]) + (v[j][2] + v[j][3]);
    mean = wave_sum(s) * (1.0f / D); float q = 0.f;
#pragma unroll
    for (int j = 0; j < 16; ++j) { const f32x4 d = v[j] - mean; q += (d[0] * d[0] + d[1] * d[1]) + (d[2] * d[2] + d[3] * d[3]); }
    rstd = 1.0f / sqrtf(wave_sum(q) * (1.0f / D) + LN_EPS);
}
template <int KIND> __device__ __forceinline__ void row_pass(Frame& F) {
    const float* mod = (const float*)(F.ws + WS_MOD); bf16* U = (bf16*)(F.ws + WS_U);
    LAS float* VA = (LAS float*)F.lds; LAS float* VB = VA + 4096;
    const float* src = KIND == 1 ? F.in[I_X] : (KIND == 6 ? (const float*)(F.ws + WS_Z1) : F.out);
    int cur = -1;
    for (int blk = F.vcu; blk < M / 32; blk += F.G) {
        const int bt = blk >> 6;
        if (KIND == 10 ? cur < 0 : bt != cur) {
            __syncthreads();
            const float* mb = mod + (size_t)bt * 24576; const int c = 8 * F.tid;
#pragma unroll
            for (int e = 0; e < 8; e += 4) { f32x4 va, vb;
                if (KIND == 1) { va = *(const f32x4*)(mb + 4096 + c + e) + 1.0f; vb = *(const f32x4*)(mb + c + e); }
                else if (KIND == 6) { const f32x4 s1 = *(const f32x4*)(mb + 4 * 4096 + c + e) + 1.0f; va = *(const f32x4*)(F.in[I_LN1G] + c + e) * s1; vb = *(const f32x4*)(F.in[I_LN1B] + c + e) * s1 + *(const f32x4*)(mb + 3 * 4096 + c + e); }
                else { va = *(const f32x4*)(F.in[I_LN2G] + c + e); vb = *(const f32x4*)(F.in[I_LN2B] + c + e); }
                *(LAS f32x4*)(VA + c + e) = va; *(LAS f32x4*)(VB + c + e) = vb; }
            __syncthreads(); cur = bt;
        }
#pragma unroll 1
        for (int r = 0; r < 4; ++r) { const int m = blk * 32 + 4 * F.wave + r; const char* rp = (const char*)(src + (size_t)m * D); const unsigned lo = (unsigned)F.lane * 16u;
            f32x4 v[16];
#pragma unroll
            for (int j = 0; j < 16; ++j) v[j] = KIND == 1 ? __builtin_nontemporal_load((const f32x4*)(rp + (lo + 1024u * j))) : *(const f32x4*)(rp + (lo + 1024u * j));
            float mean = 0.f, rstd = 1.f;
            if (KIND != 1) { ln_stats(v, mean, rstd); if (KIND == 6 && F.lane == 0) *(f32x2*)((float*)(F.ws + WS_RS1) + 2 * (size_t)m) = (f32x2){mean, rstd}; }
#pragma unroll
            for (int j = 0; j < 16; ++j) { const f32x4 va = *(const LAS f32x4*)(VA + 4 * F.lane + 256 * j), vb = *(const LAS f32x4*)(VB + 4 * F.lane + 256 * j);
                const f32x4 o = KIND == 1 ? v[j] * va + vb : (v[j] - mean) * rstd * va + vb;
                if (KIND == 10) *(f32x4*)((char*)(F.out + (size_t)m * D) + (lo + 1024u * j)) = o;
                else { v2u w; w.x = pk2(o[0], o[1]); w.y = pk2(o[2], o[3]); *(v2u*)((char*)(U + (size_t)m * D) + ((unsigned)F.lane * 8u + 512u * j)) = w;
                    if (KIND == 1) { int w8 = 0; w8 = __builtin_amdgcn_cvt_pk_fp8_f32(o[0], o[1], w8, false); w8 = __builtin_amdgcn_cvt_pk_fp8_f32(o[2], o[3], w8, true);
                        *(unsigned*)((unsigned char*)(F.ws + WS_U8) + (size_t)m * D + ((unsigned)F.lane * 4u + 256u * j)) = (unsigned)w8; } }
                if ((j & 3) == 3) __builtin_amdgcn_sched_barrier(0); } }
    }
    __syncthreads();
}
__device__ __forceinline__ void p8_hpass(Frame& F) {
    const bf16* GU = (const bf16*)(F.ws + WS_GU); bf16* H = (bf16*)(F.ws + WS_H);
    const float* cw = F.in[I_CW]; const float* cb = F.in[I_CB];
    constexpr int NCG = FF / 8, RB = 32, NITEM = NCG * (M / RB);
    for (int it = (int)blockIdx.x * 512 + F.tid; it < NITEM; it += F.G * 512) {
        const int cg = it % NCG, rb = it / NCG, c = cg * 8, m0 = rb * RB, t0 = m0 & (SEQ - 1);
        const size_t gcol = (size_t)(c >> 7) * 256 + (c & 127);
        float w0[8], w1[8], w2[8], bs[8];
#pragma unroll
        for (int e = 0; e < 8; e += 4) { const f32x4 a = *(const f32x4*)(cw + c + e), b = *(const f32x4*)(cw + FF + c + e), d = *(const f32x4*)(cw + 2 * FF + c + e), s = *(const f32x4*)(cb + c + e);
#pragma unroll
            for (int k = 0; k < 4; ++k) { w0[e + k] = a[k]; w1[e + k] = b[k]; w2[e + k] = d[k]; bs[e + k] = s[k]; } }
        v4u g1 = (v4u){0u, 0u, 0u, 0u}, g0 = (v4u){0u, 0u, 0u, 0u};
        const bf16* gp = GU + (size_t)m0 * NGU + gcol; bf16* hp = H + (size_t)m0 * FF + c;
        if (t0 >= 2) { g1 = *(const v4u*)(gp - NGU); g0 = *(const v4u*)(gp - 2 * NGU); }
#pragma unroll 1
        for (int r = 0; r < RB; r += 2) {
            v4u g2[2], up[2];
#pragma unroll
            for (int q = 0; q < 2; ++q) { g2[q] = __builtin_nontemporal_load((const v4u*)(gp + q * NGU)); up[q] = __builtin_nontemporal_load((const v4u*)(gp + q * NGU + 128)); }
#pragma unroll
            for (int q = 0; q < 2; ++q) { float o[8];
#pragma unroll
                for (int e = 0; e < 8; ++e) { const unsigned x2 = g2[q][e >> 1], x1 = g1[e >> 1], x0 = g0[e >> 1], xu = up[q][e >> 1];
                    const float a2 = (e & 1) ? bfhi(x2) : bflo(x2), a1 = (e & 1) ? bfhi(x1) : bflo(x1), a0 = (e & 1) ? bfhi(x0) : bflo(x0), uu = (e & 1) ? bfhi(xu) : bflo(xu);
                    const float gg = bs[e] + w0[e] * a0 + w1[e] * a1 + w2[e] * a2;
                    o[e] = gg / (1.0f + __expf(-gg)) * uu; }
                v4u w; w.x = pk2(o[0], o[1]); w.y = pk2(o[2], o[3]); w.z = pk2(o[4], o[5]); w.w = pk2(o[6], o[7]);
                *(v4u*)(hp + q * FF) = w;
                g0 = g1; g1 = g2[q]; }
            gp += 2 * NGU; hp += 2 * FF;
        }
    }
}


namespace att {
typedef float f32x16 __attribute__((ext_vector_type(16)));
typedef short bf16x8 __attribute__((ext_vector_type(8)));
constexpr int VP = 144;
constexpr int KREG = 32768, BUF_STRIDE = 57344;
constexpr int X_OFF = 2 * BUF_STRIDE;
__device__ __forceinline__ int swap23(int r) { return (r & ~12) | ((r & 4) << 1) | ((r & 8) >> 1); }
__device__ __forceinline__ unsigned sortable(float f) { const unsigned u = __builtin_bit_cast(unsigned, f); return (u & 0x80000000u) ? ~u : (u | 0x80000000u); }

template <int OFF> __device__ __forceinline__ void lds_rd128(bf16x8& d, unsigned addr) { asm volatile("ds_read_b128 %0, %1 offset:%2" : "=v"(d) : "v"(addr), "n"(OFF)); }
template <int N> __device__ __forceinline__ void lgkm_wait(bf16x8& d) { asm volatile("s_waitcnt lgkmcnt(%1)" : "+v"(d) : "n"(N)); }
struct Stg {
    const unsigned char* base;
    unsigned koff[4], kstep[4], voff[3];
    unsigned ldsk, ldsv;
    int nk, nv;
    template <int E> __device__ __forceinline__ void k() { if (E < nk) __builtin_amdgcn_global_load_lds((const unsigned*)(base + koff[E]), (LAS unsigned*)(unsigned long long)(ldsk + E * 1024), 16, 0, 0); }
    template <int E> __device__ __forceinline__ void v() { if (E < nv) __builtin_amdgcn_global_load_lds((const unsigned*)(base + voff[E]), (LAS unsigned*)(unsigned long long)(ldsv + E * 1024), 16, 0, 0); }
};
template <int N, int KSTEPS, int KP, int PF> struct SStep {
    static __device__ __forceinline__ void run(bf16x8 (&fr)[PF], f32x16 (&sa)[2], const bf16x8 (&qf)[KSTEPS], unsigned base, Stg& st, bool more) {
        constexpr int NMM = 2 * KSTEPS, kb = N / KSTEPS, s = N % KSTEPS, GAP = NMM / 4;
        lgkm_wait<((NMM - N < PF) ? NMM - N : PF) - 1>(fr[N % PF]);
        sa[kb] = __builtin_amdgcn_mfma_f32_32x32x16_bf16(fr[N % PF], qf[s], sa[kb], 0, 0, 0);
        if constexpr (N + PF < NMM) lds_rd128<32 * ((N + PF) / KSTEPS) * KP + 32 * ((N + PF) % KSTEPS)>(fr[N % PF], base);
        if constexpr (N % 2 == 1 && N < 8) st.template k<N / 2>();
        if constexpr (N % 2 == 1 && N >= 8 && N < 14) st.template v<(N - 8) / 2>();
        if constexpr (N + 1 < NMM) SStep<N + 1, KSTEPS, KP, PF>::run(fr, sa, qf, base, st, more);
    }
};
template <int N, int PF> struct PVStep {
    static __device__ __forceinline__ void run(bf16x8 (&fr)[PF], f32x16 (&o)[4], const bf16x8 (&pf)[4], unsigned base, Stg& st, bool more) {
        constexpr int d = N / 4, ks = N % 4;
        lgkm_wait<((16 - N < PF) ? 16 - N : PF) - 1>(fr[N % PF]);
        o[d] = __builtin_amdgcn_mfma_f32_32x32x16_bf16(fr[N % PF], pf[ks], o[d], 0, 0, 0);
        if constexpr (N + PF < 16) lds_rd128<32 * ((N + PF) / 4) * VP + 32 * ((N + PF) % 4)>(fr[N % PF], base);
        if constexpr (N + 1 < 16) PVStep<N + 1, PF>::run(fr, o, pf, base, st, more);
    }
};
template <int N, int KSTEPS, int KP, int PF> struct SPre { static __device__ __forceinline__ void run(bf16x8 (&fr)[PF], unsigned base) {
    lds_rd128<32 * (N / KSTEPS) * KP + 32 * (N % KSTEPS)>(fr[N], base); if constexpr (N + 1 < PF) SPre<N + 1, KSTEPS, KP, PF>::run(fr, base); } };
template <int N, int PF> struct PVPre { static __device__ __forceinline__ void run(bf16x8 (&fr)[PF], unsigned base) {
    lds_rd128<32 * (N / 4) * VP + 32 * (N % 4)>(fr[N], base); if constexpr (N + 1 < PF) PVPre<N + 1, PF>::run(fr, base); } };
__device__ __forceinline__ void dsa_topk(Frame& F, int b, int q0, int slot) {
    const int tid = F.tid, lane = F.lane, w = F.wave; LAS unsigned char* lds = F.lds; const size_t brow = (size_t)b * SEQ;
    LAS unsigned* bmp = (LAS unsigned*)(lds + X_OFF) + slot * 1024;
    LAS float* rb2 = (LAS float*)(lds + X_OFF + 8192 + 1024);
    {
        const float* SC = (const float*)(F.ws + WS_SC);
        for (int idx = tid; idx < 2048; idx += 512) rb2[idx] = F.in[I_RELB][(int)BUCKET_TAB[idx >> 4] * 16 + (idx & 15)] * 1.4426950408889634f;
        for (int tt = 0; tt < 2; ++tt) {
            const int t = q0 + 2 * w + tt, n = t + 1; const float* row = SC + (brow + t) * SEQ;
            unsigned u[32];
#pragma unroll
            for (int j = 0; j < 32; ++j) { const int s = 64 * j + lane; u[j] = 0u; if (64 * j < n) { if (s < n) u[j] = sortable(row[s]); } }
            unsigned T = 1u;
            bool exact = true;
            if (n > 256) {
                T = 0u; exact = false;
                for (int bit = 31; bit >= 0; --bit) {
                    const unsigned cand = T | (1u << bit); int c = 0;
#pragma unroll
                    for (int j = 0; j < 32; ++j) c += __popcll(__ballot(u[j] >= cand));
                    if (c >= 256) T = cand;
                    if (c == 256) { exact = true; break; }
                }
            }
            if (exact) {
#pragma unroll
                for (int j = 0; j < 32; ++j) { const unsigned long long mk = __ballot(u[j] >= T); if (lane < 2) bmp[(2 * w + tt) * 64 + 2 * j + lane] = (unsigned)(mk >> (32 * lane)); }
            } else {
                int need = 256;
#pragma unroll
                for (int j = 0; j < 32; ++j) need -= __popcll(__ballot(u[j] > T));
#pragma unroll
                for (int j = 0; j < 32; ++j) { unsigned long long mk = __ballot(u[j] > T), eq = __ballot(u[j] == T);
                    while (eq != 0ull && need > 0) { const unsigned long long low = eq & (~eq + 1ull); mk |= low; eq ^= low; --need; }
                    if (lane < 2) bmp[(2 * w + tt) * 64 + 2 * j + lane] = (unsigned)(mk >> (32 * lane)); }
            }
        }
    }
}
template <int MODE> __device__ __forceinline__ void attn_unit(Frame& F, int b, int h, int q0, int slot) {
    constexpr int KD = MODE == 0 ? 192 : 128, KCH = KD / 8, KP = (KCH + 1) * 16, KSTEPS = KD / 16, KTILE = 64 * KP;
    constexpr int KROWCH = KCH + 1;
    static_assert(64 * KP <= KREG && KREG + 128 * VP <= BUF_STRIDE, "tile buffers");
    const int tid = F.tid, lane = F.lane, w = F.wave, l32 = lane & 31, hh = lane >> 5;
    LAS unsigned char* lds = F.lds;
    unsigned long long wsl_ = (unsigned long long)F.ws; asm volatile("" : "+s"(wsl_));
    unsigned char* const WSP = (unsigned char*)wsl_;
    unsigned long long posl_ = (unsigned long long)F.in[I_POS]; asm volatile("" : "+s"(posl_)); const int* const POSP = (const int*)posl_;
    const bf16* QG; const bf16* KG; const bf16* K2G = nullptr; const bf16* VTG; bf16* MIX = (bf16*)(WSP + WS_MIX);
    if (MODE == 0) { QG = (const bf16*)(WSP + WS_QB); KG = (const bf16*)(WSP + WS_KN); K2G = (const bf16*)(WSP + WS_IKX); VTG = (const bf16*)(WSP + WS_VT) + (size_t)(h * 128) * M; }
    else { QG = (const bf16*)(WSP + WS_AQ); KG = (const bf16*)(WSP + WS_AKV); VTG = (const bf16*)(WSP + WS_VTA); }
    const size_t brow = (size_t)b * SEQ;
    int tq, qhead;
    if (MODE == 0) { tq = q0 + 32 * w + l32; qhead = h; } else { tq = q0 + 2 * w + (l32 >> 4); qhead = l32 & 15; }
    const int nt = MODE == 0 ? (q0 + 256) / 64 : (q0 + 16 + 63) / 64;
    LAS unsigned* bmp = (LAS unsigned*)(lds + X_OFF) + slot * 1024;
    LAS int* posk = (LAS int*)(lds + X_OFF + 8192);
    LAS int* farf = (LAS int*)(lds + X_OFF + 8192 + 512);
    LAS float* rb2 = (LAS float*)(lds + X_OFF + 8192 + 1024);
    bf16x8 qf[KSTEPS];
    int posq = 0, minposq = 0; float bias_far = 0.f;
    if (MODE == 1) { const int* pos = POSP; posq = pos[brow + tq]; const int p0 = pos[brow + q0 + 2 * w], p1 = pos[brow + q0 + 2 * w + 1]; minposq = p0 < p1 ? p0 : p1; }
    Stg st; st.base = WSP;
    { constexpr int NKI = (64 * KROWCH + 63) / 64, NVI = 18;
      int ln_ = lane; asm volatile("" : "+v"(ln_));
      st.nk = NKI - 4 * w; st.nk = st.nk < 0 ? 0 : (st.nk > 4 ? 4 : st.nk); st.nv = NVI - 3 * w; st.nv = st.nv < 0 ? 0 : (st.nv > 3 ? 3 : st.nv);
#pragma unroll
      for (int e = 0; e < 4; ++e) { const int q = (4 * w + e) * 64 + ln_, rho = q / KROWCH, c = q % KROWCH; const bool ok = rho < 64 && c < KCH; const unsigned kr = (unsigned)swap23(rho & 63);
          if (MODE == 0) { const bool two = c >= 16;
              st.koff[e] = !ok ? (unsigned)WS_KN : (two ? (unsigned)WS_IKX + ((unsigned)(brow + kr) * 256u + 128u + 8u * (c - 16)) * 2u : (unsigned)WS_KN + ((unsigned)(brow + kr) * 2048u + (unsigned)h * 128u + 8u * c) * 2u);
              st.kstep[e] = !ok ? 0u : (two ? 64u * 512u : 64u * 4096u); }
          else { st.koff[e] = !ok ? (unsigned)WS_AKV : (unsigned)WS_AKV + ((unsigned)(brow + kr) * 256u + 8u * c) * 2u; st.kstep[e] = !ok ? 0u : 64u * 512u; } }
#pragma unroll
      for (int e = 0; e < 3; ++e) { const int q = (3 * w + e) * 64 + ln_, d = q / 9, c = q % 9; const bool ok = d < 128 && c < 8;
          const unsigned vb = MODE == 0 ? (unsigned)WS_VT + (unsigned)(h * 128) * (unsigned)(M * 2) : (unsigned)WS_VTA;
          st.voff[e] = !ok ? vb : vb + (unsigned)d * (unsigned)(M * 2) + ((unsigned)brow + 8u * c) * 2u; } }
#define ATT_ADVANCE() do { _Pragma("unroll") for (int e = 0; e < 4; ++e) st.koff[e] += st.kstep[e]; _Pragma("unroll") for (int e = 0; e < 3; ++e) st.voff[e] += 128u; } while (0)
#define ATT_TARGET(i_) do { const unsigned tb_ = (unsigned)(unsigned long long)(lds + ((i_) & 1) * BUF_STRIDE); st.ldsk = tb_ + 4 * w * 1024; st.ldsv = tb_ + KREG + 3 * w * 1024; } while (0)
#define ATT_POS(i_) do { if (MODE == 1 && tid < 64) { const int* pos_ = POSP + brow + 64 * (i_); const int pk = pos_[tid]; posk[((i_) & 1) * 64 + tid] = pk; int mx = pk; \
            _Pragma("unroll") for (int o_ = 1; o_ < 64; o_ <<= 1) { const int y = __shfl_xor(mx, o_); mx = mx > y ? mx : y; } \
            if (tid == 0) farf[(i_) & 1] = mx; } } while (0)
    f32x16 o[4];
#pragma unroll
    for (int d = 0; d < 4; ++d)
#pragma unroll
        for (int r = 0; r < 16; ++r) o[d][r] = 0.f;
    float ninit = 0.f, lrun = 0.f;
    constexpr float THR = 8.0f;
    __syncthreads();
    if (MODE == 1) bias_far = rb2[127 * 16 + qhead];
    { const bf16* qp = MODE == 0 ? QG + (brow + tq) * 3072 + qhead * 192 + 8 * hh : QG + (brow + tq) * 2048 + qhead * 128 + 8 * hh;
#pragma unroll
      for (int s = 0; s < KSTEPS; ++s) qf[s] = *(const bf16x8*)(qp + 16 * s); }
    ATT_TARGET(0); st.k<0>(); st.k<1>(); st.k<2>(); st.k<3>(); st.v<0>(); st.v<1>(); st.v<2>(); ATT_POS(0); ATT_ADVANCE();
    asm volatile("s_waitcnt vmcnt(0)" ::: "memory"); __syncthreads();
    const int tmin = MODE == 0 ? q0 + 32 * w : q0;
    for (int i = 0; i < nt; ++i) {
        const bool more = i + 1 < nt;
        ATT_TARGET(i + 1); if (more) ATT_POS(i + 1);
        const int key0 = 64 * i;
        {
            const LAS unsigned char* kbuf = lds + (i & 1) * BUF_STRIDE; const LAS unsigned char* vbuf = kbuf + KREG;
            constexpr int PF = MODE == 0 ? 4 : 3;
            const unsigned kbase = (unsigned)(unsigned long long)(kbuf + l32 * KP + hh * 16), vbase = (unsigned)(unsigned long long)(vbuf + l32 * VP + hh * 16);
            f32x16 sa[2]; bf16x8 fr[PF];
            SPre<0, KSTEPS, KP, PF>::run(fr, kbase);
            if (MODE == 0) {
#pragma unroll
                for (int kb = 0; kb < 2; ++kb)
#pragma unroll
                    for (int r = 0; r < 16; ++r) sa[kb][r] = ninit;
            } else {
                const bool far_ = __builtin_amdgcn_readfirstlane(minposq - farf[i & 1]) >= 128;
#pragma unroll
                for (int kb = 0; kb < 2; ++kb)
#pragma unroll
                    for (int g = 0; g < 2; ++g) { float bia[8];
#pragma unroll
                        for (int e = 0; e < 8; ++e) bia[e] = bias_far;
                        if (!far_) { const LAS int* pp = posk + (i & 1) * 64 + 32 * kb + 16 * g + 8 * hh;
#pragma unroll
                            for (int e = 0; e < 8; ++e) { int rel = posq - pp[e]; rel = rel < 0 ? 0 : (rel > 127 ? 127 : rel); bia[e] = rb2[rel * 16 + qhead]; } }
#pragma unroll
                        for (int e = 0; e < 8; ++e) sa[kb][8 * g + e] = bia[e] + ninit;
                        __builtin_amdgcn_sched_barrier(0); }
            }
            SStep<0, KSTEPS, KP, PF>::run(fr, sa, qf, kbase, st, more);
            if (MODE == 0) {
                if (key0 + 63 > tmin) {
#pragma unroll
                    for (int kb = 0; kb < 2; ++kb)
#pragma unroll
                        for (int r = 0; r < 16; ++r) { const int key = key0 + 32 * kb + 16 * (r >> 3) + 8 * hh + (r & 7); const float xv = sa[kb][r]; sa[kb][r] = key > tq ? -__builtin_inff() : xv; }
                }
            } else {
                const v2u wds = *(const LAS v2u*)(bmp + (2 * w + (l32 >> 4)) * 64 + 2 * i);
#pragma unroll
                for (int kb = 0; kb < 2; ++kb) { const int wdh = (int)((kb == 0 ? wds.x : wds.y) >> (8 * hh));
#pragma unroll
                    for (int r = 0; r < 16; ++r) { const int mk = __builtin_amdgcn_sbfe(wdh, 16 * (r >> 3) + (r & 7), 1); const float xv = sa[kb][r];
                        sa[kb][r] = __builtin_bit_cast(float, (__builtin_bit_cast(int, xv) & mk) | ((int)0xff800000 & ~mk)); } }
            }
            float mloc = sa[0][0];
#pragma unroll
            for (int kb = 0; kb < 2; ++kb)
#pragma unroll
                for (int r = 0; r < 16; ++r) mloc = fmaxf(mloc, sa[kb][r]);
            mloc = fmaxf(mloc, __shfl_xor(mloc, 32));
            if (i == 0 || __any(mloc > THR)) {
                const float delta = i == 0 ? (mloc > -1.0e30f ? mloc : 0.f) : fmaxf(mloc, 0.f), alpha = __builtin_amdgcn_exp2f(-delta);
                ninit -= delta; lrun *= alpha;
#pragma unroll
                for (int kb = 0; kb < 2; ++kb)
#pragma unroll
                    for (int r = 0; r < 16; ++r) sa[kb][r] -= delta;
#pragma unroll
                for (int d = 0; d < 4; ++d)
#pragma unroll
                    for (int r = 0; r < 16; ++r) o[d][r] *= alpha;
            }
            float psum = 0.f;
#pragma unroll
            for (int kb = 0; kb < 2; ++kb)
#pragma unroll
                for (int r = 0; r < 16; ++r) { const float p = __builtin_amdgcn_exp2f(sa[kb][r]); sa[kb][r] = p; psum += p; }
            lrun += psum;
            bf16x8 pf[4];
#pragma unroll
            for (int ks = 0; ks < 4; ++ks) { v4u pk;
#pragma unroll
                for (int e = 0; e < 4; ++e) pk[e] = pg8::cvt_pk_bf16(sa[ks >> 1][8 * (ks & 1) + 2 * e], sa[ks >> 1][8 * (ks & 1) + 2 * e + 1]);
                pf[ks] = __builtin_bit_cast(bf16x8, pk); }
            PVPre<0, PF>::run(fr, vbase);
            PVStep<0, PF>::run(fr, o, pf, vbase, st, more);
        }
        ATT_ADVANCE();
        asm volatile("s_waitcnt vmcnt(0)" ::: "memory"); __syncthreads();
    }
    { const float lt = lrun + __shfl_xor(lrun, 32), inv = 16.0f / lt;
      int tq2 = tq; asm volatile("" : "+v"(tq2));
      const unsigned oo = (unsigned)(b * SEQ + tq2) * 4096u + (MODE == 0 ? 2048u + (unsigned)h * 128u : (unsigned)qhead * 128u);
      unsigned char* op = (unsigned char*)MIX + oo;
#pragma unroll
      for (int d = 0; d < 4; ++d)
#pragma unroll
          for (int g = 0; g < 4; ++g) { int wv = 0; wv = __builtin_amdgcn_cvt_pk_fp8_f32(o[d][4 * g] * inv, o[d][4 * g + 1] * inv, wv, false); wv = __builtin_amdgcn_cvt_pk_fp8_f32(o[d][4 * g + 2] * inv, o[d][4 * g + 3] * inv, wv, true);
              *(unsigned*)(op + 32 * d + 8 * g + 4 * hh) = (unsigned)wv; } }
}
#undef ATT_ADVANCE
#undef ATT_TARGET
#undef ATT_POS
}

__device__ __forceinline__ void indexer_unit(Frame& F, int b, int t0) {
    constexpr int KP = 272, KTILE = 64 * KP;
    const int tid = F.tid, lane = F.lane, w = F.wave, l32 = lane & 31, hh = lane >> 5;
    LAS unsigned char* lds = F.lds;
    const bf16* IQ = (const bf16*)(F.ws + WS_IQ); const bf16* IKX = (const bf16*)(F.ws + WS_IKX); const float* IW = (const float*)(F.ws + WS_IW); float* SC = (float*)(F.ws + WS_SC);
    const size_t brow = (size_t)b * SEQ, m0 = brow + t0 + 2 * w;
    att::bf16x8 af[2][8]; float wt[2][16];
#pragma unroll
    for (int tt = 0; tt < 2; ++tt) {
#pragma unroll
        for (int s = 0; s < 8; ++s) af[tt][s] = *(const att::bf16x8*)(IQ + (m0 + tt) * 4096 + l32 * 128 + 16 * s + 8 * hh);
#pragma unroll
        for (int g = 0; g < 4; ++g) { const f32x4 v = *(const f32x4*)(IW + (m0 + tt) * 32 + 8 * g + 4 * hh); wt[tt][4 * g] = v[0]; wt[tt][4 * g + 1] = v[1]; wt[tt][4 * g + 2] = v[2]; wt[tt][4 * g + 3] = v[3]; }
    }
    const int nt = (t0 + 16 + 63) / 64;
    v4u st[2];
#define IDX_LOAD(i_) do { _Pragma("unroll") for (int e = 0; e < 2; ++e) { const int q = tid + 512 * e, rho = q >> 4, c = q & 15; st[e] = *(const v4u*)(IKX + (brow + 64 * (i_) + rho) * 256 + 8 * c); } } while (0)
#define IDX_STORE(i_) do { _Pragma("unroll") for (int e = 0; e < 2; ++e) { const int q = tid + 512 * e, rho = q >> 4, c = q & 15; *(LAS v4u*)(lds + ((i_) & 1) * KTILE + rho * KP + c * 16) = st[e]; } } while (0)
    __syncthreads();
    IDX_LOAD(0); IDX_STORE(0);
    __syncthreads();
    for (int i = 0; i < nt; ++i) {
        if (i + 1 < nt) IDX_LOAD(i + 1);
        const LAS unsigned char* kbuf = lds + (i & 1) * KTILE;
#pragma unroll
        for (int kb = 0; kb < 2; ++kb) {
            att::bf16x8 bfr[8];
#pragma unroll
            for (int s = 0; s < 8; ++s) bfr[s] = *(const LAS att::bf16x8*)(kbuf + (32 * kb + l32) * KP + (2 * s + hh) * 16);
            float sc[2];
#pragma unroll
            for (int tt = 0; tt < 2; ++tt) {
                att::f32x16 acc;
#pragma unroll
                for (int r = 0; r < 16; ++r) acc[r] = 0.f;
#pragma unroll
                for (int s = 0; s < 8; ++s) acc = __builtin_amdgcn_mfma_f32_32x32x16_bf16(af[tt][s], bfr[s], acc, 0, 0, 0);
                float x = 0.f;
#pragma unroll
                for (int r = 0; r < 16; ++r) x += wt[tt][r] * fmaxf(acc[r], 0.f);
                sc[tt] = x + __shfl_xor(x, 32);
            }
            SC[(m0 + hh) * SEQ + 64 * i + 32 * kb + l32] = hh ? sc[1] : sc[0];
        }
        if (i + 1 < nt) IDX_STORE(i + 1);
        __syncthreads();
    }
#undef IDX_LOAD
#undef IDX_STORE
}
__device__ __forceinline__ void av_transpose(Frame& F, int tile) {
    const bf16* AKV = (const bf16*)(F.ws + WS_AKV); bf16* VTA = (bf16*)(F.ws + WS_VTA);
    LAS unsigned short* T = (LAS unsigned short*)F.lds;
    __syncthreads();
#pragma unroll
    for (int e = 0; e < 2; ++e) { const int tok = F.tid & 63, c = (F.tid >> 6) + 8 * e; const v4u v = *(const v4u*)(AKV + (size_t)(64 * tile + tok) * 256 + 128 + 8 * c);
#pragma unroll
        for (int k = 0; k < 4; ++k) { T[(8 * c + 2 * k) * 72 + tok] = (unsigned short)(v[k] & 0xffffu); T[(8 * c + 2 * k + 1) * 72 + tok] = (unsigned short)(v[k] >> 16); } }
    __syncthreads();
    { const int d = F.tid >> 2, part = F.tid & 3; const LAS v4u* s = (const LAS v4u*)(T + d * 72 + 16 * part);
      v4u* dst = (v4u*)(VTA + (size_t)d * M + 64 * tile + 16 * part); dst[0] = s[0]; dst[1] = s[1]; }
    __syncthreads();
}

struct Args { const float* in[21]; float* out; unsigned char* ws; int ph_lo, ph_hi; };
__global__ void __launch_bounds__(NWAVES * 64, 2) skel_fwd(Args args) {
    extern __shared__ __attribute__((aligned(16))) unsigned char lds[];
    Frame F;
    F.lds = (LAS unsigned char*)lds;
    F.MISC = (volatile LAS unsigned*)(F.lds + MISC_OFF);
    F.tid = threadIdx.x; F.lane = F.tid & 63; F.wave = __builtin_amdgcn_readfirstlane(F.tid >> 6);
    F.G = gridDim.x; { const int bx = blockIdx.x; F.vcu = (F.G % 8 == 0) ? (bx % 8) * (F.G / 8) + bx / 8 : bx; }
    F.ws = args.ws; F.ctl = (gu32*)(args.ws + WS_CTL); F.out = args.out;
#pragma unroll
    for (int i = 0; i < 21; ++i) F.in[i] = args.in[i];
    for (int u = F.tid; u < (LDS_BYTES - LDSCTL_OFF) / 4; u += NWAVES * 64) ((LAS unsigned*)(F.lds + LDSCTL_OFF))[u] = 0u;
    __syncthreads();
    XcdBarrier bar; bar.bar = (unsigned*)(F.ctl + CW_BAR); bar.x = 0; bar.st = nullptr;
    const int lo = args.ph_lo, hi = args.ph_hi;
    if (hi - lo > 1) bar = xcd_barrier_post((unsigned*)(F.ctl + CW_BAR), F.MISC + 8);
#define IN(k) (lo <= (k) && (k) < hi)
#define SEAM(k) do { if (IN(k) && IN((k) + 1)) xcd_barrier(bar); } while (0)
    unsigned char* ws = args.ws;

    if (IN(0)) { p0_prologue(F); SEAM(0); }
    if (IN(1)) { row_pass<1>(F); SEAM(1); }
    if (IN(2)) {
        { pg8::Gemm g{(const bf16*)(ws + WS_U8), (const bf16*)(ws + WS_WIN), D / 2, D / 2}; pg8::StaticOrder S; S.init(M, 4096, F.G, (int)blockIdx.x);
          pg8::EpiProj<true> E{(bf16*)(ws + WS_AQ), (bf16*)(ws + WS_AKV), (bf16*)(ws + WS_IQ), (bf16*)(ws + WS_IKX), (bf16*)(ws + WS_QL), (bf16*)(ws + WS_KVL),
                       (float*)(ws + WS_IW), (float*)(ws + WS_RSQQ), (float*)(ws + WS_RSQK), (const float*)(ws + WS_ROPE)};
          pg8::gemm_phase<pg8::EpiProj<true>, pg8::StaticOrder, true, true, true>(F.lds + RING_OFF, g, S, E); }
        { pg8::Gemm g{(const bf16*)(ws + WS_U), (const bf16*)(ws + WS_WINB), D, D}; pg8::StaticOrder S; S.init(M, 4096, F.G, (int)blockIdx.x);
          pg8::EpiProj<false> E{(bf16*)(ws + WS_AQ), (bf16*)(ws + WS_AKV), (bf16*)(ws + WS_IQ), (bf16*)(ws + WS_IKX), (bf16*)(ws + WS_QL), (bf16*)(ws + WS_KVL),
                       (float*)(ws + WS_IW), (float*)(ws + WS_RSQQ), (float*)(ws + WS_RSQK), (const float*)(ws + WS_ROPE)};
          pg8::gemm_phase<pg8::EpiProj<false>, pg8::StaticOrder, true, true>(F.lds + RING_OFF, g, S, E); }
        SEAM(2);
    }
    if (IN(3)) {
        { pg8::Gemm g{(const bf16*)(ws + WS_QL), (const bf16*)(ws + WS_WUQ), 512, 512}; pg8::StaticOrder S; S.init(M, 3072, F.G, (int)blockIdx.x);
          pg8::EpiUp<true> E{(bf16*)(ws + WS_QB), 3072, (const float*)(ws + WS_RSQQ), (const float*)(ws + WS_ROPE)};
          pg8::gemm_phase<pg8::EpiUp<true>, pg8::StaticOrder, true, true, true>(F.lds + RING_OFF, g, S, E); }
        { pg8::Gemm g{(const bf16*)(ws + WS_KVL), (const bf16*)(ws + WS_WUKV), 256, 256}; pg8::StaticOrder S; S.init(M, 2048, F.G, (int)blockIdx.x);
          pg8::EpiUp<false> E{(bf16*)(ws + WS_KN), 2048, (const float*)(ws + WS_RSQK), nullptr};
          pg8::gemm_phase<pg8::EpiUp<false>, pg8::StaticOrder, true, true, true>(F.lds + RING_OFF, g, S, E); }
        { pg8::Gemm g{(const bf16*)(ws + WS_WUKV) + (size_t)2048 * 256, (const bf16*)(ws + WS_KVL), 256, 256}; pg8::StaticOrder S; S.init(2048, M, F.G, (int)blockIdx.x);
          pg8::EpiVT E{(bf16*)(ws + WS_VT), (const float*)(ws + WS_RSQK)};
          pg8::gemm_phase<pg8::EpiVT, pg8::StaticOrder, true, true, true>(F.lds + RING_OFF, g, S, E); }
        __syncthreads();
        if (blockIdx.x < 128) av_transpose(F, (int)blockIdx.x);
        for (int P = F.vcu; P < 256; P += F.G)     { const int b = P >> 6, j = P & 63; for (int k = 0; k < 2; ++k) indexer_unit(F, b, 16 * (k ? 127 - j : j)); }
        SEAM(3);
    }
    if (IN(4)) {
        for (int P = F.vcu; P < 256; P += F.G)     { const int b = P >> 6, h = (P >> 2) & 15, j = P & 3; for (int k = 0; k < 2; ++k) att::attn_unit<0>(F, b, h, 256 * (k ? 7 - j : j), 0); }
        __syncthreads();
        for (int P = F.vcu; P < 256; P += F.G)     { const int b = P >> 6, j = P & 63;
            __syncthreads();
            for (int k = 0; k < 2; ++k) att::dsa_topk(F, b, 16 * (k ? 127 - j : j), k);
            for (int k = 0; k < 2; ++k) att::attn_unit<1>(F, b, 0, 16 * (k ? 127 - j : j), k); }
        SEAM(4);
    }
    if (IN(5)) {
        pg8::Gemm g{(const bf16*)(ws + WS_MIX), (const bf16*)(ws + WS_WO), D / 2, D / 2};     pg8::StaticOrder S; S.init(M, D, F.G, (int)blockIdx.x);
        pg8::EpiZ<false, 11> E{F.in[I_X], (float*)(ws + WS_Z1), (const float*)(ws + WS_MOD) + 2 * 4096, nullptr, nullptr, nullptr};
        pg8::gemm_phase<pg8::EpiZ<false, 11>, pg8::StaticOrder, true, true, true>(F.lds + RING_OFF, g, S, E);
        SEAM(5);
    }
    if (IN(6)) { row_pass<6>(F); SEAM(6); }
    if (IN(7)) {
        pg8::Gemm g{(const bf16*)(ws + WS_U), (const bf16*)(ws + WS_WGU), D, D}; pg8::StaticOrder S; S.init(M, NGU, F.G, (int)blockIdx.x);
        pg8::EpiPlain E{(bf16*)(ws + WS_GU), NGU};
        pg8::gemm_phase<pg8::EpiPlain, pg8::StaticOrder, true, true>(F.lds + RING_OFF, g, S, E);
        SEAM(7);
    }
    if (IN(8)) { p8_hpass(F); SEAM(8); }
    if (IN(9)) {
        pg8::Gemm g{(const bf16*)(ws + WS_H), (const bf16*)(ws + WS_WD), FF, FF}; pg8::StaticOrder S; S.init(M, D, F.G, (int)blockIdx.x);
        pg8::EpiZ<true, 0> E{(const float*)(ws + WS_Z1), F.out, (const float*)(ws + WS_MOD) + 5 * 4096, (const float*)(ws + WS_RS1), F.in[I_LN1G], F.in[I_LN1B]};
        pg8::gemm_phase<pg8::EpiZ<true, 0>, pg8::StaticOrder, true, true>(F.lds + RING_OFF, g, S, E);
        SEAM(9);
    }
    if (IN(10)) { row_pass<10>(F); }
#undef IN
#undef SEAM
}

extern "C" void kernel_launch(void* const* d_in, const int* in_sizes, int n_in, void* d_out, int out_size, void* d_ws, size_t ws_size, hipStream_t stream) {
    static int grid = 0;
    if (grid == 0) {
        if (n_in != 21 || in_sizes[0] != M * D || out_size != M * D || ws_size < WS_END) { fprintf(stderr, "kernel_launch: unexpected shapes (n_in %d, in0 %d, out %d, ws %zu); nothing launched\n", n_in, n_in > 0 ? in_sizes[0] : -1, out_size, ws_size); grid = -1; return; }
        int dev = 0, cus = 0, per_cu = 0;
        if (hipGetDevice(&dev) != hipSuccess || hipDeviceGetAttribute(&cus, hipDeviceAttributeMultiprocessorCount, dev) != hipSuccess) { grid = -1; return; }
        if (hipFuncSetAttribute((const void*)skel_fwd, hipFuncAttributeMaxDynamicSharedMemorySize, LDS_BYTES) != hipSuccess) { fprintf(stderr, "kernel_launch: hipFuncSetAttribute failed\n"); grid = -1; return; }
        if (hipOccupancyMaxActiveBlocksPerMultiprocessor(&per_cu, (const void*)skel_fwd, NWAVES * 64, LDS_BYTES) != hipSuccess || per_cu < 1)
            fprintf(stderr, "kernel_launch: note: occupancy query reports %d workgroups per CU\n", per_cu);
        (void)hipGetLastError();
        grid = cus;
    }
    if (grid < 0) return;
    if (hipMemsetAsync((char*)d_ws + WS_CTL, 0, CTL_ZERO_BYTES, stream) != hipSuccess) return;
    Args a{};
    for (int i = 0; i < 21; ++i) a.in[i] = (const float*)d_in[i];
    a.out = (float*)d_out; a.ws = (unsigned char*)d_ws;
#if MK_ONE_LAUNCH
    a.ph_lo = 0; a.ph_hi = N_PHASES;
    hipLaunchKernelGGL(skel_fwd, dim3(grid), dim3(NWAVES * 64), LDS_BYTES, stream, a);
#else
    for (int p = 0; p < N_PHASES; ++p) { a.ph_lo = p; a.ph_hi = p + 1; hipLaunchKernelGGL(skel_fwd, dim3(grid), dim3(NWAVES * 64), LDS_BYTES, stream, a); }
#endif
}
```

```cpp
#include <hip/hip_runtime.h>
#include <cstdio>
#include <cstdint>

namespace pg8 {
#define PG8_LAS __attribute__((address_space(3)))
typedef unsigned short bf16_t;
typedef short bf16x8 __attribute__((ext_vector_type(8)));
typedef float f32x4 __attribute__((ext_vector_type(4)));
typedef unsigned u32x4 __attribute__((ext_vector_type(4)));
constexpr int BM = 256, BK = 64, HALF = 128, HTB = HALF * BK * 2  , STAGE_BYTES = 8 * HTB, NXCD = 8, WGM = 8;

__host__ __device__ __forceinline__ int lds_byte(int r, int c) { const int st = (r >> 4) * 2 + (c >> 5), rr = r & 15, cc = c & 31, ob = rr * 64 + cc * 2; return st * 1024 + (ob ^ (((ob >> 9) & 1) << 5)); }
__host__ __device__ __forceinline__ void stage_rc(int b, int& R, int& C) { const int st = b / 1024, sb = b % 1024, swz = sb ^ (((sb >> 9) & 1) << 5); R = (st >> 1) * 16 + swz / 64; C = (st & 1) * 32 + (swz % 64) / 2; }
__host__ __device__ __forceinline__ int perm32(int rho) { const int n = rho >> 4, i = rho & 15; return 8 * (i >> 2) + 4 * n + (i & 3); }

struct Unit { int pm, pn; };
struct Gemm { const bf16_t* A; const bf16_t* Bt; int lda, K; };
typedef int i32x4 __attribute__((ext_vector_type(4)));
typedef int i32x8 __attribute__((ext_vector_type(8)));
__device__ __forceinline__ i32x8 cat8(bf16x8 lo, bf16x8 hi) { return __builtin_shufflevector(__builtin_bit_cast(i32x4, lo), __builtin_bit_cast(i32x4, hi), 0, 1, 2, 3, 4, 5, 6, 7); }

struct StaticOrder {
    int nM, nN, nwg, G, c;
    __host__ __device__ void init(int M, int N, int G_, int c_) { nM = M / BM; nN = N / BM; nwg = nM * nN; G = G_; c = c_; }
    __host__ __device__ bool next(int i, Unit& u) const {
        const long L = (long)i * G + c; if (L >= nwg) return false;
        int wgid = (int)L; { const int q = nwg / NXCD, r = nwg % NXCD, xcd = wgid % NXCD, off = wgid / NXCD; wgid = (xcd < r ? xcd * (q + 1) : r * (q + 1) + (xcd - r) * q) + off; }
        const int nig = WGM * nN, gid = wgid / nig, fm = gid * WGM, gsz = (nM - fm) < WGM ? (nM - fm) : WGM;
        u.pm = fm + ((wgid % nig) % gsz); u.pn = (wgid % nig) / gsz; return true;
    }
    __device__ __forceinline__ void a_ready(const Unit&) const {}
    __device__ __forceinline__ void done(const Unit&) const {}
};

__device__ __forceinline__ unsigned cvt_pk_bf16(float lo, float hi) { unsigned r; asm volatile("v_cvt_pk_bf16_f32 %0, %1, %2" : "=v"(r) : "v"(lo), "v"(hi)); return r; }
__device__ __forceinline__ u32x4 pack8(const f32x4 v0, const f32x4 v1) { u32x4 w; w.x = cvt_pk_bf16(v0[0], v0[1]); w.y = cvt_pk_bf16(v0[2], v0[3]); w.z = cvt_pk_bf16(v1[0], v1[1]); w.w = cvt_pk_bf16(v1[2], v1[3]); return w; }
__device__ __forceinline__ void rope8(f32x4& v0, f32x4& v1, const float* rp) {
    const f32x4 c0 = *(const f32x4*)rp, c1 = *(const f32x4*)(rp + 4);
    float a, b;
    a = v0[0] * c0[0] - v0[1] * c0[1]; b = v0[0] * c0[1] + v0[1] * c0[0]; v0[0] = a; v0[1] = b;
    a = v0[2] * c0[2] - v0[3] * c0[3]; b = v0[2] * c0[3] + v0[3] * c0[2]; v0[2] = a; v0[3] = b;
    a = v1[0] * c1[0] - v1[1] * c1[1]; b = v1[0] * c1[1] + v1[1] * c1[0]; v1[0] = a; v1[1] = b;
    a = v1[2] * c1[2] - v1[3] * c1[3]; b = v1[2] * c1[3] + v1[3] * c1[2]; v1[2] = a; v1[3] = b;
}

struct EpiPlain {
    static constexpr bool PERM = true, AFTER_DRAIN = false;
    bf16_t* O; int ldc;
    __device__ __forceinline__ void operator()(const f32x4 (&acc)[2][2][4][2], const Unit& u, int wr, int wc, int fr, int fq) const {
        const int row0 = u.pm * BM + wr * 64 + fr, col0 = u.pn * BM + wc * 32 + 8 * fq;
#pragma unroll
        for (int ai = 0; ai < 2; ++ai)
#pragma unroll
            for (int m = 0; m < 4; ++m) { bf16_t* rowp = O + (size_t)(row0 + ai * HALF + m * 16) * ldc + col0;
#pragma unroll
                for (int bj = 0; bj < 2; ++bj) *(u32x4*)(rowp + bj * HALF) = pack8(acc[ai][bj][m][0], acc[ai][bj][m][1]); }
    }
};

template <bool F8> struct EpiProj {
    static constexpr bool PERM = true, AFTER_DRAIN = false;
    bf16_t *AQ, *AKV, *IQ, *IKX, *QL, *KVL; float *IW, *RSQQ, *RSQK; const float* ROPE;
    __device__ __forceinline__ void operator()(const f32x4 (&acc)[2][2][4][2], const Unit& u, int wr, int wc, int fr, int fq) const {
        const int pn = F8 ? (u.pn <= 9 ? u.pn : u.pn + 16) : (u.pn < 15 ? u.pn + 10 : 25);
        bf16_t* dst; int pitch, coff, kind = 0; unsigned ropemask = 0u;
        if (pn < 8) { dst = AQ; pitch = 2048; coff = pn * 256; }
        else if (pn == 8) { dst = AKV; pitch = 256; coff = 0; }
        else if (pn < 25) { dst = IQ; pitch = 4096; coff = (pn - 9) * 256; ropemask = 0xAu; }
        else if (pn == 25) { dst = IKX; pitch = 256; coff = 0; ropemask = 0x6u; kind = 3; }
        else if (pn < 30) { dst = QL; pitch = 1024; coff = (pn - 26) * 256; kind = 1; }
        else { dst = KVL; pitch = 512; coff = (pn - 30) * 256; kind = 2; }
        const int row0 = u.pm * BM + wr * 64 + fr, lc0 = wc * 32 + 8 * fq, i0 = 16 * (wc & 1) + 4 * fq;
#pragma unroll
        for (int ai = 0; ai < 2; ++ai)
#pragma unroll
            for (int m = 0; m < 4; ++m) {
                const int row = row0 + ai * HALF + m * 16; float ss = 0.f;
#pragma unroll
                for (int bj = 0; bj < 2; ++bj) {
                    f32x4 v0 = acc[ai][bj][m][0], v1 = acc[ai][bj][m][1];
                    if (F8) { v0 = v0 * (1.0f / 64.0f); v1 = v1 * (1.0f / 64.0f); }
                    if (pn < 8) { v0 = v0 * (0.08838834764831845f * 1.4426950408889634f); v1 = v1 * (0.08838834764831845f * 1.4426950408889634f); }
                    if ((ropemask >> (2 * bj + (wc >> 1))) & 1u) rope8(v0, v1, ROPE + ((size_t)row * 32 + i0) * 2);
                    if (kind == 1 || kind == 2) ss += (v0[0] * v0[0] + v0[1] * v0[1]) + (v0[2] * v0[2] + v0[3] * v0[3]) + (v1[0] * v1[0] + v1[1] * v1[1]) + (v1[2] * v1[2] + v1[3] * v1[3]);
                    if (kind == 3 && bj == 1 && wc == 2) { float* iw = IW + (size_t)row * 32 + 8 * fq; *(f32x4*)iw = v0; *(f32x4*)(iw + 4) = v1; }
                    if (kind == 1 || kind == 2) {
                        int w0 = 0, w1 = 0; w0 = __builtin_amdgcn_cvt_pk_fp8_f32(v0[0], v0[1], w0, false); w0 = __builtin_amdgcn_cvt_pk_fp8_f32(v0[2], v0[3], w0, true);
                        w1 = __builtin_amdgcn_cvt_pk_fp8_f32(v1[0], v1[1], w1, false); w1 = __builtin_amdgcn_cvt_pk_fp8_f32(v1[2], v1[3], w1, true);
                        typedef unsigned u32x2 __attribute__((ext_vector_type(2)));
                        *(u32x2*)((unsigned char*)dst + (size_t)row * pitch + coff + lc0 + bj * HALF) = (u32x2){(unsigned)w0, (unsigned)w1}; }
                    else *(u32x4*)(dst + (size_t)row * pitch + coff + lc0 + bj * HALF) = pack8(v0, v1);
                }
                if (kind == 1 || kind == 2) {
                    ss += __shfl_xor(ss, 16); ss += __shfl_xor(ss, 32);
                    if (fq == 0) { if (kind == 1) RSQQ[(size_t)row * 16 + (pn - 26) * 4 + wc] = ss; else RSQK[(size_t)row * 8 + (pn - 30) * 4 + wc] = ss; }
                }
            }
    }
};

template <bool ISQ> struct EpiUp {
    static constexpr bool PERM = true, AFTER_DRAIN = false;
    bf16_t* O; int ldc; const float* RSQ; const float* ROPE;
    __device__ __forceinline__ void operator()(const f32x4 (&acc)[2][2][4][2], const Unit& u, int wr, int wc, int fr, int fq) const {
        const int row0 = u.pm * BM + wr * 64 + fr, col0 = u.pn * BM + wc * 32 + 8 * fq, i0 = 16 * (wc & 1) + 4 * fq;
#pragma unroll
        for (int ai = 0; ai < 2; ++ai)
#pragma unroll
            for (int m = 0; m < 4; ++m) {
                const int row = row0 + ai * HALF + m * 16; float rs;
                if (ISQ) { const f32x4* p = (const f32x4*)(RSQ + (size_t)row * 16); const f32x4 a = p[0], b = p[1], c = p[2], d = p[3];
                    const float s = ((a[0] + a[1]) + (a[2] + a[3])) + ((b[0] + b[1]) + (b[2] + b[3])) + ((c[0] + c[1]) + (c[2] + c[3])) + ((d[0] + d[1]) + (d[2] + d[3]));
                    rs = (0.07216878364870322f * 1.4426950408889634f / 32.0f) / sqrtf(s * (1.0f / 1024.0f) + 1e-6f); }
                else { const f32x4* p = (const f32x4*)(RSQ + (size_t)row * 8); const f32x4 a = p[0], b = p[1];
                    const float s = ((a[0] + a[1]) + (a[2] + a[3])) + ((b[0] + b[1]) + (b[2] + b[3]));
                    rs = (1.0f / 16.0f) / sqrtf(s * (1.0f / 512.0f) + 1e-6f); }
#pragma unroll
                for (int bj = 0; bj < 2; ++bj) {
                    f32x4 v0 = acc[ai][bj][m][0] * rs, v1 = acc[ai][bj][m][1] * rs;
                    if (ISQ) { if ((4 * u.pn + 2 * bj + (wc >> 1)) % 3 == 2) rope8(v0, v1, ROPE + ((size_t)row * 32 + i0) * 2); }
                    *(u32x4*)(O + (size_t)row * ldc + col0 + bj * HALF) = pack8(v0, v1);
                }
            }
    }
};

struct EpiVT {
    static constexpr bool PERM = true, AFTER_DRAIN = false;
    bf16_t* O; const float* RSQ;
    __device__ __forceinline__ void operator()(const f32x4 (&acc)[2][2][4][2], const Unit& u, int wr, int wc, int fr, int fq) const {
        const int row0 = u.pm * BM + wr * 64 + fr, col0 = u.pn * BM + wc * 32 + 8 * fq;
        f32x4 rs[2][2];
#pragma unroll
        for (int bj = 0; bj < 2; ++bj)
#pragma unroll
            for (int e = 0; e < 8; ++e) { const f32x4* p = (const f32x4*)(RSQ + (size_t)(col0 + bj * HALF + e) * 8); const f32x4 a = p[0], b = p[1];
                const float s = ((a[0] + a[1]) + (a[2] + a[3])) + ((b[0] + b[1]) + (b[2] + b[3]));
                rs[bj][e >> 2][e & 3] = (1.0f / 16.0f) / sqrtf(s * (1.0f / 512.0f) + 1e-6f); }
#pragma unroll
        for (int ai = 0; ai < 2; ++ai)
#pragma unroll
            for (int m = 0; m < 4; ++m) { bf16_t* rowp = O + (size_t)(row0 + ai * HALF + m * 16) * 8192 + col0;
#pragma unroll
                for (int bj = 0; bj < 2; ++bj) *(u32x4*)(rowp + bj * HALF) = pack8(acc[ai][bj][m][0] * rs[bj][0], acc[ai][bj][m][1] * rs[bj][1]); }
    }
};

struct EpiGLU {
    static constexpr bool PERM = true, AFTER_DRAIN = false;
    bf16_t* H; float* GH; float* UPH; const float* cw; const float* cb; PG8_LAS float* halo;
    static __device__ __forceinline__ float shr1(float prev, float cur) { return __builtin_bit_cast(float, __builtin_amdgcn_update_dpp(__builtin_amdgcn_update_dpp(0, __builtin_bit_cast(int, prev), 0x121, 0xf, 0xf, false), __builtin_bit_cast(int, cur), 0x111, 0xf, 0xf, false)); }
    static __device__ __forceinline__ float shr2(float prev, float cur) { return __builtin_bit_cast(float, __builtin_amdgcn_update_dpp(__builtin_amdgcn_update_dpp(0, __builtin_bit_cast(int, prev), 0x122, 0xf, 0xf, false), __builtin_bit_cast(int, cur), 0x112, 0xf, 0xf, false)); }
    __device__ __forceinline__ void operator()(const f32x4 (&acc)[2][2][4][2], const Unit& u, int wr, int wc, int fr, int fq) const {
        constexpr int FFN = 11008;
        const int c0 = u.pn * 128 + wc * 32 + 8 * fq, lc = wc * 32 + 8 * fq;
        float w0[8], w1[8], w2[8], bs[8];
#pragma unroll
        for (int e = 0; e < 8; e += 4) { const f32x4 a = *(const f32x4*)(cw + c0 + e), b = *(const f32x4*)(cw + FFN + c0 + e), d = *(const f32x4*)(cw + 2 * FFN + c0 + e), s = *(const f32x4*)(cb + c0 + e);
#pragma unroll
            for (int k = 0; k < 4; ++k) { w0[e + k] = a[k]; w1[e + k] = b[k]; w2[e + k] = d[k]; bs[e + k] = s[k]; } }
#pragma unroll
        for (int ai = 0; ai < 2; ++ai) { const int q = 2 * ai + wr;
            if (fr >= 14) { if (q < 3) { PG8_LAS float* hp = halo + ((q + 1) * 2 + (fr - 14)) * 128 + lc; *(PG8_LAS f32x4*)hp = acc[ai][0][3][0]; *(PG8_LAS f32x4*)(hp + 4) = acc[ai][0][3][1]; }
                            else { float* gp = GH + ((size_t)u.pm * 4 + 2 + (fr - 14)) * FFN + c0; *(f32x4*)gp = acc[ai][0][3][0]; *(f32x4*)(gp + 4) = acc[ai][0][3][1]; } }
            if (q == 0 && fr < 2) { float* gp = GH + ((size_t)u.pm * 4 + fr) * FFN + c0; *(f32x4*)gp = acc[0][0][0][0]; *(f32x4*)(gp + 4) = acc[0][0][0][1];
                                    float* up = UPH + ((size_t)u.pm * 2 + fr) * FFN + c0; *(f32x4*)up = acc[0][1][0][0]; *(f32x4*)(up + 4) = acc[0][1][0][1]; } }
        asm volatile("s_waitcnt lgkmcnt(0)" ::: "memory"); __builtin_amdgcn_s_barrier(); asm volatile("" ::: "memory");
#pragma unroll
        for (int ai = 0; ai < 2; ++ai) { const int q = 2 * ai + wr;
            f32x4 hp0 = (f32x4){0.f, 0.f, 0.f, 0.f}, hp1 = hp0;
            if (q > 0 && fr >= 14) { const PG8_LAS float* hp = halo + (q * 2 + (fr - 14)) * 128 + lc; hp0 = *(const PG8_LAS f32x4*)hp; hp1 = *(const PG8_LAS f32x4*)(hp + 4); }
#pragma unroll
            for (int m = 0; m < 4; ++m) {
                f32x4 o0, o1;
#pragma unroll
                for (int j = 0; j < 8; ++j) { const float G = j < 4 ? acc[ai][0][m][0][j & 3] : acc[ai][0][m][1][j & 3], UP = j < 4 ? acc[ai][1][m][0][j & 3] : acc[ai][1][m][1][j & 3];
                    float Gp; if (m == 0) Gp = j < 4 ? hp0[j & 3] : hp1[j & 3]; else Gp = j < 4 ? acc[ai][0][m > 0 ? m - 1 : 0][0][j & 3] : acc[ai][0][m > 0 ? m - 1 : 0][1][j & 3];
                    const float p1 = shr1(Gp, G), p2 = shr2(Gp, G);
                    const float g = bs[j] + w0[j] * p2 + w1[j] * p1 + w2[j] * G;
                    const float hv = g * __builtin_amdgcn_rcpf(1.0f + __builtin_amdgcn_exp2f(-1.4426950408889634f * g)) * UP;
                    if (j < 4) o0[j & 3] = hv; else o1[j & 3] = hv; }
                *(u32x4*)(H + (size_t)(u.pm * BM + ai * HALF + wr * 64 + m * 16 + fr) * FFN + c0) = pack8(o0, o1);
            }
        }
    }
};

template <bool LNR, int ASH> struct EpiZ {
    static constexpr bool PERM = false, AFTER_DRAIN = false;
    const float* R; float* Z; const float* gate;
    static constexpr float alpha = 1.189207115002721f, ascale = 1.0f / (float)(1 << ASH);
    const float* RS; const float* LG; const float* LB;
    __device__ __forceinline__ void operator()(const f32x4 (&acc)[2][2][4][2], const Unit& u, int wr, int wc, int fr, int fq) const {
        const int row0 = u.pm * BM + wr * 64 + fr, col0 = u.pn * BM + wc * 32 + 4 * fq;
        const float* gp = gate + (size_t)((u.pm * BM) >> 11) * 24576 + col0;
#pragma unroll
        for (int bj = 0; bj < 2; ++bj)
#pragma unroll
            for (int n = 0; n < 2; ++n) {
                const f32x4 gv = (*(const f32x4*)(gp + bj * HALF + 16 * n) + 1.0f) * ascale; f32x4 lg = gv, lb = gv;
                if (LNR) { lg = *(const f32x4*)(LG + col0 + bj * HALF + 16 * n) * alpha; lb = *(const f32x4*)(LB + col0 + bj * HALF + 16 * n) * alpha; }
#pragma unroll
                for (int ai = 0; ai < 2; ++ai)
#pragma unroll
                    for (int m = 0; m < 4; ++m) { const int row = row0 + ai * HALF + m * 16; const size_t ro = (size_t)row * 4096 + col0 + bj * HALF + 16 * n;
                        const f32x4 r = *(const f32x4*)(R + ro); f32x4 res;
                        if (LNR) { typedef float f32x2 __attribute__((ext_vector_type(2))); const f32x2 ms = *(const f32x2*)(RS + 2 * (size_t)row); res = (r - ms.x) * ms.y * lg + lb; } else res = r * alpha;
                        *(f32x4*)(Z + ro) = res + gv * acc[ai][bj][m][n]; } }
    }
};

template <class Epi, class Sched, bool ALIGN_EPI = false, bool SP2 = false, bool FP8 = false>
__device__ __forceinline__ void gemm_phase(PG8_LAS unsigned char* lds, const Gemm g, const Sched& S, const Epi& E) {
    const int tid = threadIdx.x, wid = __builtin_amdgcn_readfirstlane(tid >> 6), lane = tid & 63, wr = wid >> 2, wc = wid & 3, fr = lane & 15, fq = lane >> 4;
    const int K = g.K, nt = K / BK, lda = g.lda;
    unsigned voffA[2], voffB[2];
#pragma unroll
    for (int i = 0; i < 2; ++i) { int R, C; stage_rc(tid * 16 + i * 8192, R, C); const int Rb = Epi::PERM ? ((R & ~31) + perm32(R & 31)) : R;
        voffA[i] = (unsigned)(R * lda + C) * 2u; voffB[i] = (unsigned)(Rb * K + C) * 2u; }
    const size_t kstep = (size_t)(BK * 2);
    const size_t hstep = (size_t)HALF * K * 2, hstepA = (size_t)HALF * lda * 2;
    const size_t tstep = 2 * hstep, tstepA = 2 * hstepA;
    const unsigned ldsw = (unsigned)wid * 1024u;
    const int aoff = lds_byte(wr * 64 + fr, fq * 8), boff = lds_byte(wc * 32 + fr, fq * 8);
#define PG8_SA(b, h) (((b) * 2 + (h)) * HTB)
#define PG8_SB(b, h) ((4 + (b) * 2 + (h)) * HTB)
#define PG8_STAGE(bufoff, gbase, voff) do { _Pragma("unroll") for (int _i = 0; _i < 2; ++_i) \
        __builtin_amdgcn_global_load_lds((const unsigned*)((const char*)(gbase) + (voff)[_i]), (PG8_LAS unsigned*)(lds + (bufoff) + ldsw + _i * 8192), 16, 0, 0); } while (0)
#define PG8_LDA(dst, b, h) do { if constexpr (FP8) { _Pragma("unroll") for (int m = 0; m < 4; ++m) dst##8[m] = __builtin_shufflevector(*(const PG8_LAS i32x4*)(lds + PG8_SA(b, h) + aoff + m * 2048), *(const PG8_LAS i32x4*)(lds + PG8_SA(b, h) + aoff + m * 2048 + 1024), 0, 1, 2, 3, 4, 5, 6, 7); } \
        else { _Pragma("unroll") for (int m = 0; m < 4; ++m) _Pragma("unroll") for (int k = 0; k < 2; ++k) dst[m][k] = *(const PG8_LAS bf16x8*)(lds + PG8_SA(b, h) + aoff + m * 2048 + k * 1024); } } while (0)
#define PG8_LDB(dst, b, h) do { if constexpr (FP8) { _Pragma("unroll") for (int n = 0; n < 2; ++n) dst##8[n] = __builtin_shufflevector(*(const PG8_LAS i32x4*)(lds + PG8_SB(b, h) + boff + n * 2048), *(const PG8_LAS i32x4*)(lds + PG8_SB(b, h) + boff + n * 2048 + 1024), 0, 1, 2, 3, 4, 5, 6, 7); } \
        else { _Pragma("unroll") for (int n = 0; n < 2; ++n) _Pragma("unroll") for (int k = 0; k < 2; ++k) dst[n][k] = *(const PG8_LAS bf16x8*)(lds + PG8_SB(b, h) + boff + n * 2048 + k * 1024); } } while (0)
#define PG8_MMA(ai, bj, At, Bt) do { __builtin_amdgcn_s_setprio(1); \
        if constexpr (FP8) { _Pragma("unroll") for (int m = 0; m < 4; ++m) _Pragma("unroll") for (int n = 0; n < 2; ++n) \
            asm volatile("v_mfma_f32_16x16x128_f8f6f4 %0, %1, %2, %0" : "+v"(acc[ai][bj][m][n]) : "v"(Bt##8[n]), "v"(At##8[m])); } \
        else { _Pragma("unroll") for (int m = 0; m < 4; ++m) _Pragma("unroll") for (int n = 0; n < 2; ++n) _Pragma("unroll") for (int k = 0; k < 2; ++k) \
            acc[ai][bj][m][n] = __builtin_amdgcn_mfma_f32_16x16x32_bf16(Bt[n][k], At[m][k], acc[ai][bj][m][n], 0, 0, 0); } \
        __builtin_amdgcn_s_setprio(0); } while (0)
#define PG8_WAIT_V(n) asm volatile("s_waitcnt vmcnt(" #n ")" ::: "memory")
#define PG8_WAIT_L(n) asm volatile("s_waitcnt lgkmcnt(" #n ")" ::: "memory")
#define PG8_BAR __builtin_amdgcn_s_barrier()
#define PG8_SCHED __builtin_amdgcn_sched_barrier(0)
    Unit cur, nxt; int ui = 0;
    if (!S.next(0, cur)) return;
    f32x4 acc[2][2][4][2];
#pragma unroll
    for (int a = 0; a < 2; ++a)
#pragma unroll
        for (int b = 0; b < 2; ++b)
#pragma unroll
            for (int m = 0; m < 4; ++m)
#pragma unroll
                for (int n = 0; n < 2; ++n) acc[a][b][m][n] = (f32x4){0.f, 0.f, 0.f, 0.f};
    bf16x8 At[4][2], B0[2][2], B1[2][2]; i32x8 At8[4], B08[2], B18[2];
    const char* cA = (const char*)g.A + (size_t)cur.pm * tstepA; const char* cB = (const char*)g.Bt + (size_t)cur.pn * tstep;
    S.a_ready(cur);
    if constexpr (SP2) {
        PG8_STAGE(PG8_SB(0, 0), cB, voffB); PG8_STAGE(PG8_SB(0, 1), cB + hstep, voffB); PG8_STAGE(PG8_SA(0, 0), cA, voffA); PG8_STAGE(PG8_SA(0, 1), cA + hstepA, voffA);
        if (wr == 1) PG8_BAR;
        PG8_WAIT_V(2); PG8_BAR;
        PG8_STAGE(PG8_SB(1, 0), cB + kstep, voffB); PG8_STAGE(PG8_SA(1, 0), cA + kstep, voffA); PG8_STAGE(PG8_SB(1, 1), cB + hstep + kstep, voffB);
        PG8_WAIT_V(6); PG8_BAR;
    } else {
        PG8_STAGE(PG8_SB(0, 0), cB, voffB); PG8_STAGE(PG8_SA(0, 0), cA, voffA); PG8_STAGE(PG8_SB(0, 1), cB + hstep, voffB); PG8_STAGE(PG8_SA(0, 1), cA + hstepA, voffA);
        if (wr == 1) PG8_BAR;
        PG8_WAIT_V(4); PG8_BAR;
        PG8_STAGE(PG8_SB(1, 0), cB + kstep, voffB); PG8_STAGE(PG8_SA(1, 0), cA + kstep, voffA); PG8_STAGE(PG8_SB(1, 1), cB + hstep + kstep, voffB);
        PG8_WAIT_V(6); PG8_BAR;
    }
    for (;;) {
        const bool has_next = S.next(ui + 1, nxt);
        const char* nA = has_next ? (const char*)g.A + (size_t)nxt.pm * tstepA : cA; const char* nB = has_next ? (const char*)g.Bt + (size_t)nxt.pn * tstep : cB;
        for (int t = 0; t < nt; t += 2) {
            const bool last = (t == nt - 2);
            const char* a1 = cA + (size_t)(t + 1) * kstep;
            const char* a2 = last ? nA : cA + (size_t)(t + 2) * kstep; const char* b2 = last ? nB : cB + (size_t)(t + 2) * kstep;
            const char* a3 = a2 + kstep; const char* b3 = b2 + kstep;
            if (last && has_next) S.a_ready(nxt);
            if constexpr (SP2) {
            PG8_LDB(B0, 0, 0); PG8_LDB(B1, 0, 1); PG8_SCHED; PG8_LDA(At, 0, 0); PG8_STAGE(PG8_SA(1, 1), a1 + hstepA, voffA);
            PG8_WAIT_V(8); PG8_WAIT_L(0); PG8_BAR; PG8_MMA(0, 0, At, B0); PG8_MMA(0, 1, At, B1); PG8_BAR; PG8_SCHED;
            PG8_LDA(At, 0, 1); PG8_STAGE(PG8_SB(0, 0), b2, voffB); PG8_STAGE(PG8_SB(0, 1), b2 + hstep, voffB); PG8_STAGE(PG8_SA(0, 0), a2, voffA);
            PG8_WAIT_V(8); PG8_WAIT_L(0); PG8_BAR; PG8_MMA(1, 0, At, B0); PG8_MMA(1, 1, At, B1); PG8_BAR; PG8_SCHED;
            PG8_LDB(B0, 1, 0); PG8_LDB(B1, 1, 1); PG8_SCHED; PG8_LDA(At, 1, 0); PG8_STAGE(PG8_SA(0, 1), a2 + hstepA, voffA);
            PG8_WAIT_V(8); PG8_WAIT_L(0); PG8_BAR; PG8_MMA(0, 0, At, B0); PG8_MMA(0, 1, At, B1); PG8_BAR; PG8_SCHED;
            PG8_LDA(At, 1, 1); PG8_STAGE(PG8_SB(1, 0), b3, voffB); PG8_STAGE(PG8_SB(1, 1), b3 + hstep, voffB); PG8_STAGE(PG8_SA(1, 0), a3, voffA);
            PG8_WAIT_V(8); PG8_WAIT_L(0); PG8_BAR; PG8_MMA(1, 0, At, B0); PG8_MMA(1, 1, At, B1); PG8_BAR; PG8_SCHED;
            } else {
            PG8_LDB(B0, 0, 0); PG8_SCHED; PG8_LDA(At, 0, 0); PG8_STAGE(PG8_SA(1, 1), a1 + hstepA, voffA);
            PG8_WAIT_L(8); PG8_BAR; PG8_WAIT_L(0); PG8_MMA(0, 0, At, B0); PG8_BAR; PG8_SCHED;
            PG8_LDB(B1, 0, 1); PG8_STAGE(PG8_SB(0, 0), b2, voffB);
            PG8_BAR; PG8_WAIT_L(0); PG8_MMA(0, 1, At, B1); PG8_BAR;
            PG8_LDA(At, 0, 1); PG8_STAGE(PG8_SA(0, 0), a2, voffA);
            PG8_BAR; PG8_WAIT_L(0); PG8_MMA(1, 0, At, B0); PG8_BAR; PG8_SCHED;
            PG8_STAGE(PG8_SB(0, 1), b2 + hstep, voffB);
            PG8_WAIT_V(6); PG8_BAR; PG8_MMA(1, 1, At, B1); PG8_BAR;
            PG8_LDB(B0, 1, 0); PG8_SCHED; PG8_LDA(At, 1, 0); PG8_STAGE(PG8_SA(0, 1), a2 + hstepA, voffA);
            PG8_WAIT_L(8); PG8_BAR; PG8_WAIT_L(0); PG8_MMA(0, 0, At, B0); PG8_BAR; PG8_SCHED;
            PG8_LDB(B1, 1, 1); PG8_STAGE(PG8_SB(1, 0), b3, voffB);
            PG8_BAR; PG8_WAIT_L(0); PG8_MMA(0, 1, At, B1); PG8_BAR;
            PG8_LDA(At, 1, 1); PG8_STAGE(PG8_SA(1, 0), a3, voffA);
            PG8_BAR; PG8_WAIT_L(0); PG8_MMA(1, 0, At, B0); PG8_BAR; PG8_SCHED;
            PG8_STAGE(PG8_SB(1, 1), b3 + hstep, voffB);
            PG8_WAIT_V(6); PG8_BAR; PG8_MMA(1, 1, At, B1); PG8_BAR;
            }
        }
        if constexpr (ALIGN_EPI) { if (wr == 0) PG8_BAR; }
        if constexpr (!Epi::AFTER_DRAIN) { E(acc, cur, wr, wc, fr, fq); S.done(cur); }
        if (!has_next) break;
#pragma unroll
        for (int a = 0; a < 2; ++a)
#pragma unroll
            for (int b = 0; b < 2; ++b)
#pragma unroll
                for (int m = 0; m < 4; ++m)
#pragma unroll
                    for (int n = 0; n < 2; ++n) acc[a][b][m][n] = (f32x4){0.f, 0.f, 0.f, 0.f};
        cur = nxt; cA = nA; cB = nB; ++ui;
        if constexpr (ALIGN_EPI) { if (wr == 1) PG8_BAR; }
    }
    PG8_WAIT_V(0);
    if constexpr (!ALIGN_EPI) { if (wr == 0) PG8_BAR; }
    PG8_BAR;
    if constexpr (Epi::AFTER_DRAIN) { E.fused(acc, cur, wr, wc, fr, fq, lds, wid, lane); S.done(cur); }
#undef PG8_SA
#undef PG8_SB
#undef PG8_STAGE
#undef PG8_LDA
#undef PG8_LDB
#undef PG8_MMA
#undef PG8_WAIT_V
#undef PG8_WAIT_L
#undef PG8_BAR
#undef PG8_SCHED
}
}
constexpr int NWAVES = 8;
constexpr int BATCH = 4, SEQ = 2048, D = 4096, M = BATCH * SEQ, FF = 11008, NIN = 8192  , NGU = 2 * FF;
constexpr int N_PHASES = 11;
#ifndef DSA_NAIVE
#define DSA_NAIVE 0
#endif
#ifndef MK_ONE_LAUNCH
#define MK_ONE_LAUNCH 1
#endif
constexpr float LN_EPS = 1e-5f, ALPHA = 1.189207115002721f;

constexpr size_t MiB = 1u << 20;
constexpr size_t WS_CTL = 0, CTL_ZERO_BYTES = 1 * MiB;
constexpr size_t WS_MOD = 1 * MiB, WS_ROPE = 2 * MiB, WS_RSQQ = 4 * MiB, WS_RSQK = 4 * MiB + 512 * 1024, WS_IW = 5 * MiB, WS_VTA = 6 * MiB, WS_RS1 = 4 * MiB + 768 * 1024  ;
constexpr size_t WS_WIN = 8 * MiB  , WS_WINB = 24 * MiB  , WS_WUQ = 72 * MiB, WS_WUKV = 78 * MiB, WS_WO = 82 * MiB, WS_WGU = 114 * MiB, WS_WD = 286 * MiB;
constexpr size_t WS_U = 372 * MiB, WS_AQ = 436 * MiB, WS_AKV = 468 * MiB, WS_IQ = 472 * MiB, WS_IKX = 536 * MiB, WS_QL = 540 * MiB, WS_KVL = 556 * MiB;
constexpr size_t WS_QB = 564 * MiB, WS_KV = 612 * MiB, WS_KN = 612 * MiB, WS_VT = 644 * MiB, WS_SC = 676 * MiB, WS_MIX = 740 * MiB, WS_Z1 = 804 * MiB, WS_X1 = 932 * MiB;
constexpr size_t WS_GU = 436 * MiB  , WS_GH = 436 * MiB  , WS_UPH = 444 * MiB  , WS_H = 1060 * MiB, WS_U8 = 1232 * MiB  , WS_END = 1264 * MiB;
constexpr int CW_TMO = 0, CW_CODE = 1, CW_BAR = 4096;

constexpr int RING_OFF = 0, RING_BYTES = 131072;
constexpr int LDSCTL_OFF = 135168, MISC_OFF = LDSCTL_OFF + 320;
constexpr int LDS_BYTES = 147456;

#define GAS __attribute__((address_space(1)))
#define LAS __attribute__((address_space(3)))
typedef unsigned short bf16;
typedef unsigned v4u __attribute__((ext_vector_type(4)));
typedef unsigned v2u __attribute__((ext_vector_type(2)));
typedef float f32x4 __attribute__((ext_vector_type(4)));
typedef float f32x2 __attribute__((ext_vector_type(2)));
typedef GAS unsigned gu32;
#define RLX_AGENT __ATOMIC_RELAXED, __HIP_MEMORY_SCOPE_AGENT
#define LDS_WAIT() asm volatile("s_waitcnt lgkmcnt(0)" ::: "memory")
#define VM_WAIT() asm volatile("s_waitcnt vmcnt(0)" ::: "memory")
__device__ __forceinline__ unsigned f2bf(float f) { unsigned u = __builtin_bit_cast(unsigned, f); return (u + 0x7fffu + ((u >> 16) & 1u)) >> 16; }
__device__ __forceinline__ unsigned pk2(float lo, float hi) { return f2bf(lo) | (f2bf(hi) << 16); }
__device__ __forceinline__ float bflo(unsigned w) { return __builtin_bit_cast(float, w << 16); }
__device__ __forceinline__ float bfhi(unsigned w) { return __builtin_bit_cast(float, w & 0xffff0000u); }

#define XB_TMO      128
#define XB_XCNT(j)  (256  + 64 * (j))
#define XB_XSUB(j)  (1280 + 64 * (j))
#define XB_XGEN(j)  (2304 + 64 * (j))
#define XB_TOP      3328
#define XB_TOPGEN   3392
#define XCD_BAR_WORDS 3456
#define XB_SPIN_CAP (1u << 18)
__device__ __forceinline__ unsigned xb_ld(unsigned* p)              { return __hip_atomic_load(p, __ATOMIC_RELAXED, __HIP_MEMORY_SCOPE_AGENT); }
__device__ __forceinline__ unsigned xb_add(unsigned* p, unsigned v) { return __hip_atomic_fetch_add(p, v, __ATOMIC_RELAXED, __HIP_MEMORY_SCOPE_AGENT); }
__device__ __forceinline__ unsigned xb_xcc_id() { return (unsigned)__builtin_amdgcn_s_getreg((3 << 11) | 20) & 0xFu; }
#define XB_SPIN(cond, bar) do { unsigned _sp = 0; while (cond) { __builtin_amdgcn_s_sleep(1); \
    if ((++_sp & 255u) == 0u) { if (xb_ld(&(bar)[XB_TMO])) break; if (_sp > XB_SPIN_CAP) { atomicAdd(&(bar)[XB_TMO], 1u); break; } } } } while (0)
struct XcdBarrier { unsigned* bar; unsigned x; volatile LAS unsigned* st; };
__device__ __forceinline__ XcdBarrier xcd_barrier_post(unsigned* bar, volatile LAS unsigned* st) {
    XcdBarrier b; b.bar = bar; b.x = xb_xcc_id(); b.st = st;
    if (threadIdx.x == 0) (void)xb_add(&bar[XB_XCNT(b.x)], 1u);
    return b;
}
__device__ __forceinline__ void xcd_barrier_complete(unsigned* bar, unsigned x, unsigned& nloc, unsigned& nx) {
    const unsigned G = gridDim.x * gridDim.y * gridDim.z;
    unsigned sum, cnt, mine, sp = 0u;
    for (;;) {
        sum = 0u; cnt = 0u; mine = 0u;
#pragma unroll
        for (unsigned j = 0; j < 16; ++j) { const unsigned c = xb_ld(&bar[XB_XCNT(j)]); sum += c; cnt += (c > 0u) ? 1u : 0u; mine = (j == x) ? c : mine; }
        if (sum == G) break;
        __builtin_amdgcn_s_sleep(1);
        if ((++sp & 255u) == 0u) { if (xb_ld(&bar[XB_TMO])) break; if (sp > XB_SPIN_CAP) { atomicAdd(&bar[XB_TMO], 1u); break; } }
    }
    nloc = mine > 0u ? mine : 1u; nx = cnt > 0u ? cnt : 1u;
}
__device__ __forceinline__ void xcd_barrier(const XcdBarrier& b) {
    asm volatile("s_waitcnt vmcnt(0)" ::: "memory");
    __syncthreads();
    if (threadIdx.x == 0) {
        unsigned* bar = b.bar;
        __builtin_amdgcn_s_waitcnt(0);
        unsigned nloc = b.st[0], nx = b.st[1];
        if (nloc == 0u) { xcd_barrier_complete(bar, b.x, nloc, nx); b.st[0] = nloc; b.st[1] = nx; }
        const unsigned old = xb_add(&bar[XB_XSUB(b.x)], 1u);
        const unsigned gen = old / nloc;
        if (old + 1u == (gen + 1u) * nloc) {
            __builtin_amdgcn_fence(__ATOMIC_RELEASE, "agent");
            asm volatile("s_waitcnt vmcnt(0)" ::: "memory");
            const unsigned og = xb_add(&bar[XB_TOP], 1u);
            const unsigned tg = og / nx;
            if (og + 1u == (tg + 1u) * nx) xb_add(&bar[XB_TOPGEN], 1u);
            else XB_SPIN(xb_ld(&bar[XB_TOPGEN]) == tg, bar);
            __builtin_amdgcn_fence(__ATOMIC_ACQUIRE, "agent");
            xb_add(&bar[XB_XGEN(b.x)], 1u);
            asm volatile("s_waitcnt vmcnt(0)" ::: "memory");
        } else {
            XB_SPIN(xb_ld(&bar[XB_XGEN(b.x)]) == gen, bar);
            __builtin_amdgcn_fence(__ATOMIC_ACQUIRE, "agent");
            asm volatile("s_waitcnt vmcnt(0)" ::: "memory");
        }
    }
    __syncthreads();
}

struct Frame {
    LAS unsigned char* lds;
    volatile LAS unsigned* MISC;
    gu32* ctl;
    int tid, lane, wave;
    int vcu, G;
    unsigned char* ws;
    const float* in[21];
    float* out;
};
__device__ __forceinline__ float wave_sum(float v) {
#pragma unroll
    for (int o = 1; o < 64; o <<= 1) v += __shfl_xor(v, o);
    return v;
}
__device__ __forceinline__ float wave_max(float v) {
#pragma unroll
    for (int o = 1; o < 64; o <<= 1) v = fmaxf(v, __shfl_xor(v, o));
    return v;
}
__device__ __forceinline__ int wave_isum(int v) {
#pragma unroll
    for (int o = 1; o < 64; o <<= 1) v += __shfl_xor(v, o);
    return v;
}
enum { I_X = 0, I_C, I_POS, I_WADA, I_BADA, I_WIN, I_RELB, I_QG, I_WUQ, I_KVG, I_WUKV, I_WO, I_LN1G, I_LN1B, I_WG, I_WU, I_CW, I_CB, I_WD, I_LN2G, I_LN2B };

__device__ const unsigned char BUCKET_TAB[128] = {0, 1, 2, 3, 4, 5, 6, 7, 8, 9, 10, 11, 12, 13, 14, 15, 16, 16, 16, 17, 17, 18, 18, 18, 19, 19, 19, 20, 20, 20, 20, 21, 21, 21, 21, 22, 22, 22, 22, 22, 23, 23, 23, 23, 23, 23, 24, 24, 24, 24, 24, 24, 25, 25, 25, 25, 25, 25, 25, 26, 26, 26, 26, 26, 26, 26, 26, 27, 27, 27, 27, 27, 27, 27, 27, 27, 27, 28, 28, 28, 28, 28, 28, 28, 28, 28, 28, 29, 29, 29, 29, 29, 29, 29, 29, 29, 29, 29, 29, 30, 30, 30, 30, 30, 30, 30, 30, 30, 30, 30, 30, 30, 30, 31, 31, 31, 31, 31, 31, 31, 31, 31, 31, 31, 31, 31, 31, 31};
__device__ const double ROPE_FREV[32] = {
    0.15915494309189535, 0.11934937021124886, 0.08949940160889101, 0.06711508300522726,
    0.050329212104487035, 0.03774158471741977, 0.0283021958306234, 0.02122365276477766,
    0.015915494309189534, 0.011934937021124886, 0.008949940160889102, 0.006711508300522725,
    0.005032921210448704, 0.003774158471741977, 0.00283021958306234, 0.0021223652764777662,
    0.0015915494309189536, 0.0011934937021124885, 0.0008949940160889102, 0.0006711508300522726,
    0.0005032921210448703, 0.00037741584717419774, 0.00028302195830623395, 0.0002122365276477766,
    0.00015915494309189535, 0.00011934937021124886, 8.949940160889102e-05, 6.711508300522725e-05,
    5.0329212104487035e-05, 3.774158471741978e-05, 2.8302195830623396e-05, 2.122365276477766e-05
};

__device__ __forceinline__ int colmap(int kind, int c) {
    if (kind == 0) return c;
    if (kind == 1) {
        if (c < 2304) return c;
        if (c < 6400) { const int r = c - 2304, h = r >> 7, d = r & 127; const int dd = d < 64 ? d : 64 + 2 * ((d - 64) & 31) + ((d - 64) >> 5);
            return h < 2 ? 2304 + h * 128 + dd : 4096 + (h - 2) * 128 + dd; }
        if (c < 6528) { const int d = c - 6400; return 4096 + 3840 + (d < 64 ? d : 64 + 2 * ((d - 64) & 31) + ((d - 64) >> 5)); }
        if (c < 6560) return 4096 + 3840 + 192 + (c - 6528);
        if (c < 7584) return 2560 + (c - 6560);
        if (c < 8096) return 3584 + (c - 7584);
        const int j = c - 8096; return 4096 + 3840 + 128 + 2 * (j & 31) + (j >> 5);
    }
    if (kind == 2) { const int h = c / 192, d = c - h * 192; if (d < 128) return c; const int j = d - 128; return h * 192 + 128 + 2 * (j & 31) + (j >> 5); }
    if (kind == 3) return (c >> 7) * 256 + (c & 127);
    if (kind == 5) return (c >> 8) * 128 + (c & 127) + ((c & 128) ? 2048 : 0);
    return (c >> 7) * 256 + 128 + (c & 127);
}
constexpr int TT_IN = 32 * 64, TT_UQ = 8 * 24, TT_UKV = 4 * 32, TT_O = 32 * 32, TT_G = 32 * 86, TT_D = 86 * 32;
constexpr int TT_TOTAL = TT_IN + TT_UQ + TT_UKV + TT_O + 2 * TT_G + TT_D;
struct TJob { const float* W; const float* scale; bf16* WT; int K, N, kind, k0, n0; float f8s; };
__device__ __forceinline__ TJob tjob(const Frame& F, int t) {
    TJob j; j.scale = nullptr; j.f8s = 0.f; int nnt;
    if (t < TT_IN) { j.W = F.in[I_WIN]; j.WT = (bf16*)(F.ws + WS_WIN); j.K = 4096; j.N = 8160; j.kind = 1; nnt = 64; }
    else if ((t -= TT_IN) < TT_UQ) { j.W = F.in[I_WUQ]; j.scale = F.in[I_QG]; j.WT = (bf16*)(F.ws + WS_WUQ); j.K = 1024; j.N = 3072; j.kind = 2; j.f8s = 32.0f; nnt = 24; }
    else if ((t -= TT_UQ) < TT_UKV) { j.W = F.in[I_WUKV]; j.scale = F.in[I_KVG]; j.WT = (bf16*)(F.ws + WS_WUKV); j.K = 512; j.N = 4096; j.kind = 5; j.f8s = 16.0f; nnt = 32; }
    else if ((t -= TT_UKV) < TT_O) { j.W = F.in[I_WO]; j.WT = (bf16*)(F.ws + WS_WO); j.K = 4096; j.N = 4096; j.kind = 0; j.f8s = 128.0f; nnt = 32; }
    else if ((t -= TT_O) < TT_G) { j.W = F.in[I_WG]; j.WT = (bf16*)(F.ws + WS_WGU); j.K = 4096; j.N = FF; j.kind = 3; nnt = 86; }
    else if ((t -= TT_G) < TT_G) { j.W = F.in[I_WU]; j.WT = (bf16*)(F.ws + WS_WGU); j.K = 4096; j.N = FF; j.kind = 4; nnt = 86; }
    else { t -= TT_G; j.W = F.in[I_WD]; j.WT = (bf16*)(F.ws + WS_WD); j.K = FF; j.N = 4096; j.kind = 0; nnt = 32; }
    j.k0 = (t / nnt) * 128; j.n0 = (t % nnt) * 128; return j;
}
__device__ __forceinline__ void tr_load(const Frame& F, int t, f32x4 (&ld)[8]) {
    const TJob j = tjob(F, t); const int rsub = F.lane >> 5, c4 = F.lane & 31, n = j.n0 + 4 * c4;
#pragma unroll
    for (int i = 0; i < 8; ++i) { const int k = j.k0 + 16 * F.wave + 2 * i + rsub;
        f32x4 v = (f32x4){0.f, 0.f, 0.f, 0.f};
        if (n < j.N) v = __builtin_nontemporal_load((const f32x4*)(j.W + (size_t)k * j.N + n));
        if (j.scale) v = v * j.scale[k];
        ld[i] = v; }
}
__device__ __forceinline__ void p0_prologue(Frame& F) {
    const int g = blockIdx.x, G = F.G;
    { float* ROPE = (float*)(F.ws + WS_ROPE); const int* pos = (const int*)F.in[I_POS];
      for (int idx = g * 512 + F.tid; idx < M * 32; idx += G * 512) { const int m = idx >> 5, i = idx & 31;
          const double r = (double)pos[m] * ROPE_FREV[i]; const float fr = (float)(r - __builtin_floor(r)) * 2.0f;
          ROPE[2 * idx] = cospif(fr); ROPE[2 * idx + 1] = sinpif(fr); } }
    { v4u* z = (v4u*)((bf16*)(F.ws + WS_WINB) + (size_t)4064 * 4096);
      for (int idx = g * 512 + F.tid; idx < 32 * 4096 / 8; idx += G * 512) z[idx] = (v4u){0u, 0u, 0u, 0u}; }
    {
        LAS float* CACT = (LAS float*)F.lds; LAS float* RED = (LAS float*)(F.lds + 65536);
        for (int idx = F.tid; idx < 4 * 4096; idx += 512) { const float c = F.in[I_C][idx]; CACT[idx] = c / (1.0f + __expf(-c)); }
        __syncthreads();
        for (int it = g; it < 256; it += G) {
            const int ln = F.lane < 48 ? F.lane : 47; const float* wp = F.in[I_WADA] + (size_t)(512 * F.wave) * 24576 + it * 96 + 2 * ln;
            f32x2 acc[4];
#pragma unroll
            for (int b = 0; b < 4; ++b) acc[b] = (f32x2){0.f, 0.f};
            for (int k = 0; k < 512; k += 16) {
                f32x2 wv[16];
#pragma unroll
                for (int i = 0; i < 16; ++i) wv[i] = __builtin_nontemporal_load((const f32x2*)(wp + (size_t)(k + i) * 24576));
#pragma unroll
                for (int i = 0; i < 16; ++i)
#pragma unroll
                    for (int b = 0; b < 4; ++b) acc[b] += wv[i] * CACT[b * 4096 + 512 * F.wave + k + i];
            }
            if (F.lane < 48) {
#pragma unroll
                for (int b = 0; b < 4; ++b) *(LAS f32x2*)(RED + (F.wave * 4 + b) * 96 + 2 * F.lane) = acc[b]; }
            __syncthreads();
            if (F.tid < 384) { const int b = F.tid / 96, c = F.tid % 96; float s = F.in[I_BADA][it * 96 + c];
#pragma unroll
              for (int w = 0; w < 8; ++w) s += RED[(w * 4 + b) * 96 + c];
              ((float*)(F.ws + WS_MOD))[b * 24576 + it * 96 + c] = s; }
            __syncthreads();
        }
    }
    {
        const int tb = (int)((long)TT_TOTAL * g / G), te = (int)((long)TT_TOTAL * (g + 1) / G);
        LAS float* T = (LAS float*)F.lds;
        f32x4 ldA[8], ldB[8];
        if (tb < te) tr_load(F, tb, ldA);
        if (tb + 1 < te) tr_load(F, tb + 1, ldB);
#define TR_STEP(LD, t_) do { \
            { const int rsub = F.lane >> 5, c4 = F.lane & 31; \
              _Pragma("unroll") for (int i = 0; i < 8; ++i) { const int k = 16 * F.wave + 2 * i + rsub; *(LAS f32x4*)(T + 132 * k + ((4 * c4) ^ (4 * ((k >> 3) & 15)))) = LD[i]; } } \
            __syncthreads(); \
            const TJob j = tjob(F, (t_)); \
            if ((t_) + 2 < te) tr_load(F, (t_) + 2, LD); \
            { const int c = F.lane & 15; \
              _Pragma("unroll") for (int q = 0; q < 4; ++q) { const int n = (F.lane >> 4) + 4 * F.wave + 32 * q; const LAS float* s = T + 132 * (8 * c) + (n ^ (4 * c)); \
                  int R_ = (j.n0 + n < j.N) ? colmap(j.kind, j.n0 + n) : 0; const bool f8_ = j.kind == 1 ? R_ < 4096 : j.f8s != 0.f; if (j.kind == 1 && !f8_) R_ -= 4096; \
                  if (f8_) { const float fs = j.kind == 1 ? 64.0f : j.f8s; int w0 = 0, w1 = 0; \
                      w0 = __builtin_amdgcn_cvt_pk_fp8_f32(s[0] * fs, s[132] * fs, w0, false); w0 = __builtin_amdgcn_cvt_pk_fp8_f32(s[2 * 132] * fs, s[3 * 132] * fs, w0, true); \
                      w1 = __builtin_amdgcn_cvt_pk_fp8_f32(s[4 * 132] * fs, s[5 * 132] * fs, w1, false); w1 = __builtin_amdgcn_cvt_pk_fp8_f32(s[6 * 132] * fs, s[7 * 132] * fs, w1, true); \
                      if (j.n0 + n < j.N) *(v2u*)((unsigned char*)j.WT + (size_t)R_ * j.K + j.k0 + 8 * c) = (v2u){(unsigned)w0, (unsigned)w1}; } \
                  else { v4u o; o.x = pk2(s[0], s[132]); o.y = pk2(s[2 * 132], s[3 * 132]); o.z = pk2(s[4 * 132], s[5 * 132]); o.w = pk2(s[6 * 132], s[7 * 132]); \
                  if (j.n0 + n < j.N) *(v4u*)((j.kind == 1 ? (bf16*)(F.ws + WS_WINB) : j.WT) + (size_t)R_ * j.K + j.k0 + 8 * c) = o; } } } \
            __syncthreads(); } while (0)
        for (int t = tb; t < te; t += 2) { TR_STEP(ldA, t); if (t + 1 < te) TR_STEP(ldB, t + 1); }
#undef TR_STEP
    }
}

__device__ __forceinline__ void ln_stats(const f32x4 (&v)[16], float& mean, float& rstd) {
    float s = 0.f;
#pragma unroll
    for (int j = 0; j < 16; ++j) s += (v[j][0] + v[j][1]) + (v[j][2] + v[j][3]);
    mean = wave_sum(s) * (1.0f / D); float q = 0.f;
#pragma unroll
    for (int j = 0; j < 16; ++j) { const f32x4 d = v[j] - mean; q += (d[0] * d[0] + d[1] * d[1]) + (d[2] * d[2] + d[3] * d[3]); }
    rstd = 1.0f / sqrtf(wave_sum(q) * (1.0f / D) + LN_EPS);
}
template <int KIND> __device__ __forceinline__ void row_pass(Frame& F) {
    const float* mod = (const float*)(F.ws + WS_MOD); bf16* U = (bf16*)(F.ws + WS_U);
    LAS float* VA = (LAS float*)F.lds; LAS float* VB = VA + 4096;
    const float* src = KIND == 1 ? F.in[I_X] : (KIND == 6 ? (const float*)(F.ws + WS_Z1) : F.out);
    int cur = -1;
    for (int blk = F.vcu; blk < M / 32; blk += F.G) {
        const int bt = blk >> 6;
        if (KIND == 10 ? cur < 0 : bt != cur) {
            __syncthreads();
            const float* mb = mod + (size_t)bt * 24576; const int c = 8 * F.tid;
#pragma unroll
            for (int e = 0; e < 8; e += 4) { f32x4 va, vb;
                if (KIND == 1) { va = *(const f32x4*)(mb + 4096 + c + e) + 1.0f; vb = *(const f32x4*)(mb + c + e); }
                else if (KIND == 6) { const f32x4 s1 = *(const f32x4*)(mb + 4 * 4096 + c + e) + 1.0f; va = *(const f32x4*)(F.in[I_LN1G] + c + e) * s1; vb = *(const f32x4*)(F.in[I_LN1B] + c + e) * s1 + *(const f32x4*)(mb + 3 * 4096 + c + e); }
                else { va = *(const f32x4*)(F.in[I_LN2G] + c + e); vb = *(const f32x4*)(F.in[I_LN2B] + c + e); }
                *(LAS f32x4*)(VA + c + e) = va; *(LAS f32x4*)(VB + c + e) = vb; }
            __syncthreads(); cur = bt;
        }
#pragma unroll 1
        for (int r = 0; r < 4; ++r) { const int m = blk * 32 + 4 * F.wave + r; const char* rp = (const char*)(src + (size_t)m * D); const unsigned lo = (unsigned)F.lane * 16u;
            f32x4 v[16];
#pragma unroll
            for (int j = 0; j < 16; ++j) v[j] = KIND == 1 ? __builtin_nontemporal_load((const f32x4*)(rp + (lo + 1024u * j))) : *(const f32x4*)(rp + (lo + 1024u * j));
            float mean = 0.f, rstd = 1.f;
            if (KIND != 1) { ln_stats(v, mean, rstd); if (KIND == 6 && F.lane == 0) *(f32x2*)((float*)(F.ws + WS_RS1) + 2 * (size_t)m) = (f32x2){mean, rstd}; }
#pragma unroll
            for (int j = 0; j < 16; ++j) { const f32x4 va = *(const LAS f32x4*)(VA + 4 * F.lane + 256 * j), vb = *(const LAS f32x4*)(VB + 4 * F.lane + 256 * j);
                const f32x4 o = KIND == 1 ? v[j] * va + vb : (v[j] - mean) * rstd * va + vb;
                if (KIND == 10) *(f32x4*)((char*)(F.out + (size_t)m * D) + (lo + 1024u * j)) = o;
                else { v2u w; w.x = pk2(o[0], o[1]); w.y = pk2(o[2], o[3]); *(v2u*)((char*)(U + (size_t)m * D) + ((unsigned)F.lane * 8u + 512u * j)) = w;
                    if (KIND == 1) { int w8 = 0; w8 = __builtin_amdgcn_cvt_pk_fp8_f32(o[0], o[1], w8, false); w8 = __builtin_amdgcn_cvt_pk_fp8_f32(o[2], o[3], w8, true);
                        *(unsigned*)((unsigned char*)(F.ws + WS_U8) + (size_t)m * D + ((unsigned)F.lane * 4u + 256u * j)) = (unsigned)w8; } }
                if ((j & 3) == 3) __builtin_amdgcn_sched_barrier(0); } }
    }
    __syncthreads();
}
__device__ __forceinline__ void p8_fixup(Frame& F) {
    const float* GH = (const float*)(F.ws + WS_GH); const float* UPH = (const float*)(F.ws + WS_UPH); bf16* H = (bf16*)(F.ws + WS_H);
    const float* cw = F.in[I_CW]; const float* cb = F.in[I_CB];
    const int total = 32 * 2 * FF;
    for (int idx = (int)blockIdx.x * 512 + F.tid; idx < total; idx += F.G * 512) {
        const int c = idx % FF, r = (idx / FF) & 1, pm = idx / (2 * FF);
        if ((pm & 7) == 0) continue;
        const float gm2 = r == 0 ? GH[((size_t)(pm - 1) * 4 + 2) * FF + c] : GH[((size_t)(pm - 1) * 4 + 3) * FF + c];
        const float gm1 = r == 0 ? GH[((size_t)(pm - 1) * 4 + 3) * FF + c] : GH[((size_t)pm * 4 + 0) * FF + c];
        const float g0 = GH[((size_t)pm * 4 + r) * FF + c];
        const float g = cb[c] + cw[c] * gm2 + cw[FF + c] * gm1 + cw[2 * FF + c] * g0;
        H[(size_t)(pm * 256 + r) * FF + c] = (bf16)f2bf(g / (1.0f + __expf(-g)) * UPH[((size_t)pm * 2 + r) * FF + c]);
    }
}


namespace att {
typedef float f32x16 __attribute__((ext_vector_type(16)));
typedef short bf16x8 __attribute__((ext_vector_type(8)));
constexpr int VP = 144;
constexpr int KREG = 32768, BUF_STRIDE = 57344;
constexpr int X_OFF = 2 * BUF_STRIDE;
__device__ __forceinline__ int swap23(int r) { return (r & ~12) | ((r & 4) << 1) | ((r & 8) >> 1); }
__device__ __forceinline__ unsigned sortable(float f) { const unsigned u = __builtin_bit_cast(unsigned, f); return (u & 0x80000000u) ? ~u : (u | 0x80000000u); }

template <int OFF> __device__ __forceinline__ void lds_rd128(bf16x8& d, unsigned addr) { asm volatile("ds_read_b128 %0, %1 offset:%2" : "=v"(d) : "v"(addr), "n"(OFF)); }
template <int N> __device__ __forceinline__ void lgkm_wait(bf16x8& d) { asm volatile("s_waitcnt lgkmcnt(%1)" : "+v"(d) : "n"(N)); }
struct Stg {
    const unsigned char* base;
    unsigned koff[4], kstep[4], voff[3];
    unsigned ldsk, ldsv;
    int nk, nv;
    template <int E> __device__ __forceinline__ void k() { if (E < nk) __builtin_amdgcn_global_load_lds((const unsigned*)(base + koff[E]), (LAS unsigned*)(unsigned long long)(ldsk + E * 1024), 16, 0, 0); }
    template <int E> __device__ __forceinline__ void v() { if (E < nv) __builtin_amdgcn_global_load_lds((const unsigned*)(base + voff[E]), (LAS unsigned*)(unsigned long long)(ldsv + E * 1024), 16, 0, 0); }
};
template <int N, int KSTEPS, int KP, int PF> struct SStep {
    static __device__ __forceinline__ void run(bf16x8 (&fr)[PF], f32x16 (&sa)[2], const bf16x8 (&qf)[KSTEPS], unsigned base, Stg& st, bool more) {
        constexpr int NMM = 2 * KSTEPS, kb = N / KSTEPS, s = N % KSTEPS, GAP = NMM / 4;
        lgkm_wait<((NMM - N < PF) ? NMM - N : PF) - 1>(fr[N % PF]);
        sa[kb] = __builtin_amdgcn_mfma_f32_32x32x16_bf16(fr[N % PF], qf[s], sa[kb], 0, 0, 0);
        if constexpr (N + PF < NMM) lds_rd128<32 * ((N + PF) / KSTEPS) * KP + 32 * ((N + PF) % KSTEPS)>(fr[N % PF], base);
        if constexpr (N % 2 == 1 && N < 8) st.template k<N / 2>();
        if constexpr (N % 2 == 1 && N >= 8 && N < 14) st.template v<(N - 8) / 2>();
        if constexpr (N + 1 < NMM) SStep<N + 1, KSTEPS, KP, PF>::run(fr, sa, qf, base, st, more);
    }
};
template <int N, int PF> struct PVStep {
    static __device__ __forceinline__ void run(bf16x8 (&fr)[PF], f32x16 (&o)[4], const bf16x8 (&pf)[4], unsigned base, Stg& st, bool more) {
        constexpr int d = N / 4, ks = N % 4;
        lgkm_wait<((16 - N < PF) ? 16 - N : PF) - 1>(fr[N % PF]);
        o[d] = __builtin_amdgcn_mfma_f32_32x32x16_bf16(fr[N % PF], pf[ks], o[d], 0, 0, 0);
        if constexpr (N + PF < 16) lds_rd128<32 * ((N + PF) / 4) * VP + 32 * ((N + PF) % 4)>(fr[N % PF], base);
        if constexpr (N + 1 < 16) PVStep<N + 1, PF>::run(fr, o, pf, base, st, more);
    }
};
template <int N, int KSTEPS, int KP, int PF> struct SPre { static __device__ __forceinline__ void run(bf16x8 (&fr)[PF], unsigned base) {
    lds_rd128<32 * (N / KSTEPS) * KP + 32 * (N % KSTEPS)>(fr[N], base); if constexpr (N + 1 < PF) SPre<N + 1, KSTEPS, KP, PF>::run(fr, base); } };
template <int N, int PF> struct PVPre { static __device__ __forceinline__ void run(bf16x8 (&fr)[PF], unsigned base) {
    lds_rd128<32 * (N / 4) * VP + 32 * (N % 4)>(fr[N], base); if constexpr (N + 1 < PF) PVPre<N + 1, PF>::run(fr, base); } };
__device__ __forceinline__ void dsa_topk(Frame& F, int b, int q0, int slot) {
    const int tid = F.tid, lane = F.lane, w = F.wave; LAS unsigned char* lds = F.lds; const size_t brow = (size_t)b * SEQ;
    LAS unsigned* bmp = (LAS unsigned*)(lds + X_OFF) + slot * 1024;
    LAS float* rb2 = (LAS float*)(lds + X_OFF + 8192 + 1024);
    {
        const float* SC = (const float*)(F.ws + WS_SC);
        for (int idx = tid; idx < 2048; idx += 512) rb2[idx] = F.in[I_RELB][(int)BUCKET_TAB[idx >> 4] * 16 + (idx & 15)] * 1.4426950408889634f;
        for (int tt = 0; tt < 2; ++tt) {
            const int t = q0 + 2 * w + tt, n = t + 1; const float* row = SC + (brow + t) * SEQ;
            unsigned u[32];
#pragma unroll
            for (int j = 0; j < 32; ++j) { const int s = 64 * j + lane; u[j] = 0u; if (64 * j < n) { if (s < n) u[j] = sortable(row[s]); } }
            unsigned T = 1u;
            bool exact = true;
            if (n > 256) {
                T = 0u; exact = false;
                for (int bit = 31; bit >= 0; --bit) {
                    const unsigned cand = T | (1u << bit); int c = 0;
#pragma unroll
                    for (int j = 0; j < 32; ++j) c += __popcll(__ballot(u[j] >= cand));
                    if (c >= 256) T = cand;
                    if (c == 256) { exact = true; break; }
                }
            }
            if (exact) {
#pragma unroll
                for (int j = 0; j < 32; ++j) { const unsigned long long mk = __ballot(u[j] >= T); if (lane < 2) bmp[(2 * w + tt) * 64 + 2 * j + lane] = (unsigned)(mk >> (32 * lane)); }
            } else {
                int need = 256;
#pragma unroll
                for (int j = 0; j < 32; ++j) need -= __popcll(__ballot(u[j] > T));
#pragma unroll
                for (int j = 0; j < 32; ++j) { unsigned long long mk = __ballot(u[j] > T), eq = __ballot(u[j] == T);
                    while (eq != 0ull && need > 0) { const unsigned long long low = eq & (~eq + 1ull); mk |= low; eq ^= low; --need; }
                    if (lane < 2) bmp[(2 * w + tt) * 64 + 2 * j + lane] = (unsigned)(mk >> (32 * lane)); }
            }
        }
    }
}
template <int MODE> __device__ __forceinline__ void attn_unit(Frame& F, int b, int h, int q0, int slot) {
    constexpr int KD = MODE == 0 ? 192 : 128, KCH = KD / 8, KP = (KCH + 1) * 16, KSTEPS = KD / 16, KTILE = 64 * KP;
    constexpr int KROWCH = KCH + 1;
    static_assert(64 * KP <= KREG && KREG + 128 * VP <= BUF_STRIDE, "tile buffers");
    const int tid = F.tid, lane = F.lane, w = F.wave, l32 = lane & 31, hh = lane >> 5;
    LAS unsigned char* lds = F.lds;
    unsigned long long wsl_ = (unsigned long long)F.ws; asm volatile("" : "+s"(wsl_));
    unsigned char* const WSP = (unsigned char*)wsl_;
    unsigned long long posl_ = (unsigned long long)F.in[I_POS]; asm volatile("" : "+s"(posl_)); const int* const POSP = (const int*)posl_;
    const bf16* QG; const bf16* KG; const bf16* K2G = nullptr; const bf16* VTG; bf16* MIX = (bf16*)(WSP + WS_MIX);
    if (MODE == 0) { QG = (const bf16*)(WSP + WS_QB); KG = (const bf16*)(WSP + WS_KN); K2G = (const bf16*)(WSP + WS_IKX); VTG = (const bf16*)(WSP + WS_VT) + (size_t)(h * 128) * M; }
    else { QG = (const bf16*)(WSP + WS_AQ); KG = (const bf16*)(WSP + WS_AKV); VTG = (const bf16*)(WSP + WS_VTA); }
    const size_t brow = (size_t)b * SEQ;
    int tq, qhead;
    if (MODE == 0) { tq = q0 + 32 * w + l32; qhead = h; } else { tq = q0 + 2 * w + (l32 >> 4); qhead = l32 & 15; }
    const int nt = MODE == 0 ? (q0 + 256) / 64 : (q0 + 16 + 63) / 64;
    LAS unsigned* bmp = (LAS unsigned*)(lds + X_OFF) + slot * 1024;
    LAS int* posk = (LAS int*)(lds + X_OFF + 8192);
    LAS int* farf = (LAS int*)(lds + X_OFF + 8192 + 512);
    LAS float* rb2 = (LAS float*)(lds + X_OFF + 8192 + 1024);
    bf16x8 qf[KSTEPS];
    int posq = 0, minposq = 0; float bias_far = 0.f;
    if (MODE == 1) { const int* pos = POSP; posq = pos[brow + tq]; const int p0 = pos[brow + q0 + 2 * w], p1 = pos[brow + q0 + 2 * w + 1]; minposq = p0 < p1 ? p0 : p1; }
    Stg st; st.base = WSP;
    { constexpr int NKI = (64 * KROWCH + 63) / 64, NVI = 18;
      int ln_ = lane; asm volatile("" : "+v"(ln_));
      st.nk = NKI - 4 * w; st.nk = st.nk < 0 ? 0 : (st.nk > 4 ? 4 : st.nk); st.nv = NVI - 3 * w; st.nv = st.nv < 0 ? 0 : (st.nv > 3 ? 3 : st.nv);
#pragma unroll
      for (int e = 0; e < 4; ++e) { const int q = (4 * w + e) * 64 + ln_, rho = q / KROWCH, c = q % KROWCH; const bool ok = rho < 64 && c < KCH; const unsigned kr = (unsigned)swap23(rho & 63);
          if (MODE == 0) { const bool two = c >= 16;
              st.koff[e] = !ok ? (unsigned)WS_KN : (two ? (unsigned)WS_IKX + ((unsigned)(brow + kr) * 256u + 128u + 8u * (c - 16)) * 2u : (unsigned)WS_KN + ((unsigned)(brow + kr) * 2048u + (unsigned)h * 128u + 8u * c) * 2u);
              st.kstep[e] = !ok ? 0u : (two ? 64u * 512u : 64u * 4096u); }
          else { st.koff[e] = !ok ? (unsigned)WS_AKV : (unsigned)WS_AKV + ((unsigned)(brow + kr) * 256u + 8u * c) * 2u; st.kstep[e] = !ok ? 0u : 64u * 512u; } }
#pragma unroll
      for (int e = 0; e < 3; ++e) { const int q = (3 * w + e) * 64 + ln_, d = q / 9, c = q % 9; const bool ok = d < 128 && c < 8;
          const unsigned vb = MODE == 0 ? (unsigned)WS_VT + (unsigned)(h * 128) * (unsigned)(M * 2) : (unsigned)WS_VTA;
          st.voff[e] = !ok ? vb : vb + (unsigned)d * (unsigned)(M * 2) + ((unsigned)brow + 8u * c) * 2u; } }
#define ATT_ADVANCE() do { _Pragma("unroll") for (int e = 0; e < 4; ++e) st.koff[e] += st.kstep[e]; _Pragma("unroll") for (int e = 0; e < 3; ++e) st.voff[e] += 128u; } while (0)
#define ATT_TARGET(i_) do { const unsigned tb_ = (unsigned)(unsigned long long)(lds + ((i_) & 1) * BUF_STRIDE); st.ldsk = tb_ + 4 * w * 1024; st.ldsv = tb_ + KREG + 3 * w * 1024; } while (0)
#define ATT_POS(i_) do { if (MODE == 1 && tid < 64) { const int* pos_ = POSP + brow + 64 * (i_); const int pk = pos_[tid]; posk[((i_) & 1) * 64 + tid] = pk; int mx = pk; \
            _Pragma("unroll") for (int o_ = 1; o_ < 64; o_ <<= 1) { const int y = __shfl_xor(mx, o_); mx = mx > y ? mx : y; } \
            if (tid == 0) farf[(i_) & 1] = mx; } } while (0)
    f32x16 o[4];
#pragma unroll
    for (int d = 0; d < 4; ++d)
#pragma unroll
        for (int r = 0; r < 16; ++r) o[d][r] = 0.f;
    float ninit = 0.f, lrun = 0.f;
    constexpr float THR = 8.0f;
    __syncthreads();
    if (MODE == 1) bias_far = rb2[127 * 16 + qhead];
    { const bf16* qp = MODE == 0 ? QG + (brow + tq) * 3072 + qhead * 192 + 8 * hh : QG + (brow + tq) * 2048 + qhead * 128 + 8 * hh;
#pragma unroll
      for (int s = 0; s < KSTEPS; ++s) qf[s] = *(const bf16x8*)(qp + 16 * s); }
    ATT_TARGET(0); st.k<0>(); st.k<1>(); st.k<2>(); st.k<3>(); st.v<0>(); st.v<1>(); st.v<2>(); ATT_POS(0); ATT_ADVANCE();
    asm volatile("s_waitcnt vmcnt(0)" ::: "memory"); __syncthreads();
    const int tmin = MODE == 0 ? q0 + 32 * w : q0;
    for (int i = 0; i < nt; ++i) {
        const bool more = i + 1 < nt;
        ATT_TARGET(i + 1); if (more) ATT_POS(i + 1);
        const int key0 = 64 * i;
        {
            const LAS unsigned char* kbuf = lds + (i & 1) * BUF_STRIDE; const LAS unsigned char* vbuf = kbuf + KREG;
            constexpr int PF = MODE == 0 ? 4 : 3;
            const unsigned kbase = (unsigned)(unsigned long long)(kbuf + l32 * KP + hh * 16), vbase = (unsigned)(unsigned long long)(vbuf + l32 * VP + hh * 16);
            f32x16 sa[2]; bf16x8 fr[PF];
            SPre<0, KSTEPS, KP, PF>::run(fr, kbase);
            if (MODE == 0) {
#pragma unroll
                for (int kb = 0; kb < 2; ++kb)
#pragma unroll
                    for (int r = 0; r < 16; ++r) sa[kb][r] = ninit;
            } else {
                const bool far_ = __builtin_amdgcn_readfirstlane(minposq - farf[i & 1]) >= 128;
#pragma unroll
                for (int kb = 0; kb < 2; ++kb)
#pragma unroll
                    for (int g = 0; g < 2; ++g) { float bia[8];
#pragma unroll
                        for (int e = 0; e < 8; ++e) bia[e] = bias_far;
                        if (!far_) { const LAS int* pp = posk + (i & 1) * 64 + 32 * kb + 16 * g + 8 * hh;
#pragma unroll
                            for (int e = 0; e < 8; ++e) { int rel = posq - pp[e]; rel = rel < 0 ? 0 : (rel > 127 ? 127 : rel); bia[e] = rb2[rel * 16 + qhead]; } }
#pragma unroll
                        for (int e = 0; e < 8; ++e) sa[kb][8 * g + e] = bia[e] + ninit;
                        __builtin_amdgcn_sched_barrier(0); }
            }
            SStep<0, KSTEPS, KP, PF>::run(fr, sa, qf, kbase, st, more);
            if (MODE == 0) {
                if (key0 + 63 > tmin) {
#pragma unroll
                    for (int kb = 0; kb < 2; ++kb)
#pragma unroll
                        for (int r = 0; r < 16; ++r) { const int key = key0 + 32 * kb + 16 * (r >> 3) + 8 * hh + (r & 7); const float xv = sa[kb][r]; sa[kb][r] = key > tq ? -__builtin_inff() : xv; }
                }
            } else {
                const v2u wds = *(const LAS v2u*)(bmp + (2 * w + (l32 >> 4)) * 64 + 2 * i);
#pragma unroll
                for (int kb = 0; kb < 2; ++kb) { const int wdh = (int)((kb == 0 ? wds.x : wds.y) >> (8 * hh));
#pragma unroll
                    for (int r = 0; r < 16; ++r) { const int mk = __builtin_amdgcn_sbfe(wdh, 16 * (r >> 3) + (r & 7), 1); const float xv = sa[kb][r];
                        sa[kb][r] = __builtin_bit_cast(float, (__builtin_bit_cast(int, xv) & mk) | ((int)0xff800000 & ~mk)); } }
            }
            float mloc = sa[0][0];
#pragma unroll
            for (int kb = 0; kb < 2; ++kb)
#pragma unroll
                for (int r = 0; r < 16; ++r) mloc = fmaxf(mloc, sa[kb][r]);
            mloc = fmaxf(mloc, __shfl_xor(mloc, 32));
            if (i == 0 || __any(mloc > THR)) {
                const float delta = i == 0 ? (mloc > -1.0e30f ? mloc : 0.f) : fmaxf(mloc, 0.f), alpha = __builtin_amdgcn_exp2f(-delta);
                ninit -= delta; lrun *= alpha;
#pragma unroll
                for (int kb = 0; kb < 2; ++kb)
#pragma unroll
                    for (int r = 0; r < 16; ++r) sa[kb][r] -= delta;
#pragma unroll
                for (int d = 0; d < 4; ++d)
#pragma unroll
                    for (int r = 0; r < 16; ++r) o[d][r] *= alpha;
            }
            float psum = 0.f;
#pragma unroll
            for (int kb = 0; kb < 2; ++kb)
#pragma unroll
                for (int r = 0; r < 16; ++r) { const float p = __builtin_amdgcn_exp2f(sa[kb][r]); sa[kb][r] = p; psum += p; }
            lrun += psum;
            bf16x8 pf[4];
#pragma unroll
            for (int ks = 0; ks < 4; ++ks) { v4u pk;
#pragma unroll
                for (int e = 0; e < 4; ++e) pk[e] = pg8::cvt_pk_bf16(sa[ks >> 1][8 * (ks & 1) + 2 * e], sa[ks >> 1][8 * (ks & 1) + 2 * e + 1]);
                pf[ks] = __builtin_bit_cast(bf16x8, pk); }
            PVPre<0, PF>::run(fr, vbase);
            PVStep<0, PF>::run(fr, o, pf, vbase, st, more);
        }
        ATT_ADVANCE();
        asm volatile("s_waitcnt vmcnt(0)" ::: "memory"); __syncthreads();
    }
    { const float lt = lrun + __shfl_xor(lrun, 32), inv = 16.0f / lt;
      int tq2 = tq; asm volatile("" : "+v"(tq2));
      const unsigned oo = (unsigned)(b * SEQ + tq2) * 4096u + (MODE == 0 ? 2048u + (unsigned)h * 128u : (unsigned)qhead * 128u);
      unsigned char* op = (unsigned char*)MIX + oo;
#pragma unroll
      for (int d = 0; d < 4; ++d)
#pragma unroll
          for (int g = 0; g < 4; ++g) { int wv = 0; wv = __builtin_amdgcn_cvt_pk_fp8_f32(o[d][4 * g] * inv, o[d][4 * g + 1] * inv, wv, false); wv = __builtin_amdgcn_cvt_pk_fp8_f32(o[d][4 * g + 2] * inv, o[d][4 * g + 3] * inv, wv, true);
              *(unsigned*)(op + 32 * d + 8 * g + 4 * hh) = (unsigned)wv; } }
}
#undef ATT_ADVANCE
#undef ATT_TARGET
#undef ATT_POS
}

__device__ __forceinline__ void indexer_unit(Frame& F, int b, int t0) {
    constexpr int KP = 272, KTILE = 64 * KP;
    const int tid = F.tid, lane = F.lane, w = F.wave, l32 = lane & 31, hh = lane >> 5;
    LAS unsigned char* lds = F.lds;
    const bf16* IQ = (const bf16*)(F.ws + WS_IQ); const bf16* IKX = (const bf16*)(F.ws + WS_IKX); const float* IW = (const float*)(F.ws + WS_IW); float* SC = (float*)(F.ws + WS_SC);
    const size_t brow = (size_t)b * SEQ, m0 = brow + t0 + 2 * w;
    att::bf16x8 af[2][8]; float wt[2][16];
#pragma unroll
    for (int tt = 0; tt < 2; ++tt) {
#pragma unroll
        for (int s = 0; s < 8; ++s) af[tt][s] = *(const att::bf16x8*)(IQ + (m0 + tt) * 4096 + l32 * 128 + 16 * s + 8 * hh);
#pragma unroll
        for (int g = 0; g < 4; ++g) { const f32x4 v = *(const f32x4*)(IW + (m0 + tt) * 32 + 8 * g + 4 * hh); wt[tt][4 * g] = v[0]; wt[tt][4 * g + 1] = v[1]; wt[tt][4 * g + 2] = v[2]; wt[tt][4 * g + 3] = v[3]; }
    }
    const int nt = (t0 + 16 + 63) / 64;
    v4u st[2];
#define IDX_LOAD(i_) do { _Pragma("unroll") for (int e = 0; e < 2; ++e) { const int q = tid + 512 * e, rho = q >> 4, c = q & 15; st[e] = *(const v4u*)(IKX + (brow + 64 * (i_) + rho) * 256 + 8 * c); } } while (0)
#define IDX_STORE(i_) do { _Pragma("unroll") for (int e = 0; e < 2; ++e) { const int q = tid + 512 * e, rho = q >> 4, c = q & 15; *(LAS v4u*)(lds + ((i_) & 1) * KTILE + rho * KP + c * 16) = st[e]; } } while (0)
    __syncthreads();
    IDX_LOAD(0); IDX_STORE(0);
    __syncthreads();
    for (int i = 0; i < nt; ++i) {
        if (i + 1 < nt) IDX_LOAD(i + 1);
        const LAS unsigned char* kbuf = lds + (i & 1) * KTILE;
#pragma unroll
        for (int kb = 0; kb < 2; ++kb) {
            att::bf16x8 bfr[8];
#pragma unroll
            for (int s = 0; s < 8; ++s) bfr[s] = *(const LAS att::bf16x8*)(kbuf + (32 * kb + l32) * KP + (2 * s + hh) * 16);
            float sc[2];
#pragma unroll
            for (int tt = 0; tt < 2; ++tt) {
                att::f32x16 acc;
#pragma unroll
                for (int r = 0; r < 16; ++r) acc[r] = 0.f;
#pragma unroll
                for (int s = 0; s < 8; ++s) acc = __builtin_amdgcn_mfma_f32_32x32x16_bf16(af[tt][s], bfr[s], acc, 0, 0, 0);
                float x = 0.f;
#pragma unroll
                for (int r = 0; r < 16; ++r) x += wt[tt][r] * fmaxf(acc[r], 0.f);
                sc[tt] = x + __shfl_xor(x, 32);
            }
            SC[(m0 + hh) * SEQ + 64 * i + 32 * kb + l32] = hh ? sc[1] : sc[0];
        }
        if (i + 1 < nt) IDX_STORE(i + 1);
        __syncthreads();
    }
#undef IDX_LOAD
#undef IDX_STORE
}
__device__ __forceinline__ void av_transpose(Frame& F, int tile) {
    const bf16* AKV = (const bf16*)(F.ws + WS_AKV); bf16* VTA = (bf16*)(F.ws + WS_VTA);
    LAS unsigned short* T = (LAS unsigned short*)F.lds;
    __syncthreads();
#pragma unroll
    for (int e = 0; e < 2; ++e) { const int tok = F.tid & 63, c = (F.tid >> 6) + 8 * e; const v4u v = *(const v4u*)(AKV + (size_t)(64 * tile + tok) * 256 + 128 + 8 * c);
#pragma unroll
        for (int k = 0; k < 4; ++k) { T[(8 * c + 2 * k) * 72 + tok] = (unsigned short)(v[k] & 0xffffu); T[(8 * c + 2 * k + 1) * 72 + tok] = (unsigned short)(v[k] >> 16); } }
    __syncthreads();
    { const int d = F.tid >> 2, part = F.tid & 3; const LAS v4u* s = (const LAS v4u*)(T + d * 72 + 16 * part);
      v4u* dst = (v4u*)(VTA + (size_t)d * M + 64 * tile + 16 * part); dst[0] = s[0]; dst[1] = s[1]; }
    __syncthreads();
}

struct Args { const float* in[21]; float* out; unsigned char* ws; int ph_lo, ph_hi; };
__global__ void __launch_bounds__(NWAVES * 64, 2) skel_fwd(Args args) {
    extern __shared__ __attribute__((aligned(16))) unsigned char lds[];
    Frame F;
    F.lds = (LAS unsigned char*)lds;
    F.MISC = (volatile LAS unsigned*)(F.lds + MISC_OFF);
    F.tid = threadIdx.x; F.lane = F.tid & 63; F.wave = __builtin_amdgcn_readfirstlane(F.tid >> 6);
    F.G = gridDim.x; { const int bx = blockIdx.x; F.vcu = (F.G % 8 == 0) ? (bx % 8) * (F.G / 8) + bx / 8 : bx; }
    F.ws = args.ws; F.ctl = (gu32*)(args.ws + WS_CTL); F.out = args.out;
#pragma unroll
    for (int i = 0; i < 21; ++i) F.in[i] = args.in[i];
    for (int u = F.tid; u < (LDS_BYTES - LDSCTL_OFF) / 4; u += NWAVES * 64) ((LAS unsigned*)(F.lds + LDSCTL_OFF))[u] = 0u;
    __syncthreads();
    XcdBarrier bar; bar.bar = (unsigned*)(F.ctl + CW_BAR); bar.x = 0; bar.st = nullptr;
    const int lo = args.ph_lo, hi = args.ph_hi;
    if (hi - lo > 1) bar = xcd_barrier_post((unsigned*)(F.ctl + CW_BAR), F.MISC + 8);
#define IN(k) (lo <= (k) && (k) < hi)
#define SEAM(k) do { if (IN(k) && IN((k) + 1)) xcd_barrier(bar); } while (0)
    unsigned char* ws = args.ws;

    if (IN(0)) { p0_prologue(F); SEAM(0); }
    if (IN(1)) { row_pass<1>(F); SEAM(1); }
    if (IN(2)) {
        { pg8::Gemm g{(const bf16*)(ws + WS_U8), (const bf16*)(ws + WS_WIN), D / 2, D / 2}; pg8::StaticOrder S; S.init(M, 4096, F.G, (int)blockIdx.x);
          pg8::EpiProj<true> E{(bf16*)(ws + WS_AQ), (bf16*)(ws + WS_AKV), (bf16*)(ws + WS_IQ), (bf16*)(ws + WS_IKX), (bf16*)(ws + WS_QL), (bf16*)(ws + WS_KVL),
                       (float*)(ws + WS_IW), (float*)(ws + WS_RSQQ), (float*)(ws + WS_RSQK), (const float*)(ws + WS_ROPE)};
          pg8::gemm_phase<pg8::EpiProj<true>, pg8::StaticOrder, true, true, true>(F.lds + RING_OFF, g, S, E); }
        { pg8::Gemm g{(const bf16*)(ws + WS_U), (const bf16*)(ws + WS_WINB), D, D}; pg8::StaticOrder S; S.init(M, 4096, F.G, (int)blockIdx.x);
          pg8::EpiProj<false> E{(bf16*)(ws + WS_AQ), (bf16*)(ws + WS_AKV), (bf16*)(ws + WS_IQ), (bf16*)(ws + WS_IKX), (bf16*)(ws + WS_QL), (bf16*)(ws + WS_KVL),
                       (float*)(ws + WS_IW), (float*)(ws + WS_RSQQ), (float*)(ws + WS_RSQK), (const float*)(ws + WS_ROPE)};
          pg8::gemm_phase<pg8::EpiProj<false>, pg8::StaticOrder, true, true>(F.lds + RING_OFF, g, S, E); }
        SEAM(2);
    }
    if (IN(3)) {
        { pg8::Gemm g{(const bf16*)(ws + WS_QL), (const bf16*)(ws + WS_WUQ), 512, 512}; pg8::StaticOrder S; S.init(M, 3072, F.G, (int)blockIdx.x);
          pg8::EpiUp<true> E{(bf16*)(ws + WS_QB), 3072, (const float*)(ws + WS_RSQQ), (const float*)(ws + WS_ROPE)};
          pg8::gemm_phase<pg8::EpiUp<true>, pg8::StaticOrder, true, true, true>(F.lds + RING_OFF, g, S, E); }
        { pg8::Gemm g{(const bf16*)(ws + WS_KVL), (const bf16*)(ws + WS_WUKV), 256, 256}; pg8::StaticOrder S; S.init(M, 2048, F.G, (int)blockIdx.x);
          pg8::EpiUp<false> E{(bf16*)(ws + WS_KN), 2048, (const float*)(ws + WS_RSQK), nullptr};
          pg8::gemm_phase<pg8::EpiUp<false>, pg8::StaticOrder, true, true, true>(F.lds + RING_OFF, g, S, E); }
        { pg8::Gemm g{(const bf16*)(ws + WS_WUKV) + (size_t)2048 * 256, (const bf16*)(ws + WS_KVL), 256, 256}; pg8::StaticOrder S; S.init(2048, M, F.G, (int)blockIdx.x);
          pg8::EpiVT E{(bf16*)(ws + WS_VT), (const float*)(ws + WS_RSQK)};
          pg8::gemm_phase<pg8::EpiVT, pg8::StaticOrder, true, true, true>(F.lds + RING_OFF, g, S, E); }
        __syncthreads();
        if (blockIdx.x < 128) av_transpose(F, (int)blockIdx.x);
        for (int P = F.vcu; P < 256; P += F.G)     { const int b = P >> 6, j = P & 63; for (int k = 0; k < 2; ++k) indexer_unit(F, b, 16 * (k ? 127 - j : j)); }
        SEAM(3);
    }
    if (IN(4)) {
        for (int P = F.vcu; P < 256; P += F.G)     { const int b = P >> 6, h = (P >> 2) & 15, j = P & 3; for (int k = 0; k < 2; ++k) att::attn_unit<0>(F, b, h, 256 * (k ? 7 - j : j), 0); }
        __syncthreads();
        for (int P = F.vcu; P < 256; P += F.G)     { const int b = P >> 6, j = P & 63;
            __syncthreads();
            for (int k = 0; k < 2; ++k) att::dsa_topk(F, b, 16 * (k ? 127 - j : j), k);
            for (int k = 0; k < 2; ++k) att::attn_unit<1>(F, b, 0, 16 * (k ? 127 - j : j), k); }
        SEAM(4);
    }
    if (IN(5)) {
        pg8::Gemm g{(const bf16*)(ws + WS_MIX), (const bf16*)(ws + WS_WO), D / 2, D / 2};     pg8::StaticOrder S; S.init(M, D, F.G, (int)blockIdx.x);
        pg8::EpiZ<false, 11> E{F.in[I_X], (float*)(ws + WS_Z1), (const float*)(ws + WS_MOD) + 2 * 4096, nullptr, nullptr, nullptr};
        pg8::gemm_phase<pg8::EpiZ<false, 11>, pg8::StaticOrder, true, true, true>(F.lds + RING_OFF, g, S, E);
        SEAM(5);
    }
    if (IN(6)) { row_pass<6>(F); SEAM(6); }
    if (IN(7)) {
        pg8::Gemm g{(const bf16*)(ws + WS_U), (const bf16*)(ws + WS_WGU), D, D}; pg8::StaticOrder S; S.init(M, NGU, F.G, (int)blockIdx.x);
        pg8::EpiGLU E{(bf16*)(ws + WS_H), (float*)(ws + WS_GH), (float*)(ws + WS_UPH), F.in[I_CW], F.in[I_CB], (PG8_LAS float*)(F.lds + RING_BYTES)};
        pg8::gemm_phase<pg8::EpiGLU, pg8::StaticOrder, true, true>(F.lds + RING_OFF, g, S, E);
        SEAM(7);
    }
    if (IN(8)) { p8_fixup(F); SEAM(8); }
    if (IN(9)) {
        pg8::Gemm g{(const bf16*)(ws + WS_H), (const bf16*)(ws + WS_WD), FF, FF}; pg8::StaticOrder S; S.init(M, D, F.G, (int)blockIdx.x);
        pg8::EpiZ<true, 0> E{(const float*)(ws + WS_Z1), F.out, (const float*)(ws + WS_MOD) + 5 * 4096, (const float*)(ws + WS_RS1), F.in[I_LN1G], F.in[I_LN1B]};
        pg8::gemm_phase<pg8::EpiZ<true, 0>, pg8::StaticOrder, true, true>(F.lds + RING_OFF, g, S, E);
        SEAM(9);
    }
    if (IN(10)) { row_pass<10>(F); }
#undef IN
#undef SEAM
}

extern "C" void kernel_launch(void* const* d_in, const int* in_sizes, int n_in, void* d_out, int out_size, void* d_ws, size_t ws_size, hipStream_t stream) {
    static int grid = 0;
    if (grid == 0) {
        if (n_in != 21 || in_sizes[0] != M * D || out_size != M * D || ws_size < WS_END) { fprintf(stderr, "kernel_launch: unexpected shapes (n_in %d, in0 %d, out %d, ws %zu); nothing launched\n", n_in, n_in > 0 ? in_sizes[0] : -1, out_size, ws_size); grid = -1; return; }
        int dev = 0, cus = 0, per_cu = 0;
        if (hipGetDevice(&dev) != hipSuccess || hipDeviceGetAttribute(&cus, hipDeviceAttributeMultiprocessorCount, dev) != hipSuccess) { grid = -1; return; }
        if (hipFuncSetAttribute((const void*)skel_fwd, hipFuncAttributeMaxDynamicSharedMemorySize, LDS_BYTES) != hipSuccess) { fprintf(stderr, "kernel_launch: hipFuncSetAttribute failed\n"); grid = -1; return; }
        if (hipOccupancyMaxActiveBlocksPerMultiprocessor(&per_cu, (const void*)skel_fwd, NWAVES * 64, LDS_BYTES) != hipSuccess || per_cu < 1)
            fprintf(stderr, "kernel_launch: note: occupancy query reports %d workgroups per CU\n", per_cu);
        (void)hipGetLastError();
        grid = cus;
    }
    if (grid < 0) return;
    if (hipMemsetAsync((char*)d_ws + WS_CTL, 0, CTL_ZERO_BYTES, stream) != hipSuccess) return;
    Args a{};
    for (int i = 0; i < 21; ++i) a.in[i] = (const float*)d_in[i];
    a.out = (float*)d_out; a.ws = (unsigned char*)d_ws;
#if MK_ONE_LAUNCH
    a.ph_lo = 0; a.ph_hi = N_PHASES;
    hipLaunchKernelGGL(skel_fwd, dim3(grid), dim3(NWAVES * 64), LDS_BYTES, stream, a);
#else
    for (int p = 0; p < N_PHASES; ++p) { a.ph_lo = p; a.ph_hi = p + 1; hipLaunchKernelGGL(skel_fwd, dim3(grid), dim3(NWAVES * 64), LDS_BYTES, stream, a); }
#endif
}
```

```cpp
#include <hip/hip_runtime.h>
#include <cstdio>
#include <cstdint>

namespace pg8 {
#define PG8_LAS __attribute__((address_space(3)))
typedef unsigned short bf16_t;
typedef short bf16x8 __attribute__((ext_vector_type(8)));
typedef float f32x4 __attribute__((ext_vector_type(4)));
typedef unsigned u32x4 __attribute__((ext_vector_type(4)));
constexpr int BM = 256, BK = 64, HALF = 128, HTB = HALF * BK * 2  , STAGE_BYTES = 8 * HTB, NXCD = 8, WGM = 8;

__host__ __device__ __forceinline__ int lds_byte(int r, int c) { const int st = (r >> 4) * 2 + (c >> 5), rr = r & 15, cc = c & 31, ob = rr * 64 + cc * 2; return st * 1024 + (ob ^ (((ob >> 9) & 1) << 5)); }
__host__ __device__ __forceinline__ void stage_rc(int b, int& R, int& C) { const int st = b / 1024, sb = b % 1024, swz = sb ^ (((sb >> 9) & 1) << 5); R = (st >> 1) * 16 + swz / 64; C = (st & 1) * 32 + (swz % 64) / 2; }
__host__ __device__ __forceinline__ int perm32(int rho) { const int n = rho >> 4, i = rho & 15; return 8 * (i >> 2) + 4 * n + (i & 3); }

struct Unit { int pm, pn; };
struct Gemm { const bf16_t* A; const bf16_t* Bt; int lda, K; };
typedef int i32x4 __attribute__((ext_vector_type(4)));
typedef int i32x8 __attribute__((ext_vector_type(8)));
__device__ __forceinline__ i32x8 cat8(bf16x8 lo, bf16x8 hi) { return __builtin_shufflevector(__builtin_bit_cast(i32x4, lo), __builtin_bit_cast(i32x4, hi), 0, 1, 2, 3, 4, 5, 6, 7); }

struct StaticOrder {
    int nM, nN, nwg, G, c;
    __host__ __device__ void init(int M, int N, int G_, int c_) { nM = M / BM; nN = N / BM; nwg = nM * nN; G = G_; c = c_; }
    __host__ __device__ bool next(int i, Unit& u) const {
        const long L = (long)i * G + c; if (L >= nwg) return false;
        int wgid = (int)L; { const int q = nwg / NXCD, r = nwg % NXCD, xcd = wgid % NXCD, off = wgid / NXCD; wgid = (xcd < r ? xcd * (q + 1) : r * (q + 1) + (xcd - r) * q) + off; }
        const int nig = WGM * nN, gid = wgid / nig, fm = gid * WGM, gsz = (nM - fm) < WGM ? (nM - fm) : WGM;
        u.pm = fm + ((wgid % nig) % gsz); u.pn = (wgid % nig) / gsz; return true;
    }
    __device__ __forceinline__ void a_ready(const Unit&) const {}
    __device__ __forceinline__ void done(const Unit&) const {}
};

__device__ __forceinline__ unsigned cvt_pk_bf16(float lo, float hi) { unsigned r; asm volatile("v_cvt_pk_bf16_f32 %0, %1, %2" : "=v"(r) : "v"(lo), "v"(hi)); return r; }
__device__ __forceinline__ u32x4 pack8(const f32x4 v0, const f32x4 v1) { u32x4 w; w.x = cvt_pk_bf16(v0[0], v0[1]); w.y = cvt_pk_bf16(v0[2], v0[3]); w.z = cvt_pk_bf16(v1[0], v1[1]); w.w = cvt_pk_bf16(v1[2], v1[3]); return w; }
typedef unsigned u32x2 __attribute__((ext_vector_type(2)));
__device__ __forceinline__ u32x2 pack8f8(const f32x4 v0, const f32x4 v1) { int w0 = 0, w1 = 0; w0 = __builtin_amdgcn_cvt_pk_fp8_f32(v0[0], v0[1], w0, false); w0 = __builtin_amdgcn_cvt_pk_fp8_f32(v0[2], v0[3], w0, true);
    w1 = __builtin_amdgcn_cvt_pk_fp8_f32(v1[0], v1[1], w1, false); w1 = __builtin_amdgcn_cvt_pk_fp8_f32(v1[2], v1[3], w1, true); return (u32x2){(unsigned)w0, (unsigned)w1}; }
__device__ __forceinline__ void rope8(f32x4& v0, f32x4& v1, const float* rp) {
    const f32x4 c0 = *(const f32x4*)rp, c1 = *(const f32x4*)(rp + 4);
    float a, b;
    a = v0[0] * c0[0] - v0[1] * c0[1]; b = v0[0] * c0[1] + v0[1] * c0[0]; v0[0] = a; v0[1] = b;
    a = v0[2] * c0[2] - v0[3] * c0[3]; b = v0[2] * c0[3] + v0[3] * c0[2]; v0[2] = a; v0[3] = b;
    a = v1[0] * c1[0] - v1[1] * c1[1]; b = v1[0] * c1[1] + v1[1] * c1[0]; v1[0] = a; v1[1] = b;
    a = v1[2] * c1[2] - v1[3] * c1[3]; b = v1[2] * c1[3] + v1[3] * c1[2]; v1[2] = a; v1[3] = b;
}

struct EpiPlain {
    static constexpr bool PERM = true, AFTER_DRAIN = false;
    bf16_t* O; int ldc;
    __device__ __forceinline__ void operator()(const f32x4 (&acc)[2][2][4][2], const Unit& u, int wr, int wc, int fr, int fq) const {
        const int row0 = u.pm * BM + wr * 64 + fr, col0 = u.pn * BM + wc * 32 + 8 * fq;
#pragma unroll
        for (int ai = 0; ai < 2; ++ai)
#pragma unroll
            for (int m = 0; m < 4; ++m) { bf16_t* rowp = O + (size_t)(row0 + ai * HALF + m * 16) * ldc + col0;
#pragma unroll
                for (int bj = 0; bj < 2; ++bj) *(u32x4*)(rowp + bj * HALF) = pack8(acc[ai][bj][m][0], acc[ai][bj][m][1]); }
    }
};

template <bool F8> struct EpiProj {
    static constexpr bool PERM = true, AFTER_DRAIN = false;
    bf16_t *AQ, *AKV, *IQ, *IKX, *QL, *KVL; float *IW, *RSQQ, *RSQK; const float* ROPE; unsigned char* KR8;
    __device__ __forceinline__ void operator()(const f32x4 (&acc)[2][2][4][2], const Unit& u, int wr, int wc, int fr, int fq) const {
        const int pn = F8 ? (u.pn <= 9 ? u.pn : u.pn + 16) : (u.pn < 15 ? u.pn + 10 : 25);
        bf16_t* dst; int pitch, coff, kind = 0; unsigned ropemask = 0u;
        if (pn < 8) { dst = AQ; pitch = 2048; coff = pn * 256; }
        else if (pn == 8) { dst = AKV; pitch = 256; coff = 0; }
        else if (pn < 25) { dst = IQ; pitch = 4096; coff = (pn - 9) * 256; ropemask = 0xAu; }
        else if (pn == 25) { dst = IKX; pitch = 256; coff = 0; ropemask = 0x6u; kind = 3; }
        else if (pn < 30) { dst = QL; pitch = 1024; coff = (pn - 26) * 256; kind = 1; }
        else { dst = KVL; pitch = 512; coff = (pn - 30) * 256; kind = 2; }
        const int row0 = u.pm * BM + wr * 64 + fr, lc0 = wc * 32 + 8 * fq, i0 = 16 * (wc & 1) + 4 * fq;
#pragma unroll
        for (int ai = 0; ai < 2; ++ai)
#pragma unroll
            for (int m = 0; m < 4; ++m) {
                const int row = row0 + ai * HALF + m * 16; float ss = 0.f;
#pragma unroll
                for (int bj = 0; bj < 2; ++bj) {
                    f32x4 v0 = acc[ai][bj][m][0], v1 = acc[ai][bj][m][1];
                    if (F8) { v0 = v0 * (1.0f / 64.0f); v1 = v1 * (1.0f / 64.0f); }
                    if (pn < 8) { v0 = v0 * (8.0f * 0.08838834764831845f * 1.4426950408889634f); v1 = v1 * (8.0f * 0.08838834764831845f * 1.4426950408889634f); }
                    if (pn == 8 && bj == 0) { v0 = v0 * 0.125f; v1 = v1 * 0.125f; }
                    if ((ropemask >> (2 * bj + (wc >> 1))) & 1u) rope8(v0, v1, ROPE + ((size_t)row * 32 + i0) * 2);
                    if (kind == 1 || kind == 2) ss += (v0[0] * v0[0] + v0[1] * v0[1]) + (v0[2] * v0[2] + v0[3] * v0[3]) + (v1[0] * v1[0] + v1[1] * v1[1]) + (v1[2] * v1[2] + v1[3] * v1[3]);
                    if (kind == 3 && bj == 1 && wc == 2) { float* iw = IW + (size_t)row * 32 + 8 * fq; *(f32x4*)iw = v0; *(f32x4*)(iw + 4) = v1; }
                    if (kind == 3 && bj == 1 && wc < 2) *(u32x2*)(KR8 + (size_t)row * 2048 + lc0) = pack8f8(v0 * 0.125f, v1 * 0.125f);
                    if (kind == 1 || kind == 2 || pn <= 8) *(u32x2*)((unsigned char*)dst + (size_t)row * pitch + coff + lc0 + bj * HALF) = pack8f8(v0, v1);
                    else *(u32x4*)(dst + (size_t)row * pitch + coff + lc0 + bj * HALF) = pack8(v0, v1);
                }
                if (kind == 1 || kind == 2) {
                    ss += __shfl_xor(ss, 16); ss += __shfl_xor(ss, 32);
                    if (fq == 0) { if (kind == 1) RSQQ[(size_t)row * 16 + (pn - 26) * 4 + wc] = ss; else RSQK[(size_t)row * 8 + (pn - 30) * 4 + wc] = ss; }
                }
            }
    }
};

template <bool ISQ> struct EpiUp {
    static constexpr bool PERM = true, AFTER_DRAIN = false;
    bf16_t* O; int ldc; const float* RSQ; const float* ROPE;
    __device__ __forceinline__ void operator()(const f32x4 (&acc)[2][2][4][2], const Unit& u, int wr, int wc, int fr, int fq) const {
        const int row0 = u.pm * BM + wr * 64 + fr, col0 = u.pn * BM + wc * 32 + 8 * fq, i0 = 16 * (wc & 1) + 4 * fq;
#pragma unroll
        for (int ai = 0; ai < 2; ++ai)
#pragma unroll
            for (int m = 0; m < 4; ++m) {
                const int row = row0 + ai * HALF + m * 16; float rs;
                if (ISQ) { const f32x4* p = (const f32x4*)(RSQ + (size_t)row * 16); const f32x4 a = p[0], b = p[1], c = p[2], d = p[3];
                    const float s = ((a[0] + a[1]) + (a[2] + a[3])) + ((b[0] + b[1]) + (b[2] + b[3])) + ((c[0] + c[1]) + (c[2] + c[3])) + ((d[0] + d[1]) + (d[2] + d[3]));
                    rs = (8.0f * 0.07216878364870322f * 1.4426950408889634f / 32.0f) / sqrtf(s * (1.0f / 1024.0f) + 1e-6f); }
                else { const f32x4* p = (const f32x4*)(RSQ + (size_t)row * 8); const f32x4 a = p[0], b = p[1];
                    const float s = ((a[0] + a[1]) + (a[2] + a[3])) + ((b[0] + b[1]) + (b[2] + b[3]));
                    rs = (0.125f / 16.0f) / sqrtf(s * (1.0f / 512.0f) + 1e-6f); }
#pragma unroll
                for (int bj = 0; bj < 2; ++bj) {
                    f32x4 v0 = acc[ai][bj][m][0] * rs, v1 = acc[ai][bj][m][1] * rs;
                    if (ISQ) { if ((4 * u.pn + 2 * bj + (wc >> 1)) % 3 == 2) rope8(v0, v1, ROPE + ((size_t)row * 32 + i0) * 2); }
                    *(u32x2*)((unsigned char*)O + (size_t)row * ldc + col0 + bj * HALF) = pack8f8(v0, v1);
                }
            }
    }
};

struct EpiVT {
    static constexpr bool PERM = true, AFTER_DRAIN = false;
    bf16_t* O; const float* RSQ;
    __device__ __forceinline__ void operator()(const f32x4 (&acc)[2][2][4][2], const Unit& u, int wr, int wc, int fr, int fq) const {
        const int row0 = u.pm * BM + wr * 64 + fr, col0 = u.pn * BM + wc * 32 + 8 * fq;
        f32x4 rs[2][2];
#pragma unroll
        for (int bj = 0; bj < 2; ++bj)
#pragma unroll
            for (int e = 0; e < 8; ++e) { const f32x4* p = (const f32x4*)(RSQ + (size_t)(col0 + bj * HALF + e) * 8); const f32x4 a = p[0], b = p[1];
                const float s = ((a[0] + a[1]) + (a[2] + a[3])) + ((b[0] + b[1]) + (b[2] + b[3]));
                rs[bj][e >> 2][e & 3] = (1.0f / 16.0f) / sqrtf(s * (1.0f / 512.0f) + 1e-6f); }
#pragma unroll
        for (int ai = 0; ai < 2; ++ai)
#pragma unroll
            for (int m = 0; m < 4; ++m) { unsigned char* rowp = (unsigned char*)O + (size_t)(row0 + ai * HALF + m * 16) * 8192 + col0;
#pragma unroll
                for (int bj = 0; bj < 2; ++bj) *(u32x2*)(rowp + bj * HALF) = pack8f8(acc[ai][bj][m][0] * rs[bj][0], acc[ai][bj][m][1] * rs[bj][1]); }
    }
};

struct EpiGLU {
    static constexpr bool PERM = true, AFTER_DRAIN = false;
    bf16_t* H; float* GH; float* UPH; const float* cw; const float* cb; PG8_LAS float* halo;
    static __device__ __forceinline__ float shr1(float prev, float cur) { return __builtin_bit_cast(float, __builtin_amdgcn_update_dpp(__builtin_amdgcn_update_dpp(0, __builtin_bit_cast(int, prev), 0x121, 0xf, 0xf, false), __builtin_bit_cast(int, cur), 0x111, 0xf, 0xf, false)); }
    static __device__ __forceinline__ float shr2(float prev, float cur) { return __builtin_bit_cast(float, __builtin_amdgcn_update_dpp(__builtin_amdgcn_update_dpp(0, __builtin_bit_cast(int, prev), 0x122, 0xf, 0xf, false), __builtin_bit_cast(int, cur), 0x112, 0xf, 0xf, false)); }
    __device__ __forceinline__ void operator()(const f32x4 (&acc)[2][2][4][2], const Unit& u, int wr, int wc, int fr, int fq) const {
        constexpr int FFN = 11008;
        const int c0 = u.pn * 128 + wc * 32 + 8 * fq, lc = wc * 32 + 8 * fq;
        float w0[8], w1[8], w2[8], bs[8];
#pragma unroll
        for (int e = 0; e < 8; e += 4) { const f32x4 a = *(const f32x4*)(cw + c0 + e), b = *(const f32x4*)(cw + FFN + c0 + e), d = *(const f32x4*)(cw + 2 * FFN + c0 + e), s = *(const f32x4*)(cb + c0 + e);
#pragma unroll
            for (int k = 0; k < 4; ++k) { w0[e + k] = a[k]; w1[e + k] = b[k]; w2[e + k] = d[k]; bs[e + k] = s[k]; } }
#pragma unroll
        for (int ai = 0; ai < 2; ++ai) { const int q = 2 * ai + wr;
            if (fr >= 14) { if (q < 3) { PG8_LAS float* hp = halo + ((q + 1) * 2 + (fr - 14)) * 128 + lc; *(PG8_LAS f32x4*)hp = acc[ai][0][3][0]; *(PG8_LAS f32x4*)(hp + 4) = acc[ai][0][3][1]; }
                            else { float* gp = GH + ((size_t)u.pm * 4 + 2 + (fr - 14)) * FFN + c0; *(f32x4*)gp = acc[ai][0][3][0]; *(f32x4*)(gp + 4) = acc[ai][0][3][1]; } }
            if (q == 0 && fr < 2) { float* gp = GH + ((size_t)u.pm * 4 + fr) * FFN + c0; *(f32x4*)gp = acc[0][0][0][0]; *(f32x4*)(gp + 4) = acc[0][0][0][1];
                                    float* up = UPH + ((size_t)u.pm * 2 + fr) * FFN + c0; *(f32x4*)up = acc[0][1][0][0]; *(f32x4*)(up + 4) = acc[0][1][0][1]; } }
        asm volatile("s_waitcnt lgkmcnt(0)" ::: "memory"); __builtin_amdgcn_s_barrier(); asm volatile("" ::: "memory");
#pragma unroll
        for (int ai = 0; ai < 2; ++ai) { const int q = 2 * ai + wr;
            f32x4 hp0 = (f32x4){0.f, 0.f, 0.f, 0.f}, hp1 = hp0;
            if (q > 0 && fr >= 14) { const PG8_LAS float* hp = halo + (q * 2 + (fr - 14)) * 128 + lc; hp0 = *(const PG8_LAS f32x4*)hp; hp1 = *(const PG8_LAS f32x4*)(hp + 4); }
#pragma unroll
            for (int m = 0; m < 4; ++m) {
                f32x4 o0, o1;
#pragma unroll
                for (int j = 0; j < 8; ++j) { const float G = j < 4 ? acc[ai][0][m][0][j & 3] : acc[ai][0][m][1][j & 3], UP = j < 4 ? acc[ai][1][m][0][j & 3] : acc[ai][1][m][1][j & 3];
                    float Gp; if (m == 0) Gp = j < 4 ? hp0[j & 3] : hp1[j & 3]; else Gp = j < 4 ? acc[ai][0][m > 0 ? m - 1 : 0][0][j & 3] : acc[ai][0][m > 0 ? m - 1 : 0][1][j & 3];
                    const float p1 = shr1(Gp, G), p2 = shr2(Gp, G);
                    const float g = bs[j] + w0[j] * p2 + w1[j] * p1 + w2[j] * G;
                    const float hv = g * __builtin_amdgcn_rcpf(1.0f + __builtin_amdgcn_exp2f(-1.4426950408889634f * g)) * UP;
                    if (j < 4) o0[j & 3] = hv; else o1[j & 3] = hv; }
                *(u32x4*)(H + (size_t)(u.pm * BM + ai * HALF + wr * 64 + m * 16 + fr) * FFN + c0) = pack8(o0, o1);
            }
        }
    }
};

template <bool LNR, int ASH> struct EpiZ {
    static constexpr bool PERM = false, AFTER_DRAIN = false;
    const float* R; float* Z; const float* gate;
    static constexpr float alpha = 1.189207115002721f, ascale = 1.0f / (float)(1 << ASH);
    const float* RS; const float* LG; const float* LB;
    __device__ __forceinline__ void operator()(const f32x4 (&acc)[2][2][4][2], const Unit& u, int wr, int wc, int fr, int fq) const {
        const int row0 = u.pm * BM + wr * 64 + fr, col0 = u.pn * BM + wc * 32 + 4 * fq;
        const float* gp = gate + (size_t)((u.pm * BM) >> 11) * 24576 + col0;
#pragma unroll
        for (int bj = 0; bj < 2; ++bj)
#pragma unroll
            for (int n = 0; n < 2; ++n) {
                const f32x4 gv = (*(const f32x4*)(gp + bj * HALF + 16 * n) + 1.0f) * ascale; f32x4 lg = gv, lb = gv;
                if (LNR) { lg = *(const f32x4*)(LG + col0 + bj * HALF + 16 * n) * alpha; lb = *(const f32x4*)(LB + col0 + bj * HALF + 16 * n) * alpha; }
#pragma unroll
                for (int ai = 0; ai < 2; ++ai)
#pragma unroll
                    for (int m = 0; m < 4; ++m) { const int row = row0 + ai * HALF + m * 16; const size_t ro = (size_t)row * 4096 + col0 + bj * HALF + 16 * n;
                        const f32x4 r = *(const f32x4*)(R + ro); f32x4 res;
                        if (LNR) { typedef float f32x2 __attribute__((ext_vector_type(2))); const f32x2 ms = *(const f32x2*)(RS + 2 * (size_t)row); res = (r - ms.x) * ms.y * lg + lb; } else res = r * alpha;
                        *(f32x4*)(Z + ro) = res + gv * acc[ai][bj][m][n]; } }
    }
};

template <class Epi, class Sched, bool ALIGN_EPI = false, bool SP2 = false, bool FP8 = false>
__device__ __forceinline__ void gemm_phase(PG8_LAS unsigned char* lds, const Gemm g, const Sched& S, const Epi& E) {
    const int tid = threadIdx.x, wid = __builtin_amdgcn_readfirstlane(tid >> 6), lane = tid & 63, wr = wid >> 2, wc = wid & 3, fr = lane & 15, fq = lane >> 4;
    const int K = g.K, nt = K / BK, lda = g.lda;
    unsigned voffA[2], voffB[2];
#pragma unroll
    for (int i = 0; i < 2; ++i) { int R, C; stage_rc(tid * 16 + i * 8192, R, C); const int Rb = Epi::PERM ? ((R & ~31) + perm32(R & 31)) : R;
        voffA[i] = (unsigned)(R * lda + C) * 2u; voffB[i] = (unsigned)(Rb * K + C) * 2u; }
    const size_t kstep = (size_t)(BK * 2);
    const size_t hstep = (size_t)HALF * K * 2, hstepA = (size_t)HALF * lda * 2;
    const size_t tstep = 2 * hstep, tstepA = 2 * hstepA;
    const unsigned ldsw = (unsigned)wid * 1024u;
    const int aoff = lds_byte(wr * 64 + fr, fq * 8), boff = lds_byte(wc * 32 + fr, fq * 8);
#define PG8_SA(b, h) (((b) * 2 + (h)) * HTB)
#define PG8_SB(b, h) ((4 + (b) * 2 + (h)) * HTB)
#define PG8_STAGE(bufoff, gbase, voff) do { _Pragma("unroll") for (int _i = 0; _i < 2; ++_i) \
        __builtin_amdgcn_global_load_lds((const unsigned*)((const char*)(gbase) + (voff)[_i]), (PG8_LAS unsigned*)(lds + (bufoff) + ldsw + _i * 8192), 16, 0, 0); } while (0)
#define PG8_LDA(dst, b, h) do { if constexpr (FP8) { _Pragma("unroll") for (int m = 0; m < 4; ++m) dst##8[m] = __builtin_shufflevector(*(const PG8_LAS i32x4*)(lds + PG8_SA(b, h) + aoff + m * 2048), *(const PG8_LAS i32x4*)(lds + PG8_SA(b, h) + aoff + m * 2048 + 1024), 0, 1, 2, 3, 4, 5, 6, 7); } \
        else { _Pragma("unroll") for (int m = 0; m < 4; ++m) _Pragma("unroll") for (int k = 0; k < 2; ++k) dst[m][k] = *(const PG8_LAS bf16x8*)(lds + PG8_SA(b, h) + aoff + m * 2048 + k * 1024); } } while (0)
#define PG8_LDB(dst, b, h) do { if constexpr (FP8) { _Pragma("unroll") for (int n = 0; n < 2; ++n) dst##8[n] = __builtin_shufflevector(*(const PG8_LAS i32x4*)(lds + PG8_SB(b, h) + boff + n * 2048), *(const PG8_LAS i32x4*)(lds + PG8_SB(b, h) + boff + n * 2048 + 1024), 0, 1, 2, 3, 4, 5, 6, 7); } \
        else { _Pragma("unroll") for (int n = 0; n < 2; ++n) _Pragma("unroll") for (int k = 0; k < 2; ++k) dst[n][k] = *(const PG8_LAS bf16x8*)(lds + PG8_SB(b, h) + boff + n * 2048 + k * 1024); } } while (0)
#define PG8_MMA(ai, bj, At, Bt) do { __builtin_amdgcn_s_setprio(1); \
        if constexpr (FP8) { _Pragma("unroll") for (int m = 0; m < 4; ++m) _Pragma("unroll") for (int n = 0; n < 2; ++n) \
            asm volatile("v_mfma_f32_16x16x128_f8f6f4 %0, %1, %2, %0" : "+v"(acc[ai][bj][m][n]) : "v"(Bt##8[n]), "v"(At##8[m])); } \
        else { _Pragma("unroll") for (int m = 0; m < 4; ++m) _Pragma("unroll") for (int n = 0; n < 2; ++n) _Pragma("unroll") for (int k = 0; k < 2; ++k) \
            acc[ai][bj][m][n] = __builtin_amdgcn_mfma_f32_16x16x32_bf16(Bt[n][k], At[m][k], acc[ai][bj][m][n], 0, 0, 0); } \
        __builtin_amdgcn_s_setprio(0); } while (0)
#define PG8_WAIT_V(n) asm volatile("s_waitcnt vmcnt(" #n ")" ::: "memory")
#define PG8_WAIT_L(n) asm volatile("s_waitcnt lgkmcnt(" #n ")" ::: "memory")
#define PG8_BAR __builtin_amdgcn_s_barrier()
#define PG8_SCHED __builtin_amdgcn_sched_barrier(0)
    Unit cur, nxt; int ui = 0;
    if (!S.next(0, cur)) return;
    f32x4 acc[2][2][4][2];
#pragma unroll
    for (int a = 0; a < 2; ++a)
#pragma unroll
        for (int b = 0; b < 2; ++b)
#pragma unroll
            for (int m = 0; m < 4; ++m)
#pragma unroll
                for (int n = 0; n < 2; ++n) acc[a][b][m][n] = (f32x4){0.f, 0.f, 0.f, 0.f};
    bf16x8 At[4][2], B0[2][2], B1[2][2]; i32x8 At8[4], B08[2], B18[2];
    const char* cA = (const char*)g.A + (size_t)cur.pm * tstepA; const char* cB = (const char*)g.Bt + (size_t)cur.pn * tstep;
    S.a_ready(cur);
    if constexpr (SP2) {
        PG8_STAGE(PG8_SB(0, 0), cB, voffB); PG8_STAGE(PG8_SB(0, 1), cB + hstep, voffB); PG8_STAGE(PG8_SA(0, 0), cA, voffA); PG8_STAGE(PG8_SA(0, 1), cA + hstepA, voffA);
        if (wr == 1) PG8_BAR;
        PG8_WAIT_V(2); PG8_BAR;
        PG8_STAGE(PG8_SB(1, 0), cB + kstep, voffB); PG8_STAGE(PG8_SA(1, 0), cA + kstep, voffA); PG8_STAGE(PG8_SB(1, 1), cB + hstep + kstep, voffB);
        PG8_WAIT_V(6); PG8_BAR;
    } else {
        PG8_STAGE(PG8_SB(0, 0), cB, voffB); PG8_STAGE(PG8_SA(0, 0), cA, voffA); PG8_STAGE(PG8_SB(0, 1), cB + hstep, voffB); PG8_STAGE(PG8_SA(0, 1), cA + hstepA, voffA);
        if (wr == 1) PG8_BAR;
        PG8_WAIT_V(4); PG8_BAR;
        PG8_STAGE(PG8_SB(1, 0), cB + kstep, voffB); PG8_STAGE(PG8_SA(1, 0), cA + kstep, voffA); PG8_STAGE(PG8_SB(1, 1), cB + hstep + kstep, voffB);
        PG8_WAIT_V(6); PG8_BAR;
    }
    for (;;) {
        const bool has_next = S.next(ui + 1, nxt);
        const char* nA = has_next ? (const char*)g.A + (size_t)nxt.pm * tstepA : cA; const char* nB = has_next ? (const char*)g.Bt + (size_t)nxt.pn * tstep : cB;
        for (int t = 0; t < nt; t += 2) {
            const bool last = (t == nt - 2);
            const char* a1 = cA + (size_t)(t + 1) * kstep;
            const char* a2 = last ? nA : cA + (size_t)(t + 2) * kstep; const char* b2 = last ? nB : cB + (size_t)(t + 2) * kstep;
            const char* a3 = a2 + kstep; const char* b3 = b2 + kstep;
            if (last && has_next) S.a_ready(nxt);
            if constexpr (SP2) {
            PG8_LDB(B0, 0, 0); PG8_LDB(B1, 0, 1); PG8_SCHED; PG8_LDA(At, 0, 0); PG8_STAGE(PG8_SA(1, 1), a1 + hstepA, voffA);
            PG8_WAIT_V(8); PG8_WAIT_L(0); PG8_BAR; PG8_MMA(0, 0, At, B0); PG8_MMA(0, 1, At, B1); PG8_BAR; PG8_SCHED;
            PG8_LDA(At, 0, 1); PG8_STAGE(PG8_SB(0, 0), b2, voffB); PG8_STAGE(PG8_SB(0, 1), b2 + hstep, voffB); PG8_STAGE(PG8_SA(0, 0), a2, voffA);
            PG8_WAIT_V(8); PG8_WAIT_L(0); PG8_BAR; PG8_MMA(1, 0, At, B0); PG8_MMA(1, 1, At, B1); PG8_BAR; PG8_SCHED;
            PG8_LDB(B0, 1, 0); PG8_LDB(B1, 1, 1); PG8_SCHED; PG8_LDA(At, 1, 0); PG8_STAGE(PG8_SA(0, 1), a2 + hstepA, voffA);
            PG8_WAIT_V(8); PG8_WAIT_L(0); PG8_BAR; PG8_MMA(0, 0, At, B0); PG8_MMA(0, 1, At, B1); PG8_BAR; PG8_SCHED;
            PG8_LDA(At, 1, 1); PG8_STAGE(PG8_SB(1, 0), b3, voffB); PG8_STAGE(PG8_SB(1, 1), b3 + hstep, voffB); PG8_STAGE(PG8_SA(1, 0), a3, voffA);
            PG8_WAIT_V(8); PG8_WAIT_L(0); PG8_BAR; PG8_MMA(1, 0, At, B0); PG8_MMA(1, 1, At, B1); PG8_BAR; PG8_SCHED;
            } else {
            PG8_LDB(B0, 0, 0); PG8_SCHED; PG8_LDA(At, 0, 0); PG8_STAGE(PG8_SA(1, 1), a1 + hstepA, voffA);
            PG8_WAIT_L(8); PG8_BAR; PG8_WAIT_L(0); PG8_MMA(0, 0, At, B0); PG8_BAR; PG8_SCHED;
            PG8_LDB(B1, 0, 1); PG8_STAGE(PG8_SB(0, 0), b2, voffB);
            PG8_BAR; PG8_WAIT_L(0); PG8_MMA(0, 1, At, B1); PG8_BAR;
            PG8_LDA(At, 0, 1); PG8_STAGE(PG8_SA(0, 0), a2, voffA);
            PG8_BAR; PG8_WAIT_L(0); PG8_MMA(1, 0, At, B0); PG8_BAR; PG8_SCHED;
            PG8_STAGE(PG8_SB(0, 1), b2 + hstep, voffB);
            PG8_WAIT_V(6); PG8_BAR; PG8_MMA(1, 1, At, B1); PG8_BAR;
            PG8_LDB(B0, 1, 0); PG8_SCHED; PG8_LDA(At, 1, 0); PG8_STAGE(PG8_SA(0, 1), a2 + hstepA, voffA);
            PG8_WAIT_L(8); PG8_BAR; PG8_WAIT_L(0); PG8_MMA(0, 0, At, B0); PG8_BAR; PG8_SCHED;
            PG8_LDB(B1, 1, 1); PG8_STAGE(PG8_SB(1, 0), b3, voffB);
            PG8_BAR; PG8_WAIT_L(0); PG8_MMA(0, 1, At, B1); PG8_BAR;
            PG8_LDA(At, 1, 1); PG8_STAGE(PG8_SA(1, 0), a3, voffA);
            PG8_BAR; PG8_WAIT_L(0); PG8_MMA(1, 0, At, B0); PG8_BAR; PG8_SCHED;
            PG8_STAGE(PG8_SB(1, 1), b3 + hstep, voffB);
            PG8_WAIT_V(6); PG8_BAR; PG8_MMA(1, 1, At, B1); PG8_BAR;
            }
        }
        if constexpr (ALIGN_EPI) { if (wr == 0) PG8_BAR; }
        if constexpr (!Epi::AFTER_DRAIN) { E(acc, cur, wr, wc, fr, fq); S.done(cur); }
        if (!has_next) break;
#pragma unroll
        for (int a = 0; a < 2; ++a)
#pragma unroll
            for (int b = 0; b < 2; ++b)
#pragma unroll
                for (int m = 0; m < 4; ++m)
#pragma unroll
                    for (int n = 0; n < 2; ++n) acc[a][b][m][n] = (f32x4){0.f, 0.f, 0.f, 0.f};
        cur = nxt; cA = nA; cB = nB; ++ui;
        if constexpr (ALIGN_EPI) { if (wr == 1) PG8_BAR; }
    }
    PG8_WAIT_V(0);
    if constexpr (!ALIGN_EPI) { if (wr == 0) PG8_BAR; }
    PG8_BAR;
    if constexpr (Epi::AFTER_DRAIN) { E.fused(acc, cur, wr, wc, fr, fq, lds, wid, lane); S.done(cur); }
#undef PG8_SA
#undef PG8_SB
#undef PG8_STAGE
#undef PG8_LDA
#undef PG8_LDB
#undef PG8_MMA
#undef PG8_WAIT_V
#undef PG8_WAIT_L
#undef PG8_BAR
#undef PG8_SCHED
}
}
constexpr int NWAVES = 8;
constexpr int BATCH = 4, SEQ = 2048, D = 4096, M = BATCH * SEQ, FF = 11008, NIN = 8192  , NGU = 2 * FF;
constexpr int N_PHASES = 11;
#ifndef DSA_NAIVE
#define DSA_NAIVE 0
#endif
#ifndef MK_ONE_LAUNCH
#define MK_ONE_LAUNCH 1
#endif
constexpr float LN_EPS = 1e-5f, ALPHA = 1.189207115002721f;

constexpr size_t MiB = 1u << 20;
constexpr size_t WS_CTL = 0, CTL_ZERO_BYTES = 1 * MiB;
constexpr size_t WS_MOD = 1 * MiB, WS_ROPE = 2 * MiB, WS_RSQQ = 4 * MiB, WS_RSQK = 4 * MiB + 512 * 1024, WS_IW = 5 * MiB, WS_VTA = 6 * MiB, WS_RS1 = 4 * MiB + 768 * 1024  ;
constexpr size_t WS_WIN = 8 * MiB  , WS_WINB = 24 * MiB  , WS_WUQ = 72 * MiB, WS_WUKV = 78 * MiB, WS_WO = 82 * MiB, WS_WGU = 114 * MiB, WS_WD = 286 * MiB;
constexpr size_t WS_U = 372 * MiB, WS_AQ = 436 * MiB, WS_AKV = 468 * MiB, WS_IQ = 472 * MiB, WS_IKX = 536 * MiB, WS_QL = 540 * MiB, WS_KVL = 556 * MiB;
constexpr size_t WS_QB = 564 * MiB, WS_KV = 612 * MiB, WS_KN = 612 * MiB, WS_VT = 644 * MiB, WS_SC = 676 * MiB, WS_MIX = 740 * MiB, WS_Z1 = 804 * MiB, WS_X1 = 932 * MiB;
constexpr size_t WS_GU = 436 * MiB  , WS_GH = 436 * MiB  , WS_UPH = 444 * MiB  , WS_H = 1060 * MiB, WS_U8 = 1232 * MiB  , WS_KR8 = 1264 * MiB  , WS_END = 1280 * MiB;
constexpr size_t WS_QB8 = WS_QB, WS_KN8 = WS_KN, WS_VT8 = WS_VT, WS_AQ8 = WS_AQ, WS_AKV8 = WS_AKV, WS_VTA8 = WS_VTA;
constexpr int CW_TMO = 0, CW_CODE = 1, CW_BAR = 4096;

constexpr int RING_OFF = 0, RING_BYTES = 131072;
constexpr int LDSCTL_OFF = 135168, MISC_OFF = LDSCTL_OFF + 320;
constexpr int LDS_BYTES = 147456;

#define GAS __attribute__((address_space(1)))
#define LAS __attribute__((address_space(3)))
typedef unsigned short bf16;
typedef unsigned v4u __attribute__((ext_vector_type(4)));
typedef unsigned v2u __attribute__((ext_vector_type(2)));
typedef float f32x4 __attribute__((ext_vector_type(4)));
typedef float f32x2 __attribute__((ext_vector_type(2)));
typedef GAS unsigned gu32;
#define RLX_AGENT __ATOMIC_RELAXED, __HIP_MEMORY_SCOPE_AGENT
#define LDS_WAIT() asm volatile("s_waitcnt lgkmcnt(0)" ::: "memory")
#define VM_WAIT() asm volatile("s_waitcnt vmcnt(0)" ::: "memory")
__device__ __forceinline__ unsigned f2bf(float f) { unsigned u = __builtin_bit_cast(unsigned, f); return (u + 0x7fffu + ((u >> 16) & 1u)) >> 16; }
__device__ __forceinline__ unsigned pk2(float lo, float hi) { return f2bf(lo) | (f2bf(hi) << 16); }
__device__ __forceinline__ float bflo(unsigned w) { return __builtin_bit_cast(float, w << 16); }
__device__ __forceinline__ float bfhi(unsigned w) { return __builtin_bit_cast(float, w & 0xffff0000u); }

#define XB_TMO      128
#define XB_XCNT(j)  (256  + 64 * (j))
#define XB_XSUB(j)  (1280 + 64 * (j))
#define XB_XGEN(j)  (2304 + 64 * (j))
#define XB_TOP      3328
#define XB_TOPGEN   3392
#define XCD_BAR_WORDS 3456
#define XB_SPIN_CAP (1u << 18)
__device__ __forceinline__ unsigned xb_ld(unsigned* p)              { return __hip_atomic_load(p, __ATOMIC_RELAXED, __HIP_MEMORY_SCOPE_AGENT); }
__device__ __forceinline__ unsigned xb_add(unsigned* p, unsigned v) { return __hip_atomic_fetch_add(p, v, __ATOMIC_RELAXED, __HIP_MEMORY_SCOPE_AGENT); }
__device__ __forceinline__ unsigned xb_xcc_id() { return (unsigned)__builtin_amdgcn_s_getreg((3 << 11) | 20) & 0xFu; }
#define XB_SPIN(cond, bar) do { unsigned _sp = 0; while (cond) { __builtin_amdgcn_s_sleep(1); \
    if ((++_sp & 255u) == 0u) { if (xb_ld(&(bar)[XB_TMO])) break; if (_sp > XB_SPIN_CAP) { atomicAdd(&(bar)[XB_TMO], 1u); break; } } } } while (0)
struct XcdBarrier { unsigned* bar; unsigned x; volatile LAS unsigned* st; };
__device__ __forceinline__ XcdBarrier xcd_barrier_post(unsigned* bar, volatile LAS unsigned* st) {
    XcdBarrier b; b.bar = bar; b.x = xb_xcc_id(); b.st = st;
    if (threadIdx.x == 0) (void)xb_add(&bar[XB_XCNT(b.x)], 1u);
    return b;
}
__device__ __forceinline__ void xcd_barrier_complete(unsigned* bar, unsigned x, unsigned& nloc, unsigned& nx) {
    const unsigned G = gridDim.x * gridDim.y * gridDim.z;
    unsigned sum, cnt, mine, sp = 0u;
    for (;;) {
        sum = 0u; cnt = 0u; mine = 0u;
#pragma unroll
        for (unsigned j = 0; j < 16; ++j) { const unsigned c = xb_ld(&bar[XB_XCNT(j)]); sum += c; cnt += (c > 0u) ? 1u : 0u; mine = (j == x) ? c : mine; }
        if (sum == G) break;
        __builtin_amdgcn_s_sleep(1);
        if ((++sp & 255u) == 0u) { if (xb_ld(&bar[XB_TMO])) break; if (sp > XB_SPIN_CAP) { atomicAdd(&bar[XB_TMO], 1u); break; } }
    }
    nloc = mine > 0u ? mine : 1u; nx = cnt > 0u ? cnt : 1u;
}
__device__ __forceinline__ void xcd_barrier(const XcdBarrier& b) {
    asm volatile("s_waitcnt vmcnt(0)" ::: "memory");
    __syncthreads();
    if (threadIdx.x == 0) {
        unsigned* bar = b.bar;
        __builtin_amdgcn_s_waitcnt(0);
        unsigned nloc = b.st[0], nx = b.st[1];
        if (nloc == 0u) { xcd_barrier_complete(bar, b.x, nloc, nx); b.st[0] = nloc; b.st[1] = nx; }
        const unsigned old = xb_add(&bar[XB_XSUB(b.x)], 1u);
        const unsigned gen = old / nloc;
        if (old + 1u == (gen + 1u) * nloc) {
            __builtin_amdgcn_fence(__ATOMIC_RELEASE, "agent");
            asm volatile("s_waitcnt vmcnt(0)" ::: "memory");
            const unsigned og = xb_add(&bar[XB_TOP], 1u);
            const unsigned tg = og / nx;
            if (og + 1u == (tg + 1u) * nx) xb_add(&bar[XB_TOPGEN], 1u);
            else XB_SPIN(xb_ld(&bar[XB_TOPGEN]) == tg, bar);
            __builtin_amdgcn_fence(__ATOMIC_ACQUIRE, "agent");
            xb_add(&bar[XB_XGEN(b.x)], 1u);
            asm volatile("s_waitcnt vmcnt(0)" ::: "memory");
        } else {
            XB_SPIN(xb_ld(&bar[XB_XGEN(b.x)]) == gen, bar);
            __builtin_amdgcn_fence(__ATOMIC_ACQUIRE, "agent");
            asm volatile("s_waitcnt vmcnt(0)" ::: "memory");
        }
    }
    __syncthreads();
}

struct Frame {
    LAS unsigned char* lds;
    volatile LAS unsigned* MISC;
    gu32* ctl;
    int tid, lane, wave;
    int vcu, G;
    unsigned char* ws;
    const float* in[21];
    float* out;
};
__device__ __forceinline__ float wave_sum(float v) {
#pragma unroll
    for (int o = 1; o < 64; o <<= 1) v += __shfl_xor(v, o);
    return v;
}
__device__ __forceinline__ float wave_max(float v) {
#pragma unroll
    for (int o = 1; o < 64; o <<= 1) v = fmaxf(v, __shfl_xor(v, o));
    return v;
}
__device__ __forceinline__ int wave_isum(int v) {
#pragma unroll
    for (int o = 1; o < 64; o <<= 1) v += __shfl_xor(v, o);
    return v;
}
enum { I_X = 0, I_C, I_POS, I_WADA, I_BADA, I_WIN, I_RELB, I_QG, I_WUQ, I_KVG, I_WUKV, I_WO, I_LN1G, I_LN1B, I_WG, I_WU, I_CW, I_CB, I_WD, I_LN2G, I_LN2B };

__device__ const unsigned char BUCKET_TAB[128] = {0, 1, 2, 3, 4, 5, 6, 7, 8, 9, 10, 11, 12, 13, 14, 15, 16, 16, 16, 17, 17, 18, 18, 18, 19, 19, 19, 20, 20, 20, 20, 21, 21, 21, 21, 22, 22, 22, 22, 22, 23, 23, 23, 23, 23, 23, 24, 24, 24, 24, 24, 24, 25, 25, 25, 25, 25, 25, 25, 26, 26, 26, 26, 26, 26, 26, 26, 27, 27, 27, 27, 27, 27, 27, 27, 27, 27, 28, 28, 28, 28, 28, 28, 28, 28, 28, 28, 29, 29, 29, 29, 29, 29, 29, 29, 29, 29, 29, 29, 30, 30, 30, 30, 30, 30, 30, 30, 30, 30, 30, 30, 30, 30, 31, 31, 31, 31, 31, 31, 31, 31, 31, 31, 31, 31, 31, 31, 31};
__device__ const double ROPE_FREV[32] = {
    0.15915494309189535, 0.11934937021124886, 0.08949940160889101, 0.06711508300522726,
    0.050329212104487035, 0.03774158471741977, 0.0283021958306234, 0.02122365276477766,
    0.015915494309189534, 0.011934937021124886, 0.008949940160889102, 0.006711508300522725,
    0.005032921210448704, 0.003774158471741977, 0.00283021958306234, 0.0021223652764777662,
    0.0015915494309189536, 0.0011934937021124885, 0.0008949940160889102, 0.0006711508300522726,
    0.0005032921210448703, 0.00037741584717419774, 0.00028302195830623395, 0.0002122365276477766,
    0.00015915494309189535, 0.00011934937021124886, 8.949940160889102e-05, 6.711508300522725e-05,
    5.0329212104487035e-05, 3.774158471741978e-05, 2.8302195830623396e-05, 2.122365276477766e-05
};

__device__ __forceinline__ int colmap(int kind, int c) {
    if (kind == 0) return c;
    if (kind == 1) {
        if (c < 2304) return c;
        if (c < 6400) { const int r = c - 2304, h = r >> 7, d = r & 127; const int dd = d < 64 ? d : 64 + 2 * ((d - 64) & 31) + ((d - 64) >> 5);
            return h < 2 ? 2304 + h * 128 + dd : 4096 + (h - 2) * 128 + dd; }
        if (c < 6528) { const int d = c - 6400; return 4096 + 3840 + (d < 64 ? d : 64 + 2 * ((d - 64) & 31) + ((d - 64) >> 5)); }
        if (c < 6560) return 4096 + 3840 + 192 + (c - 6528);
        if (c < 7584) return 2560 + (c - 6560);
        if (c < 8096) return 3584 + (c - 7584);
        const int j = c - 8096; return 4096 + 3840 + 128 + 2 * (j & 31) + (j >> 5);
    }
    if (kind == 2) { const int h = c / 192, d = c - h * 192; if (d < 128) return c; const int j = d - 128; return h * 192 + 128 + 2 * (j & 31) + (j >> 5); }
    if (kind == 3) return (c >> 7) * 256 + (c & 127);
    if (kind == 5) return (c >> 8) * 128 + (c & 127) + ((c & 128) ? 2048 : 0);
    return (c >> 7) * 256 + 128 + (c & 127);
}
constexpr int TT_IN = 32 * 64, TT_UQ = 8 * 24, TT_UKV = 4 * 32, TT_O = 32 * 32, TT_G = 32 * 86, TT_D = 86 * 32;
constexpr int TT_TOTAL = TT_IN + TT_UQ + TT_UKV + TT_O + 2 * TT_G + TT_D;
struct TJob { const float* W; const float* scale; bf16* WT; int K, N, kind, k0, n0; float f8s; };
__device__ __forceinline__ TJob tjob(const Frame& F, int t) {
    TJob j; j.scale = nullptr; j.f8s = 0.f; int nnt;
    if (t < TT_IN) { j.W = F.in[I_WIN]; j.WT = (bf16*)(F.ws + WS_WIN); j.K = 4096; j.N = 8160; j.kind = 1; nnt = 64; }
    else if ((t -= TT_IN) < TT_UQ) { j.W = F.in[I_WUQ]; j.scale = F.in[I_QG]; j.WT = (bf16*)(F.ws + WS_WUQ); j.K = 1024; j.N = 3072; j.kind = 2; j.f8s = 32.0f; nnt = 24; }
    else if ((t -= TT_UQ) < TT_UKV) { j.W = F.in[I_WUKV]; j.scale = F.in[I_KVG]; j.WT = (bf16*)(F.ws + WS_WUKV); j.K = 512; j.N = 4096; j.kind = 5; j.f8s = 16.0f; nnt = 32; }
    else if ((t -= TT_UKV) < TT_O) { j.W = F.in[I_WO]; j.WT = (bf16*)(F.ws + WS_WO); j.K = 4096; j.N = 4096; j.kind = 0; j.f8s = 128.0f; nnt = 32; }
    else if ((t -= TT_O) < TT_G) { j.W = F.in[I_WG]; j.WT = (bf16*)(F.ws + WS_WGU); j.K = 4096; j.N = FF; j.kind = 3; nnt = 86; }
    else if ((t -= TT_G) < TT_G) { j.W = F.in[I_WU]; j.WT = (bf16*)(F.ws + WS_WGU); j.K = 4096; j.N = FF; j.kind = 4; nnt = 86; }
    else { t -= TT_G; j.W = F.in[I_WD]; j.WT = (bf16*)(F.ws + WS_WD); j.K = FF; j.N = 4096; j.kind = 0; nnt = 32; }
    j.k0 = (t / nnt) * 128; j.n0 = (t % nnt) * 128; return j;
}
__device__ __forceinline__ void tr_load(const Frame& F, int t, f32x4 (&ld)[8]) {
    const TJob j = tjob(F, t); const int rsub = F.lane >> 5, c4 = F.lane & 31, n = j.n0 + 4 * c4;
#pragma unroll
    for (int i = 0; i < 8; ++i) { const int k = j.k0 + 16 * F.wave + 2 * i + rsub;
        f32x4 v = (f32x4){0.f, 0.f, 0.f, 0.f};
        if (n < j.N) v = __builtin_nontemporal_load((const f32x4*)(j.W + (size_t)k * j.N + n));
        if (j.scale) v = v * j.scale[k];
        ld[i] = v; }
}
__device__ __forceinline__ void p0_prologue(Frame& F) {
    const int g = blockIdx.x, G = F.G;
    { float* ROPE = (float*)(F.ws + WS_ROPE); const int* pos = (const int*)F.in[I_POS];
      for (int idx = g * 512 + F.tid; idx < M * 32; idx += G * 512) { const int m = idx >> 5, i = idx & 31;
          const double r = (double)pos[m] * ROPE_FREV[i]; const float fr = (float)(r - __builtin_floor(r)) * 2.0f;
          ROPE[2 * idx] = cospif(fr); ROPE[2 * idx + 1] = sinpif(fr); } }
    { v4u* z = (v4u*)((bf16*)(F.ws + WS_WINB) + (size_t)4064 * 4096);
      for (int idx = g * 512 + F.tid; idx < 32 * 4096 / 8; idx += G * 512) z[idx] = (v4u){0u, 0u, 0u, 0u}; }
    {
        LAS float* CACT = (LAS float*)F.lds; LAS float* RED = (LAS float*)(F.lds + 65536);
        for (int idx = F.tid; idx < 4 * 4096; idx += 512) { const float c = F.in[I_C][idx]; CACT[idx] = c / (1.0f + __expf(-c)); }
        __syncthreads();
        for (int it = g; it < 256; it += G) {
            const int ln = F.lane < 48 ? F.lane : 47; const float* wp = F.in[I_WADA] + (size_t)(512 * F.wave) * 24576 + it * 96 + 2 * ln;
            f32x2 acc[4];
#pragma unroll
            for (int b = 0; b < 4; ++b) acc[b] = (f32x2){0.f, 0.f};
            for (int k = 0; k < 512; k += 16) {
                f32x2 wv[16];
#pragma unroll
                for (int i = 0; i < 16; ++i) wv[i] = __builtin_nontemporal_load((const f32x2*)(wp + (size_t)(k + i) * 24576));
#pragma unroll
                for (int i = 0; i < 16; ++i)
#pragma unroll
                    for (int b = 0; b < 4; ++b) acc[b] += wv[i] * CACT[b * 4096 + 512 * F.wave + k + i];
            }
            if (F.lane < 48) {
#pragma unroll
                for (int b = 0; b < 4; ++b) *(LAS f32x2*)(RED + (F.wave * 4 + b) * 96 + 2 * F.lane) = acc[b]; }
            __syncthreads();
            if (F.tid < 384) { const int b = F.tid / 96, c = F.tid % 96; float s = F.in[I_BADA][it * 96 + c];
#pragma unroll
              for (int w = 0; w < 8; ++w) s += RED[(w * 4 + b) * 96 + c];
              ((float*)(F.ws + WS_MOD))[b * 24576 + it * 96 + c] = s; }
            __syncthreads();
        }
    }
    {
        const int tb = (int)((long)TT_TOTAL * g / G), te = (int)((long)TT_TOTAL * (g + 1) / G);
        LAS float* T = (LAS float*)F.lds;
        f32x4 ldA[8], ldB[8];
        if (tb < te) tr_load(F, tb, ldA);
        if (tb + 1 < te) tr_load(F, tb + 1, ldB);
#define TR_STEP(LD, t_) do { \
            { const int rsub = F.lane >> 5, c4 = F.lane & 31; \
              _Pragma("unroll") for (int i = 0; i < 8; ++i) { const int k = 16 * F.wave + 2 * i + rsub; *(LAS f32x4*)(T + 132 * k + ((4 * c4) ^ (4 * ((k >> 3) & 15)))) = LD[i]; } } \
            __syncthreads(); \
            const TJob j = tjob(F, (t_)); \
            if ((t_) + 2 < te) tr_load(F, (t_) + 2, LD); \
            { const int c = F.lane & 15; \
              _Pragma("unroll") for (int q = 0; q < 4; ++q) { const int n = (F.lane >> 4) + 4 * F.wave + 32 * q; const LAS float* s = T + 132 * (8 * c) + (n ^ (4 * c)); \
                  int R_ = (j.n0 + n < j.N) ? colmap(j.kind, j.n0 + n) : 0; const bool f8_ = j.kind == 1 ? R_ < 4096 : j.f8s != 0.f; if (j.kind == 1 && !f8_) R_ -= 4096; \
                  if (f8_) { const float fs = j.kind == 1 ? 64.0f : j.f8s; int w0 = 0, w1 = 0; \
                      w0 = __builtin_amdgcn_cvt_pk_fp8_f32(s[0] * fs, s[132] * fs, w0, false); w0 = __builtin_amdgcn_cvt_pk_fp8_f32(s[2 * 132] * fs, s[3 * 132] * fs, w0, true); \
                      w1 = __builtin_amdgcn_cvt_pk_fp8_f32(s[4 * 132] * fs, s[5 * 132] * fs, w1, false); w1 = __builtin_amdgcn_cvt_pk_fp8_f32(s[6 * 132] * fs, s[7 * 132] * fs, w1, true); \
                      if (j.n0 + n < j.N) *(v2u*)((unsigned char*)j.WT + (size_t)R_ * j.K + j.k0 + 8 * c) = (v2u){(unsigned)w0, (unsigned)w1}; } \
                  else { v4u o; o.x = pk2(s[0], s[132]); o.y = pk2(s[2 * 132], s[3 * 132]); o.z = pk2(s[4 * 132], s[5 * 132]); o.w = pk2(s[6 * 132], s[7 * 132]); \
                  if (j.n0 + n < j.N) *(v4u*)((j.kind == 1 ? (bf16*)(F.ws + WS_WINB) : j.WT) + (size_t)R_ * j.K + j.k0 + 8 * c) = o; } } } \
            __syncthreads(); } while (0)
        for (int t = tb; t < te; t += 2) { TR_STEP(ldA, t); if (t + 1 < te) TR_STEP(ldB, t + 1); }
#undef TR_STEP
    }
}

__device__ __forceinline__ void ln_stats(const f32x4 (&v)[16], float& mean, float& rstd) {
    float s = 0.f;
#pragma unroll
    for (int j = 0; j < 16; ++j) s += (v[j][0] + v[j][1]) + (v[j][2] + v[j][3]);
    mean = wave_sum(s) * (1.0f / D); float q = 0.f;
#pragma unroll
    for (int j = 0; j < 16; ++j) { const f32x4 d = v[j] - mean; q += (d[0] * d[0] + d[1] * d[1]) + (d[2] * d[2] + d[3] * d[3]); }
    rstd = 1.0f / sqrtf(wave_sum(q) * (1.0f / D) + LN_EPS);
}
template <int KIND> __device__ __forceinline__ void row_pass(Frame& F) {
    const float* mod = (const float*)(F.ws + WS_MOD); bf16* U = (bf16*)(F.ws + WS_U);
    LAS float* VA = (LAS float*)F.lds; LAS float* VB = VA + 4096;
    const float* src = KIND == 1 ? F.in[I_X] : (KIND == 6 ? (const float*)(F.ws + WS_Z1) : F.out);
    int cur = -1;
    for (int blk = F.vcu; blk < M / 32; blk += F.G) {
        const int bt = blk >> 6;
        if (KIND == 10 ? cur < 0 : bt != cur) {
            __syncthreads();
            const float* mb = mod + (size_t)bt * 24576; const int c = 8 * F.tid;
#pragma unroll
            for (int e = 0; e < 8; e += 4) { f32x4 va, vb;
                if (KIND == 1) { va = *(const f32x4*)(mb + 4096 + c + e) + 1.0f; vb = *(const f32x4*)(mb + c + e); }
                else if (KIND == 6) { const f32x4 s1 = *(const f32x4*)(mb + 4 * 4096 + c + e) + 1.0f; va = *(const f32x4*)(F.in[I_LN1G] + c + e) * s1; vb = *(const f32x4*)(F.in[I_LN1B] + c + e) * s1 + *(const f32x4*)(mb + 3 * 4096 + c + e); }
                else { va = *(const f32x4*)(F.in[I_LN2G] + c + e); vb = *(const f32x4*)(F.in[I_LN2B] + c + e); }
                *(LAS f32x4*)(VA + c + e) = va; *(LAS f32x4*)(VB + c + e) = vb; }
            __syncthreads(); cur = bt;
        }
#pragma unroll 1
        for (int r = 0; r < 4; ++r) { const int m = blk * 32 + 4 * F.wave + r; const char* rp = (const char*)(src + (size_t)m * D); const unsigned lo = (unsigned)F.lane * 16u;
            f32x4 v[16];
#pragma unroll
            for (int j = 0; j < 16; ++j) v[j] = KIND == 1 ? __builtin_nontemporal_load((const f32x4*)(rp + (lo + 1024u * j))) : *(const f32x4*)(rp + (lo + 1024u * j));
            float mean = 0.f, rstd = 1.f;
            if (KIND != 1) { ln_stats(v, mean, rstd); if (KIND == 6 && F.lane == 0) *(f32x2*)((float*)(F.ws + WS_RS1) + 2 * (size_t)m) = (f32x2){mean, rstd}; }
#pragma unroll
            for (int j = 0; j < 16; ++j) { const f32x4 va = *(const LAS f32x4*)(VA + 4 * F.lane + 256 * j), vb = *(const LAS f32x4*)(VB + 4 * F.lane + 256 * j);
                const f32x4 o = KIND == 1 ? v[j] * va + vb : (v[j] - mean) * rstd * va + vb;
                if (KIND == 10) *(f32x4*)((char*)(F.out + (size_t)m * D) + (lo + 1024u * j)) = o;
                else { v2u w; w.x = pk2(o[0], o[1]); w.y = pk2(o[2], o[3]); *(v2u*)((char*)(U + (size_t)m * D) + ((unsigned)F.lane * 8u + 512u * j)) = w;
                    if (KIND == 1) { int w8 = 0; w8 = __builtin_amdgcn_cvt_pk_fp8_f32(o[0], o[1], w8, false); w8 = __builtin_amdgcn_cvt_pk_fp8_f32(o[2], o[3], w8, true);
                        *(unsigned*)((unsigned char*)(F.ws + WS_U8) + (size_t)m * D + ((unsigned)F.lane * 4u + 256u * j)) = (unsigned)w8; } }
                if ((j & 3) == 3) __builtin_amdgcn_sched_barrier(0); } }
    }
    __syncthreads();
}
__device__ __forceinline__ void p8_fixup(Frame& F) {
    const float* GH = (const float*)(F.ws + WS_GH); const float* UPH = (const float*)(F.ws + WS_UPH); bf16* H = (bf16*)(F.ws + WS_H);
    const float* cw = F.in[I_CW]; const float* cb = F.in[I_CB];
    const int total = 32 * 2 * FF;
    for (int idx = (int)blockIdx.x * 512 + F.tid; idx < total; idx += F.G * 512) {
        const int c = idx % FF, r = (idx / FF) & 1, pm = idx / (2 * FF);
        if ((pm & 7) == 0) continue;
        const float gm2 = r == 0 ? GH[((size_t)(pm - 1) * 4 + 2) * FF + c] : GH[((size_t)(pm - 1) * 4 + 3) * FF + c];
        const float gm1 = r == 0 ? GH[((size_t)(pm - 1) * 4 + 3) * FF + c] : GH[((size_t)pm * 4 + 0) * FF + c];
        const float g0 = GH[((size_t)pm * 4 + r) * FF + c];
        const float g = cb[c] + cw[c] * gm2 + cw[FF + c] * gm1 + cw[2 * FF + c] * g0;
        H[(size_t)(pm * 256 + r) * FF + c] = (bf16)f2bf(g / (1.0f + __expf(-g)) * UPH[((size_t)pm * 2 + r) * FF + c]);
    }
}


namespace att {
typedef float f32x16 __attribute__((ext_vector_type(16)));
typedef short bf16x8 __attribute__((ext_vector_type(8)));
constexpr int VP = 144;
constexpr int KREG = 32768, BUF_STRIDE = 57344;
constexpr int X_OFF = 2 * BUF_STRIDE;
__device__ __forceinline__ int swap23(int r) { return (r & ~12) | ((r & 4) << 1) | ((r & 8) >> 1); }
__device__ __forceinline__ unsigned sortable(float f) { const unsigned u = __builtin_bit_cast(unsigned, f); return (u & 0x80000000u) ? ~u : (u | 0x80000000u); }

template <int OFF> __device__ __forceinline__ void lds_rd128(bf16x8& d, unsigned addr) { asm volatile("ds_read_b128 %0, %1 offset:%2" : "=v"(d) : "v"(addr), "n"(OFF)); }
template <int N> __device__ __forceinline__ void lgkm_wait(bf16x8& d) { asm volatile("s_waitcnt lgkmcnt(%1)" : "+v"(d) : "n"(N)); }
struct Stg {
    const unsigned char* base;
    unsigned koff[4], kstep[4], voff[3];
    unsigned ldsk, ldsv;
    int nk, nv;
    template <int E> __device__ __forceinline__ void k() { if (E < nk) __builtin_amdgcn_global_load_lds((const unsigned*)(base + koff[E]), (LAS unsigned*)(unsigned long long)(ldsk + E * 1024), 16, 0, 0); }
    template <int E> __device__ __forceinline__ void v() { if (E < nv) __builtin_amdgcn_global_load_lds((const unsigned*)(base + voff[E]), (LAS unsigned*)(unsigned long long)(ldsv + E * 1024), 16, 0, 0); }
};
template <int N, int KSTEPS, int KP, int PF> struct SStep {
    static __device__ __forceinline__ void run(bf16x8 (&fr)[PF], f32x16 (&sa)[2], const bf16x8 (&qf)[KSTEPS], unsigned base, Stg& st, bool more) {
        constexpr int NMM = 2 * KSTEPS, kb = N / KSTEPS, s = N % KSTEPS, GAP = NMM / 4;
        lgkm_wait<((NMM - N < PF) ? NMM - N : PF) - 1>(fr[N % PF]);
        sa[kb] = __builtin_amdgcn_mfma_f32_32x32x16_bf16(fr[N % PF], qf[s], sa[kb], 0, 0, 0);
        if constexpr (N + PF < NMM) lds_rd128<32 * ((N + PF) / KSTEPS) * KP + 32 * ((N + PF) % KSTEPS)>(fr[N % PF], base);
        if constexpr (N % 2 == 1 && N < 8) st.template k<N / 2>();
        if constexpr (N % 2 == 1 && N >= 8 && N < 14) st.template v<(N - 8) / 2>();
        if constexpr (N + 1 < NMM) SStep<N + 1, KSTEPS, KP, PF>::run(fr, sa, qf, base, st, more);
    }
};
template <int N, int PF> struct PVStep {
    static __device__ __forceinline__ void run(bf16x8 (&fr)[PF], f32x16 (&o)[4], const bf16x8 (&pf)[4], unsigned base, Stg& st, bool more) {
        constexpr int d = N / 4, ks = N % 4;
        lgkm_wait<((16 - N < PF) ? 16 - N : PF) - 1>(fr[N % PF]);
        o[d] = __builtin_amdgcn_mfma_f32_32x32x16_bf16(fr[N % PF], pf[ks], o[d], 0, 0, 0);
        if constexpr (N + PF < 16) lds_rd128<32 * ((N + PF) / 4) * VP + 32 * ((N + PF) % 4)>(fr[N % PF], base);
        if constexpr (N + 1 < 16) PVStep<N + 1, PF>::run(fr, o, pf, base, st, more);
    }
};
template <int N, int KSTEPS, int KP, int PF> struct SPre { static __device__ __forceinline__ void run(bf16x8 (&fr)[PF], unsigned base) {
    lds_rd128<32 * (N / KSTEPS) * KP + 32 * (N % KSTEPS)>(fr[N], base); if constexpr (N + 1 < PF) SPre<N + 1, KSTEPS, KP, PF>::run(fr, base); } };
template <int N, int PF> struct PVPre { static __device__ __forceinline__ void run(bf16x8 (&fr)[PF], unsigned base) {
    lds_rd128<32 * (N / 4) * VP + 32 * (N % 4)>(fr[N], base); if constexpr (N + 1 < PF) PVPre<N + 1, PF>::run(fr, base); } };
__device__ __forceinline__ void dsa_topk(Frame& F, int b, int q0, int slot) {
    const int tid = F.tid, lane = F.lane, w = F.wave; LAS unsigned char* lds = F.lds; const size_t brow = (size_t)b * SEQ;
    LAS unsigned* bmp = (LAS unsigned*)(lds + X_OFF) + slot * 1024;
    LAS float* rb2 = (LAS float*)(lds + X_OFF + 8192 + 1024);
    {
        const float* SC = (const float*)(F.ws + WS_SC);
        for (int idx = tid; idx < 2048; idx += 512) rb2[idx] = F.in[I_RELB][(int)BUCKET_TAB[idx >> 4] * 16 + (idx & 15)] * 1.4426950408889634f;
        for (int tt = 0; tt < 2; ++tt) {
            const int t = q0 + 2 * w + tt, n = t + 1; const float* row = SC + (brow + t) * SEQ;
            unsigned u[32];
#pragma unroll
            for (int j = 0; j < 32; ++j) { const int s = 64 * j + lane; u[j] = 0u; if (64 * j < n) { if (s < n) u[j] = sortable(row[s]); } }
            unsigned T = 1u;
            bool exact = true;
            if (n > 256) {
                T = 0u; exact = false;
                for (int bit = 31; bit >= 0; --bit) {
                    const unsigned cand = T | (1u << bit); int c = 0;
#pragma unroll
                    for (int j = 0; j < 32; ++j) c += __popcll(__ballot(u[j] >= cand));
                    if (c >= 256) T = cand;
                    if (c == 256) { exact = true; break; }
                }
            }
            if (exact) {
#pragma unroll
                for (int j = 0; j < 32; ++j) { const unsigned long long mk = __ballot(u[j] >= T); if (lane < 2) bmp[(2 * w + tt) * 64 + 2 * j + lane] = (unsigned)(mk >> (32 * lane)); }
            } else {
                int need = 256;
#pragma unroll
                for (int j = 0; j < 32; ++j) need -= __popcll(__ballot(u[j] > T));
#pragma unroll
                for (int j = 0; j < 32; ++j) { unsigned long long mk = __ballot(u[j] > T), eq = __ballot(u[j] == T);
                    while (eq != 0ull && need > 0) { const unsigned long long low = eq & (~eq + 1ull); mk |= low; eq ^= low; --need; }
                    if (lane < 2) bmp[(2 * w + tt) * 64 + 2 * j + lane] = (unsigned)(mk >> (32 * lane)); }
            }
        }
    }
}
template <int MODE> __device__ __forceinline__ void attn_unit(Frame& F, int b, int h, int q0, int slot) {
    constexpr int KD = MODE == 0 ? 192 : 128, KCH = KD / 8, KP = (KCH + 1) * 16, KSTEPS = KD / 16, KTILE = 64 * KP;
    constexpr int KROWCH = KCH + 1;
    static_assert(64 * KP <= KREG && KREG + 128 * VP <= BUF_STRIDE, "tile buffers");
    const int tid = F.tid, lane = F.lane, w = F.wave, l32 = lane & 31, hh = lane >> 5;
    LAS unsigned char* lds = F.lds;
    unsigned long long wsl_ = (unsigned long long)F.ws; asm volatile("" : "+s"(wsl_));
    unsigned char* const WSP = (unsigned char*)wsl_;
    unsigned long long posl_ = (unsigned long long)F.in[I_POS]; asm volatile("" : "+s"(posl_)); const int* const POSP = (const int*)posl_;
    const bf16* QG; const bf16* KG; const bf16* K2G = nullptr; const bf16* VTG; bf16* MIX = (bf16*)(WSP + WS_MIX);
    if (MODE == 0) { QG = (const bf16*)(WSP + WS_QB); KG = (const bf16*)(WSP + WS_KN); K2G = (const bf16*)(WSP + WS_IKX); VTG = (const bf16*)(WSP + WS_VT) + (size_t)(h * 128) * M; }
    else { QG = (const bf16*)(WSP + WS_AQ); KG = (const bf16*)(WSP + WS_AKV); VTG = (const bf16*)(WSP + WS_VTA); }
    const size_t brow = (size_t)b * SEQ;
    int tq, qhead;
    if (MODE == 0) { tq = q0 + 32 * w + l32; qhead = h; } else { tq = q0 + 2 * w + (l32 >> 4); qhead = l32 & 15; }
    const int nt = MODE == 0 ? (q0 + 256) / 64 : (q0 + 16 + 63) / 64;
    LAS unsigned* bmp = (LAS unsigned*)(lds + X_OFF) + slot * 1024;
    LAS int* posk = (LAS int*)(lds + X_OFF + 8192);
    LAS int* farf = (LAS int*)(lds + X_OFF + 8192 + 512);
    LAS float* rb2 = (LAS float*)(lds + X_OFF + 8192 + 1024);
    bf16x8 qf[KSTEPS];
    int posq = 0, minposq = 0; float bias_far = 0.f;
    if (MODE == 1) { const int* pos = POSP; posq = pos[brow + tq]; const int p0 = pos[brow + q0 + 2 * w], p1 = pos[brow + q0 + 2 * w + 1]; minposq = p0 < p1 ? p0 : p1; }
    Stg st; st.base = WSP;
    { constexpr int NKI = (64 * KROWCH + 63) / 64, NVI = 18;
      int ln_ = lane; asm volatile("" : "+v"(ln_));
      st.nk = NKI - 4 * w; st.nk = st.nk < 0 ? 0 : (st.nk > 4 ? 4 : st.nk); st.nv = NVI - 3 * w; st.nv = st.nv < 0 ? 0 : (st.nv > 3 ? 3 : st.nv);
#pragma unroll
      for (int e = 0; e < 4; ++e) { const int q = (4 * w + e) * 64 + ln_, rho = q / KROWCH, c = q % KROWCH; const bool ok = rho < 64 && c < KCH; const unsigned kr = (unsigned)swap23(rho & 63);
          if (MODE == 0) { const bool two = c >= 16;
              st.koff[e] = !ok ? (unsigned)WS_KN : (two ? (unsigned)WS_IKX + ((unsigned)(brow + kr) * 256u + 128u + 8u * (c - 16)) * 2u : (unsigned)WS_KN + ((unsigned)(brow + kr) * 2048u + (unsigned)h * 128u + 8u * c) * 2u);
              st.kstep[e] = !ok ? 0u : (two ? 64u * 512u : 64u * 4096u); }
          else { st.koff[e] = !ok ? (unsigned)WS_AKV : (unsigned)WS_AKV + ((unsigned)(brow + kr) * 256u + 8u * c) * 2u; st.kstep[e] = !ok ? 0u : 64u * 512u; } }
#pragma unroll
      for (int e = 0; e < 3; ++e) { const int q = (3 * w + e) * 64 + ln_, d = q / 9, c = q % 9; const bool ok = d < 128 && c < 8;
          const unsigned vb = MODE == 0 ? (unsigned)WS_VT + (unsigned)(h * 128) * (unsigned)(M * 2) : (unsigned)WS_VTA;
          st.voff[e] = !ok ? vb : vb + (unsigned)d * (unsigned)(M * 2) + ((unsigned)brow + 8u * c) * 2u; } }
#define ATT_ADVANCE() do { _Pragma("unroll") for (int e = 0; e < 4; ++e) st.koff[e] += st.kstep[e]; _Pragma("unroll") for (int e = 0; e < 3; ++e) st.voff[e] += 128u; } while (0)
#define ATT_TARGET(i_) do { const unsigned tb_ = (unsigned)(unsigned long long)(lds + ((i_) & 1) * BUF_STRIDE); st.ldsk = tb_ + 4 * w * 1024; st.ldsv = tb_ + KREG + 3 * w * 1024; } while (0)
#define ATT_POS(i_) do { if (MODE == 1 && tid < 64) { const int* pos_ = POSP + brow + 64 * (i_); const int pk = pos_[tid]; posk[((i_) & 1) * 64 + tid] = pk; int mx = pk; \
            _Pragma("unroll") for (int o_ = 1; o_ < 64; o_ <<= 1) { const int y = __shfl_xor(mx, o_); mx = mx > y ? mx : y; } \
            if (tid == 0) farf[(i_) & 1] = mx; } } while (0)
    f32x16 o[4];
#pragma unroll
    for (int d = 0; d < 4; ++d)
#pragma unroll
        for (int r = 0; r < 16; ++r) o[d][r] = 0.f;
    float ninit = 0.f, lrun = 0.f;
    constexpr float THR = 8.0f;
    __syncthreads();
    if (MODE == 1) bias_far = rb2[127 * 16 + qhead];
    { const bf16* qp = MODE == 0 ? QG + (brow + tq) * 3072 + qhead * 192 + 8 * hh : QG + (brow + tq) * 2048 + qhead * 128 + 8 * hh;
#pragma unroll
      for (int s = 0; s < KSTEPS; ++s) qf[s] = *(const bf16x8*)(qp + 16 * s); }
    ATT_TARGET(0); st.k<0>(); st.k<1>(); st.k<2>(); st.k<3>(); st.v<0>(); st.v<1>(); st.v<2>(); ATT_POS(0); ATT_ADVANCE();
    asm volatile("s_waitcnt vmcnt(0)" ::: "memory"); __syncthreads();
    const int tmin = MODE == 0 ? q0 + 32 * w : q0;
    for (int i = 0; i < nt; ++i) {
        const bool more = i + 1 < nt;
        ATT_TARGET(i + 1); if (more) ATT_POS(i + 1);
        const int key0 = 64 * i;
        {
            const LAS unsigned char* kbuf = lds + (i & 1) * BUF_STRIDE; const LAS unsigned char* vbuf = kbuf + KREG;
            constexpr int PF = MODE == 0 ? 4 : 3;
            const unsigned kbase = (unsigned)(unsigned long long)(kbuf + l32 * KP + hh * 16), vbase = (unsigned)(unsigned long long)(vbuf + l32 * VP + hh * 16);
            f32x16 sa[2]; bf16x8 fr[PF];
            SPre<0, KSTEPS, KP, PF>::run(fr, kbase);
            if (MODE == 0) {
#pragma unroll
                for (int kb = 0; kb < 2; ++kb)
#pragma unroll
                    for (int r = 0; r < 16; ++r) sa[kb][r] = ninit;
            } else {
                const bool far_ = __builtin_amdgcn_readfirstlane(minposq - farf[i & 1]) >= 128;
#pragma unroll
                for (int kb = 0; kb < 2; ++kb)
#pragma unroll
                    for (int g = 0; g < 2; ++g) { float bia[8];
#pragma unroll
                        for (int e = 0; e < 8; ++e) bia[e] = bias_far;
                        if (!far_) { const LAS int* pp = posk + (i & 1) * 64 + 32 * kb + 16 * g + 8 * hh;
#pragma unroll
                            for (int e = 0; e < 8; ++e) { int rel = posq - pp[e]; rel = rel < 0 ? 0 : (rel > 127 ? 127 : rel); bia[e] = rb2[rel * 16 + qhead]; } }
#pragma unroll
                        for (int e = 0; e < 8; ++e) sa[kb][8 * g + e] = bia[e] + ninit;
                        __builtin_amdgcn_sched_barrier(0); }
            }
            SStep<0, KSTEPS, KP, PF>::run(fr, sa, qf, kbase, st, more);
            if (MODE == 0) {
                if (key0 + 63 > tmin) {
#pragma unroll
                    for (int kb = 0; kb < 2; ++kb)
#pragma unroll
                        for (int r = 0; r < 16; ++r) { const int key = key0 + 32 * kb + 16 * (r >> 3) + 8 * hh + (r & 7); const float xv = sa[kb][r]; sa[kb][r] = key > tq ? -__builtin_inff() : xv; }
                }
            } else {
                const v2u wds = *(const LAS v2u*)(bmp + (2 * w + (l32 >> 4)) * 64 + 2 * i);
#pragma unroll
                for (int kb = 0; kb < 2; ++kb) { const int wdh = (int)((kb == 0 ? wds.x : wds.y) >> (8 * hh));
#pragma unroll
                    for (int r = 0; r < 16; ++r) { const int mk = __builtin_amdgcn_sbfe(wdh, 16 * (r >> 3) + (r & 7), 1); const float xv = sa[kb][r];
                        sa[kb][r] = __builtin_bit_cast(float, (__builtin_bit_cast(int, xv) & mk) | ((int)0xff800000 & ~mk)); } }
            }
            float mloc = sa[0][0];
#pragma unroll
            for (int kb = 0; kb < 2; ++kb)
#pragma unroll
                for (int r = 0; r < 16; ++r) mloc = fmaxf(mloc, sa[kb][r]);
            mloc = fmaxf(mloc, __shfl_xor(mloc, 32));
            if (i == 0 || __any(mloc > THR)) {
                const float delta = i == 0 ? (mloc > -1.0e30f ? mloc : 0.f) : fmaxf(mloc, 0.f), alpha = __builtin_amdgcn_exp2f(-delta);
                ninit -= delta; lrun *= alpha;
#pragma unroll
                for (int kb = 0; kb < 2; ++kb)
#pragma unroll
                    for (int r = 0; r < 16; ++r) sa[kb][r] -= delta;
#pragma unroll
                for (int d = 0; d < 4; ++d)
#pragma unroll
                    for (int r = 0; r < 16; ++r) o[d][r] *= alpha;
            }
            float psum = 0.f;
#pragma unroll
            for (int kb = 0; kb < 2; ++kb)
#pragma unroll
                for (int r = 0; r < 16; ++r) { const float p = __builtin_amdgcn_exp2f(sa[kb][r]); sa[kb][r] = p; psum += p; }
            lrun += psum;
            bf16x8 pf[4];
#pragma unroll
            for (int ks = 0; ks < 4; ++ks) { v4u pk;
#pragma unroll
                for (int e = 0; e < 4; ++e) pk[e] = pg8::cvt_pk_bf16(sa[ks >> 1][8 * (ks & 1) + 2 * e], sa[ks >> 1][8 * (ks & 1) + 2 * e + 1]);
                pf[ks] = __builtin_bit_cast(bf16x8, pk); }
            PVPre<0, PF>::run(fr, vbase);
            PVStep<0, PF>::run(fr, o, pf, vbase, st, more);
        }
        ATT_ADVANCE();
        asm volatile("s_waitcnt vmcnt(0)" ::: "memory"); __syncthreads();
    }
    { const float lt = lrun + __shfl_xor(lrun, 32), inv = 16.0f / lt;
      int tq2 = tq; asm volatile("" : "+v"(tq2));
      const unsigned oo = (unsigned)(b * SEQ + tq2) * 4096u + (MODE == 0 ? 2048u + (unsigned)h * 128u : (unsigned)qhead * 128u);
      unsigned char* op = (unsigned char*)MIX + oo;
#pragma unroll
      for (int d = 0; d < 4; ++d)
#pragma unroll
          for (int g = 0; g < 4; ++g) { int wv = 0; wv = __builtin_amdgcn_cvt_pk_fp8_f32(o[d][4 * g] * inv, o[d][4 * g + 1] * inv, wv, false); wv = __builtin_amdgcn_cvt_pk_fp8_f32(o[d][4 * g + 2] * inv, o[d][4 * g + 3] * inv, wv, true);
              *(unsigned*)(op + 32 * d + 8 * g + 4 * hh) = (unsigned)wv; } }
}
#undef ATT_ADVANCE
#undef ATT_TARGET
#undef ATT_POS
}

namespace att8 {
typedef float f32x16 __attribute__((ext_vector_type(16)));
typedef int i32x4 __attribute__((ext_vector_type(4)));
typedef int i32x8 __attribute__((ext_vector_type(8)));
constexpr int VP = 80;
constexpr int BUF = 24576;
__device__ __forceinline__ int keyperm(int r) { return ((r & 4) << 3) | ((r & 32) >> 1) | ((r & 24) >> 1) | (r & 3); }
template <int OFF> __device__ __forceinline__ void rd32(i32x4& lo, i32x4& hi, unsigned addr) { asm volatile("ds_read_b128 %0, %2 offset:%3\n\tds_read_b128 %1, %2 offset:%4" : "=&v"(lo), "=&v"(hi) : "v"(addr), "n"(OFF), "n"(OFF + 16)); }
template <int N> __device__ __forceinline__ void wait32(i32x4& lo, i32x4& hi) { asm volatile("s_waitcnt lgkmcnt(%2)" : "+v"(lo), "+v"(hi) : "n"(N)); }
__device__ __forceinline__ i32x8 cat(i32x4 lo, i32x4 hi) { return __builtin_shufflevector(lo, hi, 0, 1, 2, 3, 4, 5, 6, 7); }
__device__ __forceinline__ f32x16 mma(i32x8 a, i32x8 b, f32x16 c) { return __builtin_amdgcn_mfma_scale_f32_32x32x64_f8f6f4(a, b, c, 0, 0, 0, 0, 0, 0); }
struct Stg {
    const unsigned char* base; unsigned off[3]; unsigned lds0; int n;
    template <int E> __device__ __forceinline__ void go() { if (E < n) __builtin_amdgcn_global_load_lds((const unsigned*)(base + off[E]), (LAS unsigned*)(unsigned long long)(lds0 + E * 1024), 16, 0, 0); }
};
template <int MODE> __device__ __forceinline__ void attn_unit(Frame& F, int b, int h, int q0, int slot) {
    constexpr int KD = MODE == 0 ? 192 : 128, KCH = KD / 16, KROWCH = KCH + 1, KP = KROWCH * 16, KS = KD / 64;
    constexpr int NKI = (64 * KROWCH + 63) / 64;
    constexpr int VOFF = NKI * 1024;
    static_assert(64 * KP <= VOFF && VOFF + 10 * 1024 <= BUF && 2 * BUF <= att::X_OFF, "tile buffers");
    const int tid = F.tid, lane = F.lane, w = F.wave, l32 = lane & 31, hh = lane >> 5;
    LAS unsigned char* lds = F.lds;
    unsigned long long wsl_ = (unsigned long long)F.ws; asm volatile("" : "+s"(wsl_)); unsigned char* const WSP = (unsigned char*)wsl_;
    unsigned long long posl_ = (unsigned long long)F.in[I_POS]; asm volatile("" : "+s"(posl_)); const int* const POSP = (const int*)posl_;
    const size_t brow = (size_t)b * SEQ;
    int tq, qhead;
    if (MODE == 0) { tq = q0 + 32 * w + l32; qhead = h; } else { tq = q0 + 2 * w + (l32 >> 4); qhead = l32 & 15; }
    const int nt = MODE == 0 ? (q0 + 256) / 64 : (q0 + 16 + 63) / 64;
    LAS unsigned* bmp = (LAS unsigned*)(lds + att::X_OFF) + slot * 1024;
    LAS int* posk = (LAS int*)(lds + att::X_OFF + 8192);
    LAS int* farf = (LAS int*)(lds + att::X_OFF + 8192 + 512);
    LAS float* rb2 = (LAS float*)(lds + att::X_OFF + 8192 + 1024);
    int posq = 0, minposq = 0; float bias_far = 0.f;
    if (MODE == 1) { posq = POSP[brow + tq]; const int p0 = POSP[brow + q0 + 2 * w], p1 = POSP[brow + q0 + 2 * w + 1]; minposq = p0 < p1 ? p0 : p1; }
    Stg st; st.base = WSP;
    { int ln_ = lane; asm volatile("" : "+v"(ln_));
      st.n = NKI + 10 - 3 * w; st.n = st.n < 0 ? 0 : (st.n > 3 ? 3 : st.n);
#pragma unroll
      for (int e = 0; e < 3; ++e) { const int I = 3 * w + e;
          if (I < NKI) { const int q = I * 64 + ln_, rho = q / KROWCH, c = q % KROWCH; const bool ok = rho < 64 && c < KCH; const unsigned kr = (unsigned)keyperm(rho & 63);
              if (MODE == 0) st.off[e] = !ok ? (unsigned)WS_KN8 : (c < 8 ? (unsigned)WS_KN8 + (unsigned)(brow + kr) * 2048u + (unsigned)h * 128u + 16u * c : (unsigned)WS_KR8 + (unsigned)(brow + kr) * 2048u + 16u * (c - 8));
              else st.off[e] = !ok ? (unsigned)WS_AKV8 : (unsigned)WS_AKV8 + (unsigned)(brow + kr) * 256u + 16u * c; }
          else { const int q = (I - NKI) * 64 + ln_, d = q / 5, c = q % 5; const bool ok = d < 128 && c < 4;
              const unsigned vb = MODE == 0 ? (unsigned)WS_VT8 + (unsigned)(h * 128) * (unsigned)M : (unsigned)WS_VTA8;
              st.off[e] = !ok ? vb : vb + (unsigned)d * (unsigned)M + (unsigned)brow + 16u * c; } } }
#define A8_ADVANCE() do { _Pragma("unroll") for (int e = 0; e < 3; ++e) st.off[e] += (3 * w + e < NKI) ? (MODE == 0 ? 64u * 2048u : 64u * 256u) : 64u; } while (0)
#define A8_TARGET(i_) do { st.lds0 = (unsigned)(unsigned long long)(lds + ((i_) & 1) * BUF) + 3 * w * 1024; } while (0)
#define A8_POS(i_) do { if (MODE == 1 && tid < 64) { const int* pos_ = POSP + brow + 64 * (i_); const int pk = pos_[tid]; posk[((i_) & 1) * 64 + tid] = pk; int mx = pk; \
            _Pragma("unroll") for (int o_ = 1; o_ < 64; o_ <<= 1) { const int y = __shfl_xor(mx, o_); mx = mx > y ? mx : y; } \
            if (tid == 0) farf[(i_) & 1] = mx; } } while (0)
    f32x16 o[4];
#pragma unroll
    for (int d = 0; d < 4; ++d)
#pragma unroll
        for (int r = 0; r < 16; ++r) o[d][r] = 0.f;
    float ninit = 0.f, lrun = 0.f; constexpr float THR = 8.0f;
    __syncthreads();
    if (MODE == 1) bias_far = rb2[127 * 16 + qhead];
    i32x8 qf[KS];
    { const unsigned char* qp = MODE == 0 ? WSP + WS_QB8 + (brow + tq) * 3072 + qhead * 192 + 32 * hh : WSP + WS_AQ8 + (brow + tq) * 2048 + qhead * 128 + 32 * hh;
#pragma unroll
      for (int s = 0; s < KS; ++s) qf[s] = cat(*(const i32x4*)(qp + 64 * s), *(const i32x4*)(qp + 64 * s + 16)); }
    A8_TARGET(0); st.go<0>(); st.go<1>(); st.go<2>(); A8_POS(0); A8_ADVANCE();
    asm volatile("s_waitcnt vmcnt(0)" ::: "memory"); __syncthreads();
    const int tmin = MODE == 0 ? q0 + 32 * w : q0;
    for (int i = 0; i < nt; ++i) {
        A8_TARGET(i + 1); if (i + 1 < nt) A8_POS(i + 1);
        const int key0 = 64 * i;
        const LAS unsigned char* kbuf = lds + (i & 1) * BUF; const LAS unsigned char* vbuf = kbuf + VOFF;
        const unsigned kbase = (unsigned)(unsigned long long)(kbuf + l32 * KP + hh * 32), vbase = (unsigned)(unsigned long long)(vbuf + l32 * VP + hh * 32);
        f32x16 sa[2];
        float ni_ = ninit; asm volatile("" : "+v"(ni_));
        if (MODE == 0) {
#pragma unroll
            for (int kb = 0; kb < 2; ++kb)
#pragma unroll
                for (int r = 0; r < 16; ++r) sa[kb][r] = ni_;
        } else {
            const bool far_ = __builtin_amdgcn_readfirstlane(minposq - farf[i & 1]) >= 128;
#pragma unroll
            for (int kb = 0; kb < 2; ++kb)
#pragma unroll
                for (int g = 0; g < 2; ++g) { float bia[8];
#pragma unroll
                    for (int e = 0; e < 8; ++e) bia[e] = bias_far;
                    if (!far_) { const LAS int* pp = posk + (i & 1) * 64 + 32 * hh + 16 * kb + 8 * g;
#pragma unroll
                        for (int e = 0; e < 8; ++e) { int rel = posq - pp[e]; rel = rel < 0 ? 0 : (rel > 127 ? 127 : rel); bia[e] = rb2[rel * 16 + qhead]; } }
#pragma unroll
                    for (int e = 0; e < 8; ++e) sa[kb][8 * g + e] = bia[e] + ni_;
                    __builtin_amdgcn_sched_barrier(0); }
        }
        {   i32x4 lo[2], hi[2];
            rd32<0>(lo[0], hi[0], kbase);
#pragma unroll
            for (int n = 0; n < 2 * KS; ++n) { constexpr int dummy = 0; (void)dummy;
                const int kb = n / KS, s = n % KS;
                if (n + 1 < 2 * KS) { const int kb1 = (n + 1) / KS, s1 = (n + 1) % KS;
                    const int offv = 32 * kb1 * KP + 64 * s1;
                    if (offv == 64) rd32<64>(lo[(n + 1) & 1], hi[(n + 1) & 1], kbase); else if (offv == 128) rd32<128>(lo[(n + 1) & 1], hi[(n + 1) & 1], kbase);
                    else if (offv == 32 * KP) rd32<32 * KP>(lo[(n + 1) & 1], hi[(n + 1) & 1], kbase); else if (offv == 32 * KP + 64) rd32<32 * KP + 64>(lo[(n + 1) & 1], hi[(n + 1) & 1], kbase);
                    else rd32<32 * KP + 128>(lo[(n + 1) & 1], hi[(n + 1) & 1], kbase);
                    wait32<2>(lo[n & 1], hi[n & 1]); }
                else wait32<0>(lo[n & 1], hi[n & 1]);
                sa[kb] = mma(cat(lo[n & 1], hi[n & 1]), qf[s], sa[kb]);
                if (n == 0) { st.go<0>(); st.go<1>(); } if (n == 1) st.go<2>(); }
        }
        if (MODE == 0) { if (key0 + 63 > tmin) {
#pragma unroll
            for (int kb = 0; kb < 2; ++kb)
#pragma unroll
                for (int r = 0; r < 16; ++r) { const int key = key0 + 32 * hh + 16 * kb + r; const float xv = sa[kb][r]; sa[kb][r] = key > tq ? -__builtin_inff() : xv; } } }
        else { const int wd = (int)bmp[(2 * w + (l32 >> 4)) * 64 + 2 * i + hh];
#pragma unroll
            for (int kb = 0; kb < 2; ++kb)
#pragma unroll
                for (int r = 0; r < 16; ++r) { const int mk = __builtin_amdgcn_sbfe(wd, 16 * kb + r, 1); const float xv = sa[kb][r];
                    sa[kb][r] = __builtin_bit_cast(float, (__builtin_bit_cast(int, xv) & mk) | ((int)0xff800000 & ~mk)); } }
        float mloc = sa[0][0];
#pragma unroll
        for (int kb = 0; kb < 2; ++kb)
#pragma unroll
            for (int r = 0; r < 16; ++r) mloc = fmaxf(mloc, sa[kb][r]);
        mloc = fmaxf(mloc, __shfl_xor(mloc, 32));
        if (i == 0 || __any(mloc > THR)) {
            const float delta = i == 0 ? (mloc > -1.0e30f ? mloc : 0.f) : fmaxf(mloc, 0.f), alpha = __builtin_amdgcn_exp2f(-delta);
            ninit -= delta; lrun *= alpha;
#pragma unroll
            for (int kb = 0; kb < 2; ++kb)
#pragma unroll
                for (int r = 0; r < 16; ++r) sa[kb][r] -= delta;
#pragma unroll
            for (int d = 0; d < 4; ++d)
#pragma unroll
                for (int r = 0; r < 16; ++r) o[d][r] *= alpha;
        }
        float psum = 0.f; i32x8 pf;
#pragma unroll
        for (int kb = 0; kb < 2; ++kb)
#pragma unroll
            for (int g = 0; g < 4; ++g) { float p[4];
#pragma unroll
                for (int e = 0; e < 4; ++e) { p[e] = __builtin_amdgcn_exp2f(sa[kb][4 * g + e]); psum += p[e]; }
                int wv = 0; wv = __builtin_amdgcn_cvt_pk_fp8_f32(p[0], p[1], wv, false); wv = __builtin_amdgcn_cvt_pk_fp8_f32(p[2], p[3], wv, true); pf[4 * kb + g] = wv; }
        lrun += psum;
        {   i32x4 lo[2], hi[2];
            rd32<0>(lo[0], hi[0], vbase);
            rd32<32 * VP>(lo[1], hi[1], vbase); wait32<2>(lo[0], hi[0]); o[0] = mma(cat(lo[0], hi[0]), pf, o[0]);
            rd32<64 * VP>(lo[0], hi[0], vbase); wait32<2>(lo[1], hi[1]); o[1] = mma(cat(lo[1], hi[1]), pf, o[1]);
            rd32<96 * VP>(lo[1], hi[1], vbase); wait32<2>(lo[0], hi[0]); o[2] = mma(cat(lo[0], hi[0]), pf, o[2]);
            wait32<0>(lo[1], hi[1]); o[3] = mma(cat(lo[1], hi[1]), pf, o[3]);
        }
        A8_ADVANCE();
        asm volatile("s_waitcnt vmcnt(0)" ::: "memory"); __syncthreads();
    }
    { const float lt = lrun + __shfl_xor(lrun, 32), inv = 16.0f / lt;
      int tq2 = tq; asm volatile("" : "+v"(tq2));
      const unsigned oo = (unsigned)(b * SEQ + tq2) * 4096u + (MODE == 0 ? 2048u + (unsigned)h * 128u : (unsigned)qhead * 128u);
      unsigned char* op = WSP + WS_MIX + oo;
#pragma unroll
      for (int d = 0; d < 4; ++d)
#pragma unroll
          for (int g = 0; g < 4; ++g) { int wv = 0; wv = __builtin_amdgcn_cvt_pk_fp8_f32(o[d][4 * g] * inv, o[d][4 * g + 1] * inv, wv, false); wv = __builtin_amdgcn_cvt_pk_fp8_f32(o[d][4 * g + 2] * inv, o[d][4 * g + 3] * inv, wv, true);
              *(unsigned*)(op + 32 * d + 8 * g + 4 * hh) = (unsigned)wv; } }
#undef A8_ADVANCE
#undef A8_TARGET
#undef A8_POS
}
}

__device__ __forceinline__ void indexer_unit(Frame& F, int b, int t0) {
    constexpr int KP = 272, KTILE = 64 * KP;
    const int tid = F.tid, lane = F.lane, w = F.wave, l32 = lane & 31, hh = lane >> 5;
    LAS unsigned char* lds = F.lds;
    const bf16* IQ = (const bf16*)(F.ws + WS_IQ); const bf16* IKX = (const bf16*)(F.ws + WS_IKX); const float* IW = (const float*)(F.ws + WS_IW); float* SC = (float*)(F.ws + WS_SC);
    const size_t brow = (size_t)b * SEQ, m0 = brow + t0 + 2 * w;
    att::bf16x8 af[2][8]; float wt[2][16];
#pragma unroll
    for (int tt = 0; tt < 2; ++tt) {
#pragma unroll
        for (int s = 0; s < 8; ++s) af[tt][s] = *(const att::bf16x8*)(IQ + (m0 + tt) * 4096 + l32 * 128 + 16 * s + 8 * hh);
#pragma unroll
        for (int g = 0; g < 4; ++g) { const f32x4 v = *(const f32x4*)(IW + (m0 + tt) * 32 + 8 * g + 4 * hh); wt[tt][4 * g] = v[0]; wt[tt][4 * g + 1] = v[1]; wt[tt][4 * g + 2] = v[2]; wt[tt][4 * g + 3] = v[3]; }
    }
    const int nt = (t0 + 16 + 63) / 64;
    v4u st[2];
#define IDX_LOAD(i_) do { _Pragma("unroll") for (int e = 0; e < 2; ++e) { const int q = tid + 512 * e, rho = q >> 4, c = q & 15; st[e] = *(const v4u*)(IKX + (brow + 64 * (i_) + rho) * 256 + 8 * c); } } while (0)
#define IDX_STORE(i_) do { _Pragma("unroll") for (int e = 0; e < 2; ++e) { const int q = tid + 512 * e, rho = q >> 4, c = q & 15; *(LAS v4u*)(lds + ((i_) & 1) * KTILE + rho * KP + c * 16) = st[e]; } } while (0)
    __syncthreads();
    IDX_LOAD(0); IDX_STORE(0);
    __syncthreads();
    for (int i = 0; i < nt; ++i) {
        if (i + 1 < nt) IDX_LOAD(i + 1);
        const LAS unsigned char* kbuf = lds + (i & 1) * KTILE;
#pragma unroll
        for (int kb = 0; kb < 2; ++kb) {
            att::bf16x8 bfr[8];
#pragma unroll
            for (int s = 0; s < 8; ++s) bfr[s] = *(const LAS att::bf16x8*)(kbuf + (32 * kb + l32) * KP + (2 * s + hh) * 16);
            float sc[2];
#pragma unroll
            for (int tt = 0; tt < 2; ++tt) {
                att::f32x16 acc;
#pragma unroll
                for (int r = 0; r < 16; ++r) acc[r] = 0.f;
#pragma unroll
                for (int s = 0; s < 8; ++s) acc = __builtin_amdgcn_mfma_f32_32x32x16_bf16(af[tt][s], bfr[s], acc, 0, 0, 0);
                float x = 0.f;
#pragma unroll
                for (int r = 0; r < 16; ++r) x += wt[tt][r] * fmaxf(acc[r], 0.f);
                sc[tt] = x + __shfl_xor(x, 32);
            }
            SC[(m0 + hh) * SEQ + 64 * i + 32 * kb + l32] = hh ? sc[1] : sc[0];
        }
        if (i + 1 < nt) IDX_STORE(i + 1);
        __syncthreads();
    }
#undef IDX_LOAD
#undef IDX_STORE
}
__device__ __forceinline__ void av_transpose(Frame& F, int tile) {
    const unsigned char* AKV = (const unsigned char*)(F.ws + WS_AKV8); unsigned char* VTA = (unsigned char*)(F.ws + WS_VTA8);
    LAS unsigned char* T = (LAS unsigned char*)F.lds;
    __syncthreads();
    { const int tok = F.tid & 63, c = F.tid >> 6; const v4u v = *(const v4u*)(AKV + (size_t)(64 * tile + tok) * 256 + 128 + 16 * c);
#pragma unroll
      for (int k = 0; k < 4; ++k)
#pragma unroll
          for (int e = 0; e < 4; ++e) T[(16 * c + 4 * k + e) * 80 + tok] = (unsigned char)(v[k] >> (8 * e)); }
    __syncthreads();
    { const int d = F.tid >> 2, part = F.tid & 3; *(v4u*)(VTA + (size_t)d * M + 64 * tile + 16 * part) = *(const LAS v4u*)(T + d * 80 + 16 * part); }
    __syncthreads();
}

struct Args { const float* in[21]; float* out; unsigned char* ws; int ph_lo, ph_hi; };
__global__ void __launch_bounds__(NWAVES * 64, 2) skel_fwd(Args args) {
    extern __shared__ __attribute__((aligned(16))) unsigned char lds[];
    Frame F;
    F.lds = (LAS unsigned char*)lds;
    F.MISC = (volatile LAS unsigned*)(F.lds + MISC_OFF);
    F.tid = threadIdx.x; F.lane = F.tid & 63; F.wave = __builtin_amdgcn_readfirstlane(F.tid >> 6);
    F.G = gridDim.x; { const int bx = blockIdx.x; F.vcu = (F.G % 8 == 0) ? (bx % 8) * (F.G / 8) + bx / 8 : bx; }
    F.ws = args.ws; F.ctl = (gu32*)(args.ws + WS_CTL); F.out = args.out;
#pragma unroll
    for (int i = 0; i < 21; ++i) F.in[i] = args.in[i];
    for (int u = F.tid; u < (LDS_BYTES - LDSCTL_OFF) / 4; u += NWAVES * 64) ((LAS unsigned*)(F.lds + LDSCTL_OFF))[u] = 0u;
    __syncthreads();
    XcdBarrier bar; bar.bar = (unsigned*)(F.ctl + CW_BAR); bar.x = 0; bar.st = nullptr;
    const int lo = args.ph_lo, hi = args.ph_hi;
    if (hi - lo > 1) bar = xcd_barrier_post((unsigned*)(F.ctl + CW_BAR), F.MISC + 8);
#define IN(k) (lo <= (k) && (k) < hi)
#define SEAM(k) do { if (IN(k) && IN((k) + 1)) xcd_barrier(bar); } while (0)
    unsigned char* ws = args.ws;

    if (IN(0)) { p0_prologue(F); SEAM(0); }
    if (IN(1)) { row_pass<1>(F); SEAM(1); }
    if (IN(2)) {
        { pg8::Gemm g{(const bf16*)(ws + WS_U8), (const bf16*)(ws + WS_WIN), D / 2, D / 2}; pg8::StaticOrder S; S.init(M, 4096, F.G, (int)blockIdx.x);
          pg8::EpiProj<true> E{(bf16*)(ws + WS_AQ), (bf16*)(ws + WS_AKV), (bf16*)(ws + WS_IQ), (bf16*)(ws + WS_IKX), (bf16*)(ws + WS_QL), (bf16*)(ws + WS_KVL),
                       (float*)(ws + WS_IW), (float*)(ws + WS_RSQQ), (float*)(ws + WS_RSQK), (const float*)(ws + WS_ROPE), ws + WS_KR8};
          pg8::gemm_phase<pg8::EpiProj<true>, pg8::StaticOrder, true, true, true>(F.lds + RING_OFF, g, S, E); }
        { pg8::Gemm g{(const bf16*)(ws + WS_U), (const bf16*)(ws + WS_WINB), D, D}; pg8::StaticOrder S; S.init(M, 4096, F.G, (int)blockIdx.x);
          pg8::EpiProj<false> E{(bf16*)(ws + WS_AQ), (bf16*)(ws + WS_AKV), (bf16*)(ws + WS_IQ), (bf16*)(ws + WS_IKX), (bf16*)(ws + WS_QL), (bf16*)(ws + WS_KVL),
                       (float*)(ws + WS_IW), (float*)(ws + WS_RSQQ), (float*)(ws + WS_RSQK), (const float*)(ws + WS_ROPE), ws + WS_KR8};
          pg8::gemm_phase<pg8::EpiProj<false>, pg8::StaticOrder, true, true>(F.lds + RING_OFF, g, S, E); }
        SEAM(2);
    }
    if (IN(3)) {
        { pg8::Gemm g{(const bf16*)(ws + WS_QL), (const bf16*)(ws + WS_WUQ), 512, 512}; pg8::StaticOrder S; S.init(M, 3072, F.G, (int)blockIdx.x);
          pg8::EpiUp<true> E{(bf16*)(ws + WS_QB), 3072, (const float*)(ws + WS_RSQQ), (const float*)(ws + WS_ROPE)};
          pg8::gemm_phase<pg8::EpiUp<true>, pg8::StaticOrder, true, true, true>(F.lds + RING_OFF, g, S, E); }
        { pg8::Gemm g{(const bf16*)(ws + WS_KVL), (const bf16*)(ws + WS_WUKV), 256, 256}; pg8::StaticOrder S; S.init(M, 2048, F.G, (int)blockIdx.x);
          pg8::EpiUp<false> E{(bf16*)(ws + WS_KN), 2048, (const float*)(ws + WS_RSQK), nullptr};
          pg8::gemm_phase<pg8::EpiUp<false>, pg8::StaticOrder, true, true, true>(F.lds + RING_OFF, g, S, E); }
        { pg8::Gemm g{(const bf16*)(ws + WS_WUKV) + (size_t)2048 * 256, (const bf16*)(ws + WS_KVL), 256, 256}; pg8::StaticOrder S; S.init(2048, M, F.G, (int)blockIdx.x);
          pg8::EpiVT E{(bf16*)(ws + WS_VT), (const float*)(ws + WS_RSQK)};
          pg8::gemm_phase<pg8::EpiVT, pg8::StaticOrder, true, true, true>(F.lds + RING_OFF, g, S, E); }
        __syncthreads();
        if (blockIdx.x < 128) av_transpose(F, (int)blockIdx.x);
        for (int P = F.vcu; P < 256; P += F.G)     { const int b = P >> 6, j = P & 63; for (int k = 0; k < 2; ++k) indexer_unit(F, b, 16 * (k ? 127 - j : j)); }
        SEAM(3);
    }
    if (IN(4)) {
        for (int P = F.vcu; P < 256; P += F.G)     { const int b = P >> 6, h = (P >> 2) & 15, j = P & 3; for (int k = 0; k < 2; ++k) att8::attn_unit<0>(F, b, h, 256 * (k ? 7 - j : j), 0); }
        __syncthreads();
        for (int P = F.vcu; P < 256; P += F.G)     { const int b = P >> 6, j = P & 63;
            __syncthreads();
            for (int k = 0; k < 2; ++k) att::dsa_topk(F, b, 16 * (k ? 127 - j : j), k);
            for (int k = 0; k < 2; ++k) att8::attn_unit<1>(F, b, 0, 16 * (k ? 127 - j : j), k); }
        SEAM(4);
    }
    if (IN(5)) {
        pg8::Gemm g{(const bf16*)(ws + WS_MIX), (const bf16*)(ws + WS_WO), D / 2, D / 2};     pg8::StaticOrder S; S.init(M, D, F.G, (int)blockIdx.x);
        pg8::EpiZ<false, 11> E{F.in[I_X], (float*)(ws + WS_Z1), (const float*)(ws + WS_MOD) + 2 * 4096, nullptr, nullptr, nullptr};
        pg8::gemm_phase<pg8::EpiZ<false, 11>, pg8::StaticOrder, true, true, true>(F.lds + RING_OFF, g, S, E);
        SEAM(5);
    }
    if (IN(6)) { row_pass<6>(F); SEAM(6); }
    if (IN(7)) {
        pg8::Gemm g{(const bf16*)(ws + WS_U), (const bf16*)(ws + WS_WGU), D, D}; pg8::StaticOrder S; S.init(M, NGU, F.G, (int)blockIdx.x);
        pg8::EpiGLU E{(bf16*)(ws + WS_H), (float*)(ws + WS_GH), (float*)(ws + WS_UPH), F.in[I_CW], F.in[I_CB], (PG8_LAS float*)(F.lds + RING_BYTES)};
        pg8::gemm_phase<pg8::EpiGLU, pg8::StaticOrder, true, true>(F.lds + RING_OFF, g, S, E);
        SEAM(7);
    }
    if (IN(8)) { p8_fixup(F); SEAM(8); }
    if (IN(9)) {
        pg8::Gemm g{(const bf16*)(ws + WS_H), (const bf16*)(ws + WS_WD), FF, FF}; pg8::StaticOrder S; S.init(M, D, F.G, (int)blockIdx.x);
        pg8::EpiZ<true, 0> E{(const float*)(ws + WS_Z1), F.out, (const float*)(ws + WS_MOD) + 5 * 4096, (const float*)(ws + WS_RS1), F.in[I_LN1G], F.in[I_LN1B]};
        pg8::gemm_phase<pg8::EpiZ<true, 0>, pg8::StaticOrder, true, true>(F.lds + RING_OFF, g, S, E);
        SEAM(9);
    }
    if (IN(10)) { row_pass<10>(F); }
#undef IN
#undef SEAM
}

extern "C" void kernel_launch(void* const* d_in, const int* in_sizes, int n_in, void* d_out, int out_size, void* d_ws, size_t ws_size, hipStream_t stream) {
    static int grid = 0;
    if (grid == 0) {
        if (n_in != 21 || in_sizes[0] != M * D || out_size != M * D || ws_size < WS_END) { fprintf(stderr, "kernel_launch: unexpected shapes (n_in %d, in0 %d, out %d, ws %zu); nothing launched\n", n_in, n_in > 0 ? in_sizes[0] : -1, out_size, ws_size); grid = -1; return; }
        int dev = 0, cus = 0, per_cu = 0;
        if (hipGetDevice(&dev) != hipSuccess || hipDeviceGetAttribute(&cus, hipDeviceAttributeMultiprocessorCount, dev) != hipSuccess) { grid = -1; return; }
        if (hipFuncSetAttribute((const void*)skel_fwd, hipFuncAttributeMaxDynamicSharedMemorySize, LDS_BYTES) != hipSuccess) { fprintf(stderr, "kernel_launch: hipFuncSetAttribute failed\n"); grid = -1; return; }
        if (hipOccupancyMaxActiveBlocksPerMultiprocessor(&per_cu, (const void*)skel_fwd, NWAVES * 64, LDS_BYTES) != hipSuccess || per_cu < 1)
            fprintf(stderr, "kernel_launch: note: occupancy query reports %d workgroups per CU\n", per_cu);
        (void)hipGetLastError();
        grid = cus;
    }
    if (grid < 0) return;
    if (hipMemsetAsync((char*)d_ws + WS_CTL, 0, CTL_ZERO_BYTES, stream) != hipSuccess) return;
    Args a{};
    for (int i = 0; i < 21; ++i) a.in[i] = (const float*)d_in[i];
    a.out = (float*)d_out; a.ws = (unsigned char*)d_ws;
#if MK_ONE_LAUNCH
    a.ph_lo = 0; a.ph_hi = N_PHASES;
    hipLaunchKernelGGL(skel_fwd, dim3(grid), dim3(NWAVES * 64), LDS_BYTES, stream, a);
#else
    for (int p = 0; p < N_PHASES; ++p) { a.ph_lo = p; a.ph_hi = p + 1; hipLaunchKernelGGL(skel_fwd, dim3(grid), dim3(NWAVES * 64), LDS_BYTES, stream, a); }
#endif
}
```
